# Optimizing an MI355X kernel written in HIP

```python
import math
import jax, jax.numpy as jnp
from jax import lax
import numpy as np

D_MODEL = 1024
BATCH = 32
SEQ = 2048
DEPTH = 4
DEC_BATCH = 8
DEC_SEQ = 4096
PAST_LEN = 128

F32 = jnp.float32
EPS = 1e-6
D_PLE = 256
D_FF = 2816
A_GROUPS = ((128, 1), (512, 4), (2048, 16))
A_HEADS_PER_GROUP = 4
A_HEAD_DIM = 64
A_HEADS = 12
A_WIDTH = 768
A_OUT = 256
A_BLOCK = 64
N_BUCKETS = 32
MAX_DISTANCE = 1024
B_HEADS = 4
B_HEAD_DIM = 128
B_WIDTH = 512
RET_CHUNK = 128
ROPE_BASE = 10000.0
C_HEADS = 4
C_KEY_DIM = 128
C_VAL_DIM = 128
C_WIDTH = 512
GLA_CHUNK = 64
SPLITS = (A_WIDTH, A_WIDTH, A_WIDTH, B_WIDTH, B_WIDTH, B_WIDTH, B_WIDTH, C_WIDTH, C_WIDTH, C_WIDTH, C_WIDTH, C_WIDTH)
N_IN = 3 * A_WIDTH + 4 * B_WIDTH + 5 * C_WIDTH

kernel_name = 'hybrid_bidir_dilated_retention_hgrn2_encoder'


def _rmsnorm(x, g):
    x32 = x.astype(F32)
    y = x32 * lax.rsqrt(jnp.mean(x32 * x32, axis=-1, keepdims=True) + EPS)
    return (y * g.astype(F32)).astype(x.dtype)


def _swiglu(u, wg, wu, wd):
    return (jax.nn.silu(u @ wg) * (u @ wu)) @ wd


def _t5_bucket(rel):
    half = N_BUCKETS // 2
    max_exact = half // 2
    ret = jnp.where(rel > 0, half, 0)
    n = jnp.abs(rel)
    nf = jnp.maximum(n, 1).astype(F32)
    large = max_exact + (jnp.log(nf / max_exact) / math.log(MAX_DISTANCE / max_exact) * (half - max_exact)).astype(jnp.int32)
    large = jnp.minimum(large, half - 1)
    return ret + jnp.where(n < max_exact, n, large)


def _dilated_band_attention(q, k, v, bias_table, dilation, n_side):
    Bn, S, H, hd = q.shape
    L = S // dilation
    C = A_BLOCK
    nC = -(-L // C)
    Lp = nC * C

    def to_sub(t):
        t = t.reshape(Bn, L, dilation, H, hd).transpose(0, 2, 1, 3, 4)
        t = jnp.pad(t, ((0, 0), (0, 0), (0, Lp - L), (0, 0), (0, 0)))
        return t.reshape(Bn, dilation, nC, C, H, hd)

    def band(t):
        tp = jnp.pad(t, ((0, 0), (0, 0), (1, 1), (0, 0), (0, 0), (0, 0)))
        return jnp.concatenate([tp[:, :, :-2], tp[:, :, 1:-1], tp[:, :, 2:]], axis=3)

    qs = to_sub(q)
    kb, vb = band(to_sub(k)), band(to_sub(v))
    qi = np.arange(C)[:, None]
    kj = np.arange(3 * C)[None, :]
    off = kj - C - qi
    bias = bias_table[_t5_bucket(jnp.asarray(off * dilation, dtype=jnp.int32))]
    bias = jnp.transpose(bias, (2, 0, 1)).astype(F32)
    kpos = (np.arange(nC)[:, None, None] - 1) * C + kj[None]
    valid = (np.abs(off) <= n_side)[None] & (kpos >= 0) & (kpos < L)
    s = jnp.einsum('brnqhd,brnkhd->brnhqk', qs, kb).astype(F32) * (hd ** -0.5) + bias
    s = jnp.where(valid[:, None], s, -1e30)
    m = jnp.max(s, axis=-1, keepdims=True)
    e = jnp.exp(s - m)
    den = jnp.sum(e, axis=-1, keepdims=True)
    o = jnp.einsum('brnhqk,brnkhd->brnqhd', (e / den).astype(v.dtype), vb)
    lse = jnp.swapaxes((m + jnp.log(den))[..., 0], 3, 4)

    def from_sub(t):
        t = t.reshape((Bn, dilation, Lp) + t.shape[4:])[:, :, :L]
        t = jnp.swapaxes(t, 1, 2)
        return t.reshape((Bn, S) + t.shape[3:])

    return from_sub(o), from_sub(lse)


def _mixer_a(q, k, v, rel_bias):
    Bn, S, _ = q.shape
    shp = (Bn, S, A_HEADS, A_HEAD_DIM)
    q, k, v = q.reshape(shp), k.reshape(shp), v.reshape(shp)
    outs, lses = [], []
    for g, (window, dil) in enumerate(A_GROUPS):
        sl = slice(g * A_HEADS_PER_GROUP, (g + 1) * A_HEADS_PER_GROUP)
        o, lse = _dilated_band_attention(q[:, :, sl], k[:, :, sl], v[:, :, sl], rel_bias[:, sl], dil, (window // 2) // dil)
        outs.append(o)
        lses.append(lse)
    w = jax.nn.softmax(jnp.stack(lses), axis=0)[..., None]
    out = jnp.sum(w * jnp.stack(outs).astype(F32), axis=0)
    return out.reshape(Bn, S, A_OUT).astype(q.dtype)


def _rotary(x, pos):
    half = x.shape[-1] // 2
    inv = ROPE_BASE ** (-jnp.arange(half, dtype=F32) / half)
    ang = pos[:, None] * inv[None]
    cos, sin = jnp.cos(ang)[None, :, None, :], jnp.sin(ang)[None, :, None, :]
    x1, x2 = x[..., :half], x[..., half:]
    return jnp.concatenate([x1 * cos - x2 * sin, x1 * sin + x2 * cos], axis=-1).astype(x.dtype)


def _retention_dir(q, k, v, log_gamma):
    Bn, S, H, dk = q.shape
    dv = v.shape[-1]
    C = RET_CHUNK
    n = S // C
    q = q.reshape(Bn, n, C, H, dk)
    k = k.reshape(Bn, n, C, H, dk)
    v = v.reshape(Bn, n, C, H, dv)
    idx = jnp.arange(C, dtype=F32)
    rel = idx[:, None] - idx[None, :]
    decay = jnp.where((rel >= 0)[..., None], jnp.exp(jnp.maximum(rel, 0.0)[..., None] * log_gamma), 0.0)
    att = jnp.einsum('bnihd,bnjhd->bnhij', q, k) * jnp.transpose(decay, (2, 0, 1))
    o = jnp.einsum('bnhij,bnjhe->bnihe', att, v)
    k_dec = k * jnp.exp((C - 1 - idx)[:, None] * log_gamma)[:, :, None]
    kv = jnp.einsum('bnjhd,bnjhe->nbhde', k_dec, v)
    g_chunk = jnp.exp(C * log_gamma)[:, None, None]

    def step(state, kv_c):
        return state * g_chunk + kv_c, state

    _, prev = lax.scan(step, jnp.zeros(kv.shape[1:], kv.dtype), kv)
    q_dec = q * jnp.exp((idx + 1)[:, None] * log_gamma)[:, :, None]
    o = o + jnp.einsum('bnihd,nbhde->bnihe', q_dec, prev)
    return o.reshape(Bn, S, H, dv)


def _mixer_b(q, k, v, g, gain):
    Bn, S, _ = q.shape
    shp = (Bn, S, B_HEADS, B_HEAD_DIM)
    q, k, v = q.reshape(shp), k.reshape(shp), v.reshape(shp)
    pos = jnp.arange(S, dtype=F32)
    q = _rotary(q, pos)
    k = _rotary(k, pos) * (B_HEAD_DIM ** -0.5)
    hh = jnp.arange(B_HEADS, dtype=F32)
    lg_fwd = jnp.log1p(-jnp.exp2(-5.0 - hh))
    lg_bwd = jnp.log1p(-jnp.exp2(-5.5 - hh))
    o = _retention_dir(q, k, v, lg_fwd) + _retention_dir(q[:, ::-1], k[:, ::-1], v[:, ::-1], lg_bwd)[:, ::-1]
    o = o.astype(F32)
    mu = jnp.mean(o, axis=-1, keepdims=True)
    var = jnp.mean(jnp.square(o - mu), axis=-1, keepdims=True)
    o = ((o - mu) * lax.rsqrt(var + EPS)).reshape(Bn, S, B_WIDTH) * gain.astype(F32)
    return (jax.nn.silu(g.astype(F32)) * o).astype(g.dtype)


def _gla_dir(q, k, v, logf):
    Bn, S, H, dk = q.shape
    dv = v.shape[-1]
    C = GLA_CHUNK
    n = S // C
    q = q.reshape(Bn, n, C, H, dk)
    k = k.reshape(Bn, n, C, H, dk)
    v = v.reshape(Bn, n, C, H, dv)
    b = jnp.cumsum(logf.reshape(Bn, n, C, H, dk), axis=2)
    b_ref = b[:, :, C // 2 - 1:C // 2]
    att = jnp.einsum('bnihd,bnjhd->bnhij', q * jnp.exp(b - b_ref), k * jnp.exp(b_ref - b))
    tri = jnp.tril(jnp.ones((C, C), dtype=bool))
    att = jnp.where(tri, att, 0.0)
    o = jnp.einsum('bnhij,bnjhe->bnihe', att, v)
    b_last = b[:, :, -1:]
    kv = jnp.einsum('bnjhd,bnjhe->nbhde', k * jnp.exp(b_last - b), v)
    g_chunk = jnp.moveaxis(jnp.exp(b_last[:, :, 0]), 1, 0)

    def step(state, inp):
        kv_c, g_c = inp
        return state * g_c[..., None] + kv_c, state

    _, prev = lax.scan(step, jnp.zeros(kv.shape[1:], kv.dtype), (kv, g_chunk))
    o = o + jnp.einsum('bnihd,nbhde->bnihe', q * jnp.exp(b), prev)
    return o.reshape(Bn, S, H, dv)


def _mixer_c(q, zf, zb, v, g, lb, gain):
    Bn, S, _ = q.shape
    kshp = (Bn, S, C_HEADS, C_KEY_DIM)
    q = jax.nn.silu(q).reshape(kshp)
    v = v.reshape(Bn, S, C_HEADS, C_VAL_DIM)
    log_lb, log_1mlb = jnp.log(lb), jnp.log1p(-lb)

    def gate(z):
        z = z.astype(F32)
        logf = jnp.logaddexp(log_lb, log_1mlb + jax.nn.log_sigmoid(z))
        key = jnp.exp(log_1mlb + jax.nn.log_sigmoid(-z))
        return logf.reshape(kshp), key.reshape(kshp)

    logf_f, k_f = gate(zf)
    logf_b, k_b = gate(zb)
    o = _gla_dir(q, k_f, v, logf_f) + _gla_dir(q[:, ::-1], k_b[:, ::-1], v[:, ::-1], logf_b[:, ::-1])[:, ::-1]
    o = o.astype(F32)
    o = o * lax.rsqrt(jnp.mean(o * o, axis=-1, keepdims=True) + EPS)
    o = o.reshape(Bn, S, C_WIDTH) * gain.astype(F32)
    return (jax.nn.silu(g.astype(F32)) * o).astype(g.dtype)


def _trunk(x, p, lbs, w):
    h = x
    cuts = [int(c) for c in np.cumsum(SPLITS)[:-1]]
    for l in range(DEPTH):
        h = h + 0.5 * _swiglu(_rmsnorm(h, w['ffn1_norm'][l]), w['ffn1_w_gate'][l], w['ffn1_w_up'][l], w['ffn1_w_down'][l])
        u = _rmsnorm(h, w['mix_norm'][l])
        z = u @ w['w_in'][l]
        qa, ka, va, qb, kb, vb, gb, qc, fcf, fcb, ic, gc = jnp.split(z, cuts, axis=-1)
        a = _mixer_a(qa, ka, va, w['rel_bias'])
        b = _mixer_b(qb, kb, vb, gb, w['ret_norm'][l])
        c = _mixer_c(qc, fcf, fcb, ic, gc, lbs[l], w['hgrn_norm'][l])
        ga, gbr, gcr = jnp.split(jax.nn.sigmoid(u @ w['w_merge_gate'][l]), 3, axis=-1)
        m = ga * (a @ w['w_branch_a'][l]) + gbr * (b @ w['w_branch_b'][l]) + gcr * (c @ w['w_branch_c'][l])
        h = h + m @ w['w_out'][l]
        h = h + 0.5 * _swiglu(_rmsnorm(h, w['ffn2_norm'][l]), w['ffn2_w_gate'][l], w['ffn2_w_up'][l], w['ffn2_w_down'][l])
        h = h + jax.nn.sigmoid(_rmsnorm(h, w['ple_norm'][l]) @ w['w_ple_gate'][l]) * (p[l] @ w['w_ple_proj'][l])
    return _rmsnorm(h, w['final_norm'])


def setup_inputs(seed: int = 0) -> dict:
    key = jax.random.key(seed)
    ks = iter(jax.random.split(key, 32))
    D, F = D_MODEL, D_FF

    def nrm(shape, scale):
        return jax.random.normal(next(ks), shape, F32) * scale

    def gain(shape):
        return 1.0 + 0.05 * jax.random.normal(next(ks), shape, F32)

    return {
        'x_prompt': nrm((BATCH, SEQ, D), 1.0),
        'x_sample': nrm((DEC_BATCH, DEC_SEQ, D), 1.0),
        'p_prompt': nrm((DEPTH, BATCH, SEQ, D_PLE), 1.0),
        'p_sample': nrm((DEPTH, DEC_BATCH, DEC_SEQ, D_PLE), 1.0),
        'ffn1_norm': gain((DEPTH, D)),
        'ffn1_w_gate': nrm((DEPTH, D, F), D ** -0.5),
        'ffn1_w_up': nrm((DEPTH, D, F), D ** -0.5),
        'ffn1_w_down': nrm((DEPTH, F, D), F ** -0.5),
        'mix_norm': gain((DEPTH, D)),
        'w_in': nrm((DEPTH, D, N_IN), D ** -0.5),
        'rel_bias': nrm((N_BUCKETS, A_HEADS), 0.5),
        'ret_norm': gain((DEPTH, B_WIDTH)),
        'hgrn_lower_bound': nrm((DEPTH, C_WIDTH), 1.0),
        'hgrn_norm': gain((DEPTH, C_WIDTH)),
        'w_branch_a': nrm((DEPTH, A_OUT, D), A_OUT ** -0.5),
        'w_branch_b': nrm((DEPTH, B_WIDTH, D), B_WIDTH ** -0.5),
        'w_branch_c': nrm((DEPTH, C_WIDTH, D), C_WIDTH ** -0.5),
        'w_merge_gate': nrm((DEPTH, D, 3 * D), D ** -0.5),
        'w_out': nrm((DEPTH, D, D), D ** -0.5),
        'ffn2_norm': gain((DEPTH, D)),
        'ffn2_w_gate': nrm((DEPTH, D, F), D ** -0.5),
        'ffn2_w_up': nrm((DEPTH, D, F), D ** -0.5),
        'ffn2_w_down': nrm((DEPTH, F, D), F ** -0.5),
        'ple_norm': gain((DEPTH, D)),
        'w_ple_gate': nrm((DEPTH, D, D), D ** -0.5),
        'w_ple_proj': nrm((DEPTH, D_PLE, D), D_PLE ** -0.5),
        'final_norm': gain((D,)),
    }


def reference(x_prompt, x_sample, p_prompt, p_sample, ffn1_norm, ffn1_w_gate, ffn1_w_up, ffn1_w_down, mix_norm, w_in, rel_bias, ret_norm, hgrn_lower_bound, hgrn_norm, w_branch_a, w_branch_b, w_branch_c, w_merge_gate, w_out, ffn2_norm, ffn2_w_gate, ffn2_w_up, ffn2_w_down, ple_norm, w_ple_gate, w_ple_proj, final_norm):
    lb = jax.nn.softmax(hgrn_lower_bound.astype(F32), axis=0)
    lb = jnp.cumsum(lb, axis=0)
    lbs = lb - lb[0]
    w = dict(ffn1_norm=ffn1_norm, ffn1_w_gate=ffn1_w_gate, ffn1_w_up=ffn1_w_up, ffn1_w_down=ffn1_w_down,
             mix_norm=mix_norm, w_in=w_in, rel_bias=rel_bias, ret_norm=ret_norm, hgrn_norm=hgrn_norm,
             w_branch_a=w_branch_a, w_branch_b=w_branch_b, w_branch_c=w_branch_c, w_merge_gate=w_merge_gate,
             w_out=w_out, ffn2_norm=ffn2_norm, ffn2_w_gate=ffn2_w_gate, ffn2_w_up=ffn2_w_up,
             ffn2_w_down=ffn2_w_down, ple_norm=ple_norm, w_ple_gate=w_ple_gate, w_ple_proj=w_ple_proj,
             final_norm=final_norm)
    y_prompt = _trunk(x_prompt, p_prompt, lbs, w)
    y_sample = _trunk(x_sample, p_sample, lbs, w)
    return (y_prompt, y_sample)
```

```cpp
#ifndef CPU_EMU
#include <hip/hip_runtime.h>
#include <cstdio>
#include <cstdint>
#define LAS __attribute__((address_space(3)))
#define DEVFN __device__ __forceinline__
#define HDFN __host__ __device__ __forceinline__
#define EPI_FENCE() asm volatile("" ::: "memory")
#define OPAQUE_V(x) asm volatile("" : "+v"(x))
#else
#define EPI_FENCE()
#define OPAQUE_V(x)
#endif

#ifdef SMALL_CFG
constexpr int D = 256, FF = 256, BATCH = 2, SEQ = 2048, DEC_BATCH = 1, DEC_SEQ = 4096, DEPTH = 2, SLAB = 4096;
#else
constexpr int D = 1024, FF = 2816, BATCH = 32, SEQ = 2048, DEC_BATCH = 8, DEC_SEQ = 4096, DEPTH = 4, SLAB = 16384;
#endif
#ifndef ONE_LAUNCH
#define ONE_LAUNCH 1
#endif
constexpr int NP = BATCH * SEQ, NS = DEC_BATCH * DEC_SEQ, T = NP + NS, NSLAB = T / SLAB;
constexpr int D_PLE = 256, N_IN = 6912, ZW = N_IN + 3 * D, MIXW = 1280, AOW = 768;
constexpr int OFF_QA = 0, OFF_KA = 768, OFF_VA = 1536, OFF_QB = 2304, OFF_KB = 2816, OFF_VB = 3328, OFF_GB = 3840, OFF_QC = 4352, OFF_FCF = 4864, OFF_IC = 5888, OFF_GC = 6400, OFF_MG = 6912;
constexpr float EPS = 1e-6f;
static_assert(NP % SLAB == 0 && NS % SLAB == 0 && SLAB % SEQ == 0 && SLAB % DEC_SEQ == 0 && T % 256 == 0 && (2 * FF) % 256 == 0 && FF % 128 == 0 && D % 256 == 0, "shape");

constexpr size_t MiB = 1u << 20;
constexpr size_t al(size_t x) { return (x + 255) & ~(size_t)255; }
constexpr size_t WS_CTL = 0, CTL_BYTES = 1 * MiB;
constexpr size_t WS_ROPE = WS_CTL + CTL_BYTES;
constexpr size_t WS_BIAS = WS_ROPE + 2 * MiB;
constexpr size_t WS_LBS = WS_BIAS + 16384;
constexpr size_t WS_WB = WS_LBS + 16384;
constexpr size_t WE_GU1 = 0, WE_D1 = WE_GU1 + (size_t)2 * FF * D, WE_IN = WE_D1 + (size_t)D * FF, WE_BR = WE_IN + (size_t)ZW * D, WE_OUT = WE_BR + (size_t)D * MIXW,
                 WE_GU2 = WE_OUT + (size_t)D * D, WE_D2 = WE_GU2 + (size_t)2 * FF * D, WE_PG = WE_D2 + (size_t)D * FF, WE_PP = WE_PG + (size_t)D * D, WE_END = WE_PP + (size_t)D * D_PLE;
constexpr size_t WS_XN = al(WS_WB + WE_END * 2);
constexpr size_t WS_XN2 = al(WS_XN + (size_t)T * D * 2);
constexpr size_t WS_SSQ = al(WS_XN2 + (size_t)T * D * 2);
constexpr size_t WS_PB = al(WS_SSQ + (size_t)3 * T * 16);
constexpr size_t WS_R = al(WS_PB + (size_t)T * D_PLE * 2);
constexpr size_t R_ACT = 0, R_ACT_END = (size_t)T * FF * 2;
constexpr size_t R_Z = 0, R_AO = al(R_Z + (size_t)SLAB * ZW * 2), R_LSE = al(R_AO + (size_t)SLAB * AOW * 2), R_MIX = al(R_LSE + (size_t)SLAB * 12 * 4),
                 R_MH = al(R_MIX + (size_t)SLAB * MIXW * 2), R_SB = al(R_MH + (size_t)SLAB * D * 2),
                 R_SC = al(R_SB + (size_t)(SLAB / 128) * 4 * 2 * 16384 * 2), R_GC = al(R_SC + (size_t)(SLAB / 64) * 4 * 2 * 16384 * 2), R_MIX_END = al(R_GC + (size_t)(SLAB / 64) * 4 * 2 * 128 * 4);
constexpr size_t R_SG = 0, R_PLE_END = al(R_SG + (size_t)T * D * 2);
constexpr size_t cmax(size_t a, size_t b) { return a > b ? a : b; }
constexpr size_t WS_END = WS_R + cmax(cmax(R_ACT_END, R_MIX_END), R_PLE_END);
constexpr int LDS_BYTES = 147456;
#ifndef MIXREP
#define MIXREP 1
#endif
#ifndef REP_A
#define REP_A 1
#endif
#ifndef REP_KV
#define REP_KV 1
#endif
#ifndef REP_OUT
#define REP_OUT 1
#endif
constexpr int NFP = (T % 768 == 0) ? 3 : 2, TP = T / NFP;
static_assert(TP % 256 == 0, "FFN parts");
constexpr int NPH = 2 + DEPTH * (2 + 2 * (NFP + 1) + (NSLAB + 1) + NSLAB * (1 + 3 * MIXREP));

typedef unsigned short bf16_t;
typedef short bf16x8 __attribute__((ext_vector_type(8)));
typedef short s16x4 __attribute__((ext_vector_type(4)));
typedef float f32x4 __attribute__((ext_vector_type(4)));
typedef unsigned u32x4 __attribute__((ext_vector_type(4)));
typedef unsigned u32x2 __attribute__((ext_vector_type(2)));

#ifndef CPU_EMU
DEVFN int lane_id_v() { int l; asm volatile("v_mbcnt_lo_u32_b32 %0, -1, 0\n\tv_mbcnt_hi_u32_b32 %0, -1, %0" : "=v"(l)); return l; }
DEVFN int opaque_tid(int w0) { return w0 * 64 + lane_id_v(); }
#else
DEVFN int opaque_tid(int) { return threadIdx.x; }
#endif
DEVFN unsigned f2bf(float f) { unsigned u = __builtin_bit_cast(unsigned, f); return (u + 0x7fffu + ((u >> 16) & 1u)) >> 16; }
#ifndef CPU_EMU
typedef float f32x2_t __attribute__((ext_vector_type(2)));
typedef __bf16 bf16x2_t __attribute__((ext_vector_type(2)));
DEVFN unsigned pk2(float lo, float hi) { const f32x2_t v = {lo, hi}; return __builtin_bit_cast(unsigned, __builtin_convertvector(v, bf16x2_t)); }
#else
DEVFN unsigned pk2(float lo, float hi) { return f2bf(lo) | (f2bf(hi) << 16); }
#endif
DEVFN float bf2f(unsigned b) { return __builtin_bit_cast(float, b << 16); }
DEVFN float bflo(unsigned w) { return __builtin_bit_cast(float, w << 16); }
DEVFN float bfhi(unsigned w) { return __builtin_bit_cast(float, w & 0xffff0000u); }
DEVFN unsigned f2h(float f) { _Float16 h = (_Float16)f; return (unsigned)__builtin_bit_cast(unsigned short, h); }
DEVFN float h2f(unsigned b) { return (float)__builtin_bit_cast(_Float16, (unsigned short)b); }
DEVFN u32x2 pk4(f32x4 v) { u32x2 r; r.x = pk2(v[0], v[1]); r.y = pk2(v[2], v[3]); return r; }
#ifndef CPU_EMU
DEVFN f32x4 mfma16(bf16x8 a, bf16x8 b, f32x4 c) { return __builtin_amdgcn_mfma_f32_16x16x32_bf16(a, b, c, 0, 0, 0); }
DEVFN float fexp(float x) { return __expf(x); }
DEVFN float flog(float x) { return __logf(x); }
DEVFN float frcp(float x) { return __builtin_amdgcn_rcpf(x); }
#else
f32x4 mfma16(bf16x8 a, bf16x8 b, f32x4 c);
DEVFN float fexp(float x) { return expf(x); }
DEVFN float flog(float x) { return logf(x); }
DEVFN float frcp(float x) { return 1.0f / x; }
#endif
DEVFN float rms_rinv(float ssq) { return 1.0f / sqrtf(ssq * (1.0f / D) + EPS); }
DEVFN float row_rinv(const float* ssqp, unsigned row) { const f32x4 q = *(const f32x4*)(ssqp + 4 * row); float t = q[0]; if (D >= 512) t += q[1]; if (D >= 768) t += q[2]; if (D >= 1024) t += q[3]; return rms_rinv(t); }
#ifndef CPU_EMU
#define EPI_BARRIER() do { asm volatile("s_waitcnt lgkmcnt(0)" ::: "memory"); __builtin_amdgcn_s_barrier(); asm volatile("" ::: "memory"); } while (0)
#else
#define EPI_BARRIER() __syncthreads()
#endif
constexpr int EPI_RED_OFF = 131072;
constexpr int EPI_RINV_OFF = EPI_RED_OFF + 4096;
DEVFN void rinv_pre(const float* ssqp, LAS unsigned char* lds, int pm, int par, int tid) {
#ifndef CPU_EMU
    asm volatile("" : "+v"(tid));
#endif
    if (tid < 256) ((LAS float*)(lds + EPI_RINV_OFF))[par * 256 + tid] = row_rinv(ssqp, (unsigned)(pm * 256 + tid)); }
DEVFN float rinv_get(const LAS unsigned char* lds, int par, int r) { return ((const LAS float*)(lds + EPI_RINV_OFF))[par * 256 + r]; }
#ifndef CPU_EMU
DEVFN f32x4 swiglu4(f32x4 g, f32x4 u, float ri2, float nl) {
    const f32x4 t = g * nl; f32x4 e; e[0] = __builtin_amdgcn_exp2f(t[0]); e[1] = __builtin_amdgcn_exp2f(t[1]); e[2] = __builtin_amdgcn_exp2f(t[2]); e[3] = __builtin_amdgcn_exp2f(t[3]);
    const f32x4 d = e + 1.0f; f32x4 r; r[0] = __builtin_amdgcn_rcpf(d[0]); r[1] = __builtin_amdgcn_rcpf(d[1]); r[2] = __builtin_amdgcn_rcpf(d[2]); r[3] = __builtin_amdgcn_rcpf(d[3]);
    return (g * u) * (r * ri2);
}
#else
DEVFN f32x4 swiglu4(f32x4 g, f32x4 u, float ri2, float nl) { f32x4 o; for (int j = 0; j < 4; ++j) o[j] = (g[j] * u[j]) * ri2 / (1.0f + exp2f(g[j] * nl)); return o; }
#endif
DEVFN float fsigmoid(float x) { return frcp(1.0f + fexp(-x)); }
DEVFN float fsilu(float x) { return x * fsigmoid(x); }
DEVFN bf16x8 cat8(s16x4 lo, s16x4 hi) { return __builtin_shufflevector(lo, hi, 0, 1, 2, 3, 4, 5, 6, 7); }
DEVFN bf16x8 pack8(f32x4 a, f32x4 b) { u32x4 w; w.x = pk2(a[0], a[1]); w.y = pk2(a[2], a[3]); w.z = pk2(b[0], b[1]); w.w = pk2(b[2], b[3]); return __builtin_bit_cast(bf16x8, w); }
DEVFN int pos_of(int row) { return row < NP ? (row & (SEQ - 1)) : ((row - NP) & (DEC_SEQ - 1)); }
DEVFN float ret_l2(int dir, int h) { const float x = exp2f((dir ? -5.5f : -5.0f) - (float)h); return log1pf(-x) * 1.4426950408889634f; }

namespace pg8 {
constexpr int BM = 256, BK = 64, HALF = 128, HTB = HALF * BK * 2, STAGE_BYTES = 8 * HTB, NXCD = 8, WGM = 8;
HDFN int lds_byte(int r, int c) { const int st = (r >> 4) * 2 + (c >> 5), rr = r & 15, cc = c & 31, ob = rr * 64 + cc * 2; return st * 1024 + (ob ^ (((ob >> 9) & 1) << 5)); }
HDFN void stage_rc(int b, int& R, int& C) { const int st = b / 1024, sb = b % 1024, swz = sb ^ (((sb >> 9) & 1) << 5); R = (st >> 1) * 16 + swz / 64; C = (st & 1) * 32 + (swz % 64) / 2; }
HDFN int perm32(int rho) { const int n = rho >> 4, i = rho & 15; return 8 * (i >> 2) + 4 * n + (i & 3); }
struct Unit { int pm, pn; };
struct Gemm { const bf16_t* A; const bf16_t* Bt; int M, N, K, lda, ldb; };
struct StaticOrder {
    int nM, nN, nwg, G, c;
    HDFN void init(int M, int N, int G_, int c_) { nM = M / BM; nN = N / BM; nwg = nM * nN; G = G_; c = c_; }
    HDFN bool next(int i, Unit& u) const {
        const long L = (long)i * G + c; if (L >= nwg) return false;
        int wgid = (int)L; { const int q = nwg / NXCD, r = nwg % NXCD, xcd = wgid % NXCD, off = wgid / NXCD; wgid = (xcd < r ? xcd * (q + 1) : r * (q + 1) + (xcd - r) * q) + off; }
        const int nig = WGM * nN, gid = wgid / nig, fm = gid * WGM, gsz = (nM - fm) < WGM ? (nM - fm) : WGM;
        u.pm = fm + ((wgid % nig) % gsz); u.pn = (wgid % nig) / gsz; return true;
    }
    DEVFN void a_ready(const Unit&) const {}
    DEVFN void done(const Unit&) const {}
};

struct EpiSwiglu {
    static constexpr bool PERM = true, MIDK = false;
    bf16_t* O; int ldc; const float* ssq; LAS unsigned char* lds;
    DEVFN void pre(const Unit& u, int par, int tid) const { rinv_pre(ssq, lds, u.pm, par, tid); }
    DEVFN void operator()(const f32x4 (&acc)[2][2][4][2], const Unit& u, int wr, int wc, int fr, int fq, int par) const {
        const int row0 = u.pm * BM + wr * 64 + fr, col0 = u.pn * HALF + wc * 32 + 8 * fq;
#pragma unroll
        for (int ai = 0; ai < 2; ++ai)
#pragma unroll
            for (int m = 0; m < 4; ++m) {
                bf16_t* rowp = O + (size_t)(row0 + ai * HALF + m * 16) * ldc + col0;
                const float ri = rinv_get(lds, par, ai * HALF + wr * 64 + m * 16 + fr);
                const float ri2 = ri * ri, nl = ri * -1.4426950408889634f;
                f32x4 a = swiglu4(acc[ai][0][m][0], acc[ai][1][m][0], ri2, nl), b = swiglu4(acc[ai][0][m][1], acc[ai][1][m][1], ri2, nl);
                u32x4 w; w.x = pk2(a[0], a[1]); w.y = pk2(a[2], a[3]); w.z = pk2(b[0], b[1]); w.w = pk2(b[2], b[3]);
                *(u32x4*)rowp = w; EPI_FENCE();
            }
    }
};
struct EpiResAdd {
    static constexpr bool PERM = false, MIDK = false;
    float* C; bf16_t* XN; float* ssq; int ldc; int halve; LAS unsigned char* lds;
    DEVFN void pre(const Unit&, int, int) const {}
    DEVFN void operator()(const f32x4 (&acc)[2][2][4][2], const Unit& u, int wr, int wc, int fr, int fq, int) const {
        const int row0 = u.pm * BM + wr * 64 + fr, col0 = u.pn * BM + wc * 32 + 4 * fq;
        int frq = fr; OPAQUE_V(frq);
        const float scale = halve == 2 ? 0.0f : (halve ? 0.5f : 1.0f); const f32x4 sc4 = {scale, scale, scale, scale};
#pragma unroll
        for (int ai = 0; ai < 2; ++ai) {
            f32x4 hv[4][2][2];
#pragma unroll
            for (int m = 0; m < 4; ++m) { const unsigned off = (unsigned)(row0 + ai * HALF + m * 16) * (unsigned)ldc + (unsigned)col0;
#pragma unroll
                for (int bj = 0; bj < 2; ++bj)
#pragma unroll
                    for (int n = 0; n < 2; ++n) hv[m][bj][n] = *(const f32x4*)(C + (off + bj * HALF + n * 16)); }
            EPI_FENCE();
#pragma unroll
            for (int m = 0; m < 4; ++m) { const unsigned off = (unsigned)(row0 + ai * HALF + m * 16) * (unsigned)ldc + (unsigned)col0; float part = 0.f;
#pragma unroll
                for (int bj = 0; bj < 2; ++bj)
#pragma unroll
                    for (int n = 0; n < 2; ++n) { const f32x4 v = hv[m][bj][n] + acc[ai][bj][m][n] * sc4; *(f32x4*)(C + (off + bj * HALF + n * 16)) = v; *(u32x2*)(XN + (off + bj * HALF + n * 16)) = pk4(v);
                        part += (v[0] * v[0] + v[1] * v[1]) + (v[2] * v[2] + v[3] * v[3]); }
                part += __shfl_xor(part, 16); part += __shfl_xor(part, 32);
                if (fq == 0) ((LAS float*)(lds + EPI_RED_OFF))[(ai * HALF + wr * 64 + m * 16 + frq) * 4 + wc] = part;
                if (m & 1) EPI_FENCE(); }
        }
        EPI_BARRIER();
        { int t = wr * 256 + wc * 64 + fq * 16 + fr; OPAQUE_V(t); if (t < 256) { const f32x4 q = *(const LAS f32x4*)(lds + EPI_RED_OFF + t * 16); ssq[(size_t)(u.pm * BM + t) * 4 + u.pn] = (q[0] + q[1]) + (q[2] + q[3]); } }
    }
};
struct EpiGateBf16 {
    static constexpr bool PERM = false, MIDK = false;
    bf16_t* SG; int ldc; const float* ssq; LAS unsigned char* lds;
    DEVFN void pre(const Unit& u, int par, int tid) const { rinv_pre(ssq, lds, u.pm, par, tid); }
    DEVFN void operator()(const f32x4 (&acc)[2][2][4][2], const Unit& u, int wr, int wc, int fr, int fq, int par) const {
        const int row0 = u.pm * BM + wr * 64 + fr, col0 = u.pn * BM + wc * 32 + 4 * fq;
#pragma unroll
        for (int ai = 0; ai < 2; ++ai)
#pragma unroll
            for (int m = 0; m < 4; ++m) { const unsigned off = (unsigned)(row0 + ai * HALF + m * 16) * (unsigned)ldc + (unsigned)col0; const float ri = rinv_get(lds, par, ai * HALF + wr * 64 + m * 16 + fr);
#pragma unroll
                for (int bj = 0; bj < 2; ++bj)
#pragma unroll
                    for (int n = 0; n < 2; ++n) { f32x4 v = acc[ai][bj][m][n];
#pragma unroll
                        for (int j = 0; j < 4; ++j) v[j] = fsigmoid(v[j] * ri);
                        *(u32x2*)(SG + (off + bj * HALF + n * 16)) = pk4(v); }
                EPI_FENCE(); }
    }
};
struct EpiPle {
    static constexpr bool PERM = false, MIDK = false;
    float* C; const bf16_t* SG; int ldc; bf16_t* XN2; float* ssq_out; LAS unsigned char* lds;
    DEVFN void pre(const Unit&, int, int) const {}
    DEVFN void operator()(const f32x4 (&acc)[2][2][4][2], const Unit& u, int wr, int wc, int fr, int fq, int) const {
        const int row0 = u.pm * BM + wr * 64 + fr, col0 = u.pn * BM + wc * 32 + 4 * fq;
        int frq = fr; OPAQUE_V(frq);
#pragma unroll
        for (int ai = 0; ai < 2; ++ai)
#pragma unroll
            for (int mp = 0; mp < 2; ++mp) {
                f32x4 hv[2][2][2]; u32x2 gv[2][2][2];
#pragma unroll
                for (int m2 = 0; m2 < 2; ++m2) { const unsigned ro = (unsigned)(row0 + ai * HALF + (2 * mp + m2) * 16) * (unsigned)ldc + (unsigned)col0;
#pragma unroll
                    for (int bj = 0; bj < 2; ++bj)
#pragma unroll
                        for (int n = 0; n < 2; ++n) { hv[m2][bj][n] = *(const f32x4*)(C + (ro + bj * HALF + n * 16)); gv[m2][bj][n] = *(const u32x2*)(SG + (ro + bj * HALF + n * 16)); } }
                EPI_FENCE();
#pragma unroll
                for (int m2 = 0; m2 < 2; ++m2) { const int m = 2 * mp + m2; const unsigned ro = (unsigned)(row0 + ai * HALF + m * 16) * (unsigned)ldc + (unsigned)col0; float part = 0.f;
#pragma unroll
                    for (int bj = 0; bj < 2; ++bj)
#pragma unroll
                        for (int n = 0; n < 2; ++n) { const f32x4 a = acc[ai][bj][m][n]; const u32x2 gw = gv[m2][bj][n]; f32x4 o = hv[m2][bj][n];
                            o[0] += bflo(gw.x) * a[0]; o[1] += bfhi(gw.x) * a[1]; o[2] += bflo(gw.y) * a[2]; o[3] += bfhi(gw.y) * a[3];
                            *(f32x4*)(C + (ro + bj * HALF + n * 16)) = o; *(u32x2*)(XN2 + (ro + bj * HALF + n * 16)) = pk4(o); part += (o[0] * o[0] + o[1] * o[1]) + (o[2] * o[2] + o[3] * o[3]); }
                    part += __shfl_xor(part, 16); part += __shfl_xor(part, 32);
                    if (fq == 0) ((LAS float*)(lds + EPI_RED_OFF))[(ai * HALF + wr * 64 + m * 16 + frq) * 4 + wc] = part; }
                EPI_FENCE();
            }
        EPI_BARRIER();
        { int t = wr * 256 + wc * 64 + fq * 16 + fr; OPAQUE_V(t); if (t < 256) { const f32x4 q = *(const LAS f32x4*)(lds + EPI_RED_OFF + t * 16); ssq_out[(size_t)(u.pm * BM + t) * 4 + u.pn] = (q[0] + q[1]) + (q[2] + q[3]); } }
    }
};
struct EpiMerge {
    static constexpr bool PERM = true, MIDK = true;
    bf16_t* MH; const bf16_t* G; int ldg;
    DEVFN void pre(const Unit&, int, int) const {}
    DEVFN void gate8(unsigned off, f32x4& g0, f32x4& g1) const { const u32x4 w = *(const u32x4*)(G + off);
        g0[0] = fmaxf(bflo(w.x), 1e-30f); g0[1] = fmaxf(bfhi(w.x), 1e-30f); g0[2] = fmaxf(bflo(w.y), 1e-30f); g0[3] = fmaxf(bfhi(w.y), 1e-30f);
        g1[0] = fmaxf(bflo(w.z), 1e-30f); g1[1] = fmaxf(bfhi(w.z), 1e-30f); g1[2] = fmaxf(bflo(w.w), 1e-30f); g1[3] = fmaxf(bfhi(w.w), 1e-30f); }
    DEVFN void mid(f32x4 (&acc)[2][2][4][2], const Unit& u, int wr, int wc, int fr, int fq, int x) const {
        const int row0 = u.pm * BM + wr * 64 + fr, col0 = u.pn * BM + wc * 32 + 8 * fq + x * D;
#pragma unroll
        for (int ai = 0; ai < 2; ++ai)
#pragma unroll
            for (int m = 0; m < 4; ++m) { const unsigned off = (unsigned)(row0 + ai * HALF + m * 16) * (unsigned)ldg + (unsigned)col0;
#pragma unroll
                for (int bj = 0; bj < 2; ++bj) { f32x4 n0, n1, d0, d1; gate8(off + bj * HALF, n0, n1); gate8(off + D + bj * HALF, d0, d1);
#pragma unroll
                    for (int j = 0; j < 4; ++j) { acc[ai][bj][m][0][j] *= n0[j] * frcp(d0[j]); acc[ai][bj][m][1][j] *= n1[j] * frcp(d1[j]); } }
                if (m & 1) EPI_FENCE(); }
    }
    DEVFN void operator()(const f32x4 (&acc)[2][2][4][2], const Unit& u, int wr, int wc, int fr, int fq, int) const {
        const int row0 = u.pm * BM + wr * 64 + fr, col0 = u.pn * BM + wc * 32 + 8 * fq;
#pragma unroll
        for (int ai = 0; ai < 2; ++ai)
#pragma unroll
            for (int m = 0; m < 4; ++m) { const unsigned row = (unsigned)(row0 + ai * HALF + m * 16);
#pragma unroll
                for (int bj = 0; bj < 2; ++bj) { const int col = col0 + bj * HALF; f32x4 g0, g1; gate8(row * (unsigned)ldg + 2 * D + col, g0, g1);
                    const f32x4 v0 = acc[ai][bj][m][0] * g0, v1 = acc[ai][bj][m][1] * g1;
                    u32x4 w; w.x = pk2(v0[0], v0[1]); w.y = pk2(v0[2], v0[3]); w.z = pk2(v1[0], v1[1]); w.w = pk2(v1[2], v1[3]);
                    *(u32x4*)(MH + row * (unsigned)D + col) = w; }
                if (m & 1) EPI_FENCE(); }
    }
};
struct EpiInProj {
    static constexpr bool PERM = true, MIDK = false;
    bf16_t* O; const float* cosT; const float* sinT; const float* lb; int row_base; const float* ssq; LAS unsigned char* lds;
    DEVFN void pre(const Unit& u, int par, int tid) const { rinv_pre(ssq, lds, u.pm, par, tid); }
    DEVFN void operator()(const f32x4 (&acc)[2][2][4][2], const Unit& u, int wr, int wc, int fr, int fq, int par) const {
        const int pn = u.pn;
        const int mode = pn < 9 ? 0 : pn < 13 ? 1 : pn < 15 ? 0 : pn < 19 ? 2 : pn < 23 ? 3 : pn < 25 ? 0 : pn < 27 ? 2 : 4;
        const int row0 = u.pm * BM + wr * 64 + fr, col0 = pn * BM + wc * 32 + 8 * fq;
        f32x4 lbv[2][2];
#pragma unroll
        for (int bj = 0; bj < 2; ++bj) { const int lc = (col0 + bj * HALF - OFF_FCF) & 511; lbv[bj][0] = mode == 3 ? *(const f32x4*)(lb + lc) : (f32x4){0.f, 0.f, 0.f, 0.f}; lbv[bj][1] = mode == 3 ? *(const f32x4*)(lb + lc + 4) : (f32x4){0.f, 0.f, 0.f, 0.f}; }
#pragma unroll
        for (int ai = 0; ai < 2; ++ai) {
            f32x4 cq[4], sq[4];
#pragma unroll
            for (int m = 0; m < 4; ++m) { cq[m] = (f32x4){0.f, 0.f, 0.f, 0.f}; sq[m] = cq[m];
                if (mode == 1) { const int pos = pos_of(row_base + row0 + ai * HALF + m * 16); cq[m] = *(const f32x4*)(cosT + pos * 64 + 4 * (4 * wc + fq)); sq[m] = *(const f32x4*)(sinT + pos * 64 + 4 * (4 * wc + fq)); } }
            EPI_FENCE();
#pragma unroll
            for (int m = 0; m < 4; ++m) {
                const int row = row0 + ai * HALF + m * 16;
                bf16_t* rowp = O + (size_t)row * ZW + col0;
                const float ri = rinv_get(lds, par, ai * HALF + wr * 64 + m * 16 + fr);
                const f32x4 c4 = cq[m], s4 = sq[m];
#pragma unroll
                for (int bj = 0; bj < 2; ++bj) {
                    f32x4 v0 = acc[ai][bj][m][0] * ri, v1 = acc[ai][bj][m][1] * ri;
                    u32x4 w;
                    if (mode == 1) { const f32x4 o1 = v0 * c4 - v1 * s4, o2 = v0 * s4 + v1 * c4; v0 = o1; v1 = o2; }
                    else if (mode == 2) {
#pragma unroll
                        for (int j = 0; j < 4; ++j) { v0[j] = fsilu(v0[j]); v1[j] = fsilu(v1[j]); } }
                    else if (mode == 4) {
#pragma unroll
                        for (int j = 0; j < 4; ++j) { v0[j] = fsigmoid(v0[j]); v1[j] = fsigmoid(v1[j]); } }
                    if (mode == 3) {
                        const f32x4 l0 = lbv[bj][0], l1 = lbv[bj][1];
#pragma unroll
                        for (int j = 0; j < 4; ++j) { v0[j] = fmaxf(flog(l0[j] + (1.f - l0[j]) * fsigmoid(v0[j])), -30.f); v1[j] = fmaxf(flog(l1[j] + (1.f - l1[j]) * fsigmoid(v1[j])), -30.f); }
                        w.x = f2h(v0[0]) | (f2h(v0[1]) << 16); w.y = f2h(v0[2]) | (f2h(v0[3]) << 16); w.z = f2h(v1[0]) | (f2h(v1[1]) << 16); w.w = f2h(v1[2]) | (f2h(v1[3]) << 16);
                    } else { w.x = pk2(v0[0], v0[1]); w.y = pk2(v0[2], v0[3]); w.z = pk2(v1[0], v1[1]); w.w = pk2(v1[2], v1[3]); }
                    *(u32x4*)(rowp + bj * HALF) = w;
                }
                EPI_FENCE();
            }
        }
    }
};

#ifndef CPU_EMU
#define PG8_LAS __attribute__((address_space(3)))
template <class Epi, class Sched, bool ALIGN_EPI = true, bool SP2 = true>
__device__ __forceinline__ void gemm_phase(int w0, PG8_LAS unsigned char* lds, const Gemm g, const Sched S, const Epi E) {
    const int tid = opaque_tid(w0), wid = __builtin_amdgcn_readfirstlane(tid >> 6), lane = tid & 63, wr = wid >> 2, wc = wid & 3, fr = lane & 15, fq = lane >> 4;
    const int K = g.K, nt = K / BK;
    unsigned voffA[2], voffB[2];
#pragma unroll
    for (int i = 0; i < 2; ++i) { int R, C; stage_rc(tid * 16 + i * 8192, R, C); const int Rb = Epi::PERM ? ((R & ~31) + perm32(R & 31)) : R;
        voffA[i] = (unsigned)(R * g.lda + C) * 2u; voffB[i] = (unsigned)(Rb * g.ldb + C) * 2u; }
    const size_t kstep = (size_t)(BK * 2);
    const size_t hstepA = (size_t)HALF * g.lda * 2, hstepB = (size_t)HALF * g.ldb * 2;
    const size_t tstepA = 2 * hstepA, tstepB = 2 * hstepB;
    const unsigned ldsw = (unsigned)wid * 1024u;
    const int aoff = lds_byte(wr * 64 + fr, fq * 8), boff = lds_byte(wc * 32 + fr, fq * 8);
#define PG8_SA(b, h) (((b) * 2 + (h)) * HTB)
#define PG8_SB(b, h) ((4 + (b) * 2 + (h)) * HTB)
#define PG8_STAGE(bufoff, gbase, voff) do { _Pragma("unroll") for (int _i = 0; _i < 2; ++_i) \
        __builtin_amdgcn_global_load_lds((const unsigned*)((const char*)(gbase) + (voff)[_i]), (PG8_LAS unsigned*)(lds + (bufoff) + ldsw + _i * 8192), 16, 0, 0); } while (0)
#define PG8_LDA(dst, b, h) do { _Pragma("unroll") for (int m = 0; m < 4; ++m) _Pragma("unroll") for (int k = 0; k < 2; ++k) dst[m][k] = *(const PG8_LAS bf16x8*)(lds + PG8_SA(b, h) + aoff + m * 2048 + k * 1024); } while (0)
#define PG8_LDB(dst, b, h) do { _Pragma("unroll") for (int n = 0; n < 2; ++n) _Pragma("unroll") for (int k = 0; k < 2; ++k) dst[n][k] = *(const PG8_LAS bf16x8*)(lds + PG8_SB(b, h) + boff + n * 2048 + k * 1024); } while (0)
#define PG8_MMA(ai, bj, At, Bt) do { __builtin_amdgcn_s_setprio(1); _Pragma("unroll") for (int m = 0; m < 4; ++m) _Pragma("unroll") for (int n = 0; n < 2; ++n) _Pragma("unroll") for (int k = 0; k < 2; ++k) \
        acc[ai][bj][m][n] = __builtin_amdgcn_mfma_f32_16x16x32_bf16(Bt[n][k], At[m][k], acc[ai][bj][m][n], 0, 0, 0); __builtin_amdgcn_s_setprio(0); } while (0)
#define PG8_WAIT_V(n) asm volatile("s_waitcnt vmcnt(" #n ")" ::: "memory")
#define PG8_WAIT_L(n) asm volatile("s_waitcnt lgkmcnt(" #n ")" ::: "memory")
#define PG8_BAR __builtin_amdgcn_s_barrier()
#define PG8_SCHED __builtin_amdgcn_sched_barrier(0)
    Unit cur, nxt; int ui = 0;
    if (!S.next(0, cur)) return;
    f32x4 acc[2][2][4][2];
#pragma unroll
    for (int a = 0; a < 2; ++a)
#pragma unroll
        for (int b = 0; b < 2; ++b)
#pragma unroll
            for (int m = 0; m < 4; ++m)
#pragma unroll
                for (int n = 0; n < 2; ++n) acc[a][b][m][n] = (f32x4){0.f, 0.f, 0.f, 0.f};
    bf16x8 At[4][2], B0[2][2], B1[2][2];
    const char* cA = (const char*)g.A + (size_t)cur.pm * tstepA; const char* cB = (const char*)g.Bt + (size_t)cur.pn * tstepB;
    S.a_ready(cur);
    E.pre(cur, 0, wid * 64 + lane_id_v());
    if constexpr (SP2) {
        PG8_STAGE(PG8_SB(0, 0), cB, voffB); PG8_STAGE(PG8_SB(0, 1), cB + hstepB, voffB); PG8_STAGE(PG8_SA(0, 0), cA, voffA); PG8_STAGE(PG8_SA(0, 1), cA + hstepA, voffA);
        if (wr == 1) PG8_BAR;
        PG8_WAIT_V(2); PG8_BAR;
        PG8_STAGE(PG8_SB(1, 0), cB + kstep, voffB); PG8_STAGE(PG8_SA(1, 0), cA + kstep, voffA); PG8_STAGE(PG8_SB(1, 1), cB + hstepB + kstep, voffB);
        PG8_WAIT_V(6); PG8_BAR;
    } else {
        PG8_STAGE(PG8_SB(0, 0), cB, voffB); PG8_STAGE(PG8_SA(0, 0), cA, voffA); PG8_STAGE(PG8_SB(0, 1), cB + hstepB, voffB); PG8_STAGE(PG8_SA(0, 1), cA + hstepA, voffA);
        if (wr == 1) PG8_BAR;
        PG8_WAIT_V(4); PG8_BAR;
        PG8_STAGE(PG8_SB(1, 0), cB + kstep, voffB); PG8_STAGE(PG8_SA(1, 0), cA + kstep, voffA); PG8_STAGE(PG8_SB(1, 1), cB + hstepB + kstep, voffB);
        PG8_WAIT_V(6); PG8_BAR;
    }
    for (;;) {
        const bool has_next = S.next(ui + 1, nxt);
        const char* nA = has_next ? (const char*)g.A + (size_t)nxt.pm * tstepA : cA; const char* nB = has_next ? (const char*)g.Bt + (size_t)nxt.pn * tstepB : cB;
        constexpr int NSEG = Epi::MIDK ? 3 : 1;
#pragma nounroll
        for (int seg = 0; seg < NSEG; ++seg) {
        const int tb = Epi::MIDK ? (seg == 0 ? 0 : (seg == 1 ? 4 : 12)) : 0, te = Epi::MIDK ? (seg == 0 ? 4 : (seg == 1 ? 12 : nt)) : nt;
#pragma nounroll
        for (int t = tb; t < te; t += 2) {
            const bool last = (t == nt - 2);
            const char* a1 = cA + (size_t)(t + 1) * kstep;
            const char* a2 = last ? nA : cA + (size_t)(t + 2) * kstep; const char* b2 = last ? nB : cB + (size_t)(t + 2) * kstep;
            const char* a3 = a2 + kstep; const char* b3 = b2 + kstep;
            if (last && has_next) S.a_ready(nxt);
            if constexpr (SP2) {
            PG8_LDB(B0, 0, 0); PG8_LDB(B1, 0, 1); PG8_SCHED; PG8_LDA(At, 0, 0); PG8_STAGE(PG8_SA(1, 1), a1 + hstepA, voffA);
            PG8_WAIT_V(8); PG8_WAIT_L(0); PG8_BAR; PG8_MMA(0, 0, At, B0); PG8_MMA(0, 1, At, B1); PG8_BAR; PG8_SCHED;
            PG8_LDA(At, 0, 1); PG8_STAGE(PG8_SB(0, 0), b2, voffB); PG8_STAGE(PG8_SB(0, 1), b2 + hstepB, voffB); PG8_STAGE(PG8_SA(0, 0), a2, voffA);
            PG8_WAIT_V(8); PG8_WAIT_L(0); PG8_BAR; PG8_MMA(1, 0, At, B0); PG8_MMA(1, 1, At, B1); PG8_BAR; PG8_SCHED;
            PG8_LDB(B0, 1, 0); PG8_LDB(B1, 1, 1); PG8_SCHED; PG8_LDA(At, 1, 0); PG8_STAGE(PG8_SA(0, 1), a2 + hstepA, voffA);
            PG8_WAIT_V(8); PG8_WAIT_L(0); PG8_BAR; PG8_MMA(0, 0, At, B0); PG8_MMA(0, 1, At, B1); PG8_BAR; PG8_SCHED;
            PG8_LDA(At, 1, 1); PG8_STAGE(PG8_SB(1, 0), b3, voffB); PG8_STAGE(PG8_SB(1, 1), b3 + hstepB, voffB); PG8_STAGE(PG8_SA(1, 0), a3, voffA);
            PG8_WAIT_V(8); PG8_WAIT_L(0); PG8_BAR; PG8_MMA(1, 0, At, B0); PG8_MMA(1, 1, At, B1); PG8_BAR; PG8_SCHED;
            } else {
            PG8_LDB(B0, 0, 0); PG8_SCHED; PG8_LDA(At, 0, 0); PG8_STAGE(PG8_SA(1, 1), a1 + hstepA, voffA);
            PG8_WAIT_L(8); PG8_BAR; PG8_WAIT_L(0); PG8_MMA(0, 0, At, B0); PG8_BAR; PG8_SCHED;
            PG8_LDB(B1, 0, 1); PG8_STAGE(PG8_SB(0, 0), b2, voffB);
            PG8_BAR; PG8_WAIT_L(0); PG8_MMA(0, 1, At, B1); PG8_BAR;
            PG8_LDA(At, 0, 1); PG8_STAGE(PG8_SA(0, 0), a2, voffA);
            PG8_BAR; PG8_WAIT_L(0); PG8_MMA(1, 0, At, B0); PG8_BAR; PG8_SCHED;
            PG8_STAGE(PG8_SB(0, 1), b2 + hstepB, voffB);
            PG8_WAIT_V(6); PG8_BAR; PG8_MMA(1, 1, At, B1); PG8_BAR;
            PG8_LDB(B0, 1, 0); PG8_SCHED; PG8_LDA(At, 1, 0); PG8_STAGE(PG8_SA(0, 1), a2 + hstepA, voffA);
            PG8_WAIT_L(8); PG8_BAR; PG8_WAIT_L(0); PG8_MMA(0, 0, At, B0); PG8_BAR; PG8_SCHED;
            PG8_LDB(B1, 1, 1); PG8_STAGE(PG8_SB(1, 0), b3, voffB);
            PG8_BAR; PG8_WAIT_L(0); PG8_MMA(0, 1, At, B1); PG8_BAR;
            PG8_LDA(At, 1, 1); PG8_STAGE(PG8_SA(1, 0), a3, voffA);
            PG8_BAR; PG8_WAIT_L(0); PG8_MMA(1, 0, At, B0); PG8_BAR; PG8_SCHED;
            PG8_STAGE(PG8_SB(1, 1), b3 + hstepB, voffB);
            PG8_WAIT_V(6); PG8_BAR; PG8_MMA(1, 1, At, B1); PG8_BAR;
            }
        }
        if constexpr (Epi::MIDK) { if (seg < 2) E.mid(acc, cur, wr, wc, fr, fq, seg); }
        }
        if constexpr (ALIGN_EPI) { if (wr == 0) PG8_BAR; }
        E(acc, cur, wr, wc, fr, fq, ui & 1); S.done(cur);
        if (!has_next) break;
        E.pre(nxt, (ui + 1) & 1, wid * 64 + lane_id_v());
#pragma unroll
        for (int a = 0; a < 2; ++a)
#pragma unroll
            for (int b = 0; b < 2; ++b)
#pragma unroll
                for (int m = 0; m < 4; ++m)
#pragma unroll
                    for (int n = 0; n < 2; ++n) acc[a][b][m][n] = (f32x4){0.f, 0.f, 0.f, 0.f};
        cur = nxt; cA = nA; cB = nB; ++ui;
        if constexpr (ALIGN_EPI) { if (wr == 1) PG8_BAR; }
    }
    PG8_WAIT_V(0);
    if constexpr (!ALIGN_EPI) { if (wr == 0) PG8_BAR; }
    PG8_BAR;
#undef PG8_SA
#undef PG8_SB
#undef PG8_STAGE
#undef PG8_LDA
#undef PG8_LDB
#undef PG8_MMA
#undef PG8_WAIT_V
#undef PG8_WAIT_L
#undef PG8_BAR
#undef PG8_SCHED
}
#else
template <class Epi, class Sched, bool ALIGN_EPI = true, bool SP2 = true>
void gemm_phase(int w0, unsigned char* lds, const Gemm g, const Sched& S, const Epi& E) {
    (void)lds; const int tid = opaque_tid(w0), wid = tid >> 6, lane = tid & 63, wr = wid >> 2, wc = wid & 3, fr = lane & 15, fq = lane >> 4;
    Unit cur;
    for (int ui = 0; S.next(ui, cur); ++ui) {
        E.pre(cur, ui & 1, tid); __syncthreads();
        f32x4 acc[2][2][4][2];
        for (int ai = 0; ai < 2; ++ai) for (int bj = 0; bj < 2; ++bj) for (int m = 0; m < 4; ++m) for (int n = 0; n < 2; ++n) for (int j = 0; j < 4; ++j) {
            const int row = 256 * cur.pm + 128 * ai + 64 * wr + 16 * m + fr;
            const int col = Epi::PERM ? 256 * cur.pn + 128 * bj + 32 * wc + 8 * fq + 4 * n + j : 256 * cur.pn + 128 * bj + 32 * wc + 16 * n + 4 * fq + j;
            acc[ai][bj][m][n][j] = 0.f; }
        const int nseg = Epi::MIDK ? 3 : 1; const int kb[4] = {0, Epi::MIDK ? 256 : g.K, 768, g.K};
        for (int sg = 0; sg < nseg; ++sg) {
            for (int ai = 0; ai < 2; ++ai) for (int bj = 0; bj < 2; ++bj) for (int m = 0; m < 4; ++m) for (int n = 0; n < 2; ++n) for (int j = 0; j < 4; ++j) {
                const int row = 256 * cur.pm + 128 * ai + 64 * wr + 16 * m + fr;
                const int col = Epi::PERM ? 256 * cur.pn + 128 * bj + 32 * wc + 8 * fq + 4 * n + j : 256 * cur.pn + 128 * bj + 32 * wc + 16 * n + 4 * fq + j;
                const bf16_t* a = g.A + (size_t)row * g.lda; const bf16_t* b = g.Bt + (size_t)col * g.ldb; float s = 0.f;
                for (int k = kb[sg]; k < kb[sg + 1]; ++k) s += bf2f(a[k]) * bf2f(b[k]);
                acc[ai][bj][m][n][j] += s; }
            if constexpr (Epi::MIDK) { if (sg < 2) E.mid(acc, cur, wr, wc, fr, fq, sg); }
        }
        E(acc, cur, wr, wc, fr, fq, ui & 1);
    }
}
#endif
}

#ifndef CPU_EMU
#define XB_TMO      128
#define XB_XCNT(j)  (256  + 64 * (j))
#define XB_XSUB(j)  (1280 + 64 * (j))
#define XB_XGEN(j)  (2304 + 64 * (j))
#define XB_TOP      3328
#define XB_TOPGEN   3392
#define XCD_BAR_WORDS 3456
#define XB_SPIN_CAP (1u << 22)
__device__ __forceinline__ unsigned xb_ld(unsigned* p)              { return __hip_atomic_load(p, __ATOMIC_RELAXED, __HIP_MEMORY_SCOPE_AGENT); }
__device__ __forceinline__ unsigned xb_add(unsigned* p, unsigned v) { return __hip_atomic_fetch_add(p, v, __ATOMIC_RELAXED, __HIP_MEMORY_SCOPE_AGENT); }
__device__ __forceinline__ unsigned xb_xcc_id() { return (unsigned)__builtin_amdgcn_s_getreg((3 << 11) | 20) & 0xFu; }
#define XB_SPIN(cond, bar) do { unsigned _sp = 0; while (cond) { __builtin_amdgcn_s_sleep(1); \
    if ((++_sp & 255u) == 0u) { if (xb_ld(&(bar)[XB_TMO])) break; if (_sp > XB_SPIN_CAP) { atomicAdd(&(bar)[XB_TMO], 1u); break; } } } } while (0)
struct XcdBarrier { unsigned* bar; unsigned x; volatile LAS unsigned* st; };
__device__ __forceinline__ XcdBarrier xcd_barrier_post(unsigned* bar, volatile LAS unsigned* st) {
    XcdBarrier b; b.bar = bar; b.x = xb_xcc_id(); b.st = st;
    if (threadIdx.x == 0) (void)xb_add(&bar[XB_XCNT(b.x)], 1u);
    return b;
}
__device__ __forceinline__ void xcd_barrier_complete(unsigned* bar, unsigned x, unsigned& nloc, unsigned& nx) {
    const unsigned G = gridDim.x * gridDim.y * gridDim.z;
    unsigned sum, cnt, mine, sp = 0u;
    for (;;) {
        sum = 0u; cnt = 0u; mine = 0u;
#pragma unroll
        for (unsigned j = 0; j < 16; ++j) { const unsigned c = xb_ld(&bar[XB_XCNT(j)]); sum += c; cnt += (c > 0u) ? 1u : 0u; mine = (j == x) ? c : mine; }
        if (sum == G) break;
        __builtin_amdgcn_s_sleep(1);
        if ((++sp & 255u) == 0u) { if (xb_ld(&bar[XB_TMO])) break; if (sp > XB_SPIN_CAP) { atomicAdd(&bar[XB_TMO], 1u); break; } }
    }
    nloc = mine > 0u ? mine : 1u; nx = cnt > 0u ? cnt : 1u;
}
__device__ __forceinline__ void xcd_barrier(const XcdBarrier& b, int w0) {
    asm volatile("s_waitcnt vmcnt(0)" ::: "memory");
    __syncthreads();
    if (w0 == 0 && lane_id_v() == 0) {
        unsigned* bar = b.bar;
        __builtin_amdgcn_s_waitcnt(0);
        unsigned nloc = b.st[0], nx = b.st[1];
        if (nloc == 0u) { xcd_barrier_complete(bar, b.x, nloc, nx); b.st[0] = nloc; b.st[1] = nx; }
        const unsigned old = xb_add(&bar[XB_XSUB(b.x)], 1u);
        const unsigned gen = old / nloc;
        if (old + 1u == (gen + 1u) * nloc) {
            __builtin_amdgcn_fence(__ATOMIC_RELEASE, "agent");
            asm volatile("s_waitcnt vmcnt(0)" ::: "memory");
            const unsigned og = xb_add(&bar[XB_TOP], 1u);
            const unsigned tg = og / nx;
            if (og + 1u == (tg + 1u) * nx) xb_add(&bar[XB_TOPGEN], 1u);
            else XB_SPIN(xb_ld(&bar[XB_TOPGEN]) == tg, bar);
            __builtin_amdgcn_fence(__ATOMIC_ACQUIRE, "agent");
            xb_add(&bar[XB_XGEN(b.x)], 1u);
            asm volatile("s_waitcnt vmcnt(0)" ::: "memory");
        } else {
            XB_SPIN(xb_ld(&bar[XB_XGEN(b.x)]) == gen, bar);
            __builtin_amdgcn_fence(__ATOMIC_ACQUIRE, "agent");
            asm volatile("s_waitcnt vmcnt(0)" ::: "memory");
        }
    }
    __syncthreads();
}
#endif

enum { I_XP = 0, I_XS, I_PP, I_PS, I_F1N, I_F1G, I_F1U, I_F1D, I_MIXN, I_WIN, I_RELB, I_RETN, I_HLB, I_HGN, I_WBA, I_WBB, I_WBC, I_WMG, I_WOUT, I_F2N, I_F2G, I_F2U, I_F2D, I_PLEN, I_WPG, I_WPP, I_FINN, N_INPUTS };
struct Args { const float* in[N_INPUTS]; float* out; unsigned char* ws; int lo, hi; };

DEVFN float wave_sum(float v) {
#pragma unroll
    for (int o = 1; o < 64; o <<= 1) v += __shfl_xor(v, o);
    return v;
}
DEVFN void init_rows(const Args& a, float* h, bf16_t* XN2, float* ssq0, int gw, int ngw, int lane) {
    constexpr int NC = D / 256;
    for (int row = gw; row < T; row += ngw) {
        const float* src = row < NP ? a.in[I_XP] + (size_t)row * D : a.in[I_XS] + (size_t)(row - NP) * D;
        f32x4 v[NC]; float s = 0.f;
#pragma unroll
        for (int j = 0; j < NC; ++j) { v[j] = *(const f32x4*)(src + 4 * (lane + 64 * j)); s += (v[j][0] * v[j][0] + v[j][1] * v[j][1]) + (v[j][2] * v[j][2] + v[j][3] * v[j][3]); }
        s = wave_sum(s);
#pragma unroll
        for (int j = 0; j < NC; ++j) { const int c = 4 * (lane + 64 * j); *(f32x4*)(h + (size_t)row * D + c) = v[j]; *(u32x2*)(XN2 + (size_t)row * D + c) = pk4(v[j]); }
        if (lane == 0) *(f32x4*)(ssq0 + 4 * (size_t)row) = (f32x4){s, 0.f, 0.f, 0.f};
    }
}
DEVFN void final_norm_rows(float* h, const float* gfin, int gw, int ngw, int lane) {
    constexpr int NC = D / 256;
    for (int row = gw; row < T; row += ngw) {
        f32x4 v[NC]; float s = 0.f;
#pragma unroll
        for (int j = 0; j < NC; ++j) { v[j] = *(const f32x4*)(h + (size_t)row * D + 4 * (lane + 64 * j)); s += (v[j][0] * v[j][0] + v[j][1] * v[j][1]) + (v[j][2] * v[j][2] + v[j][3] * v[j][3]); }
        const float rinv = rms_rinv(wave_sum(s));
#pragma unroll
        for (int j = 0; j < NC; ++j) { const int c = 4 * (lane + 64 * j); const f32x4 gq = *(const f32x4*)(gfin + c); *(f32x4*)(h + (size_t)row * D + c) = v[j] * rinv * gq; }
    }
}
DEVFN void cvt_ple(const Args& a, int l, bf16_t* PB, int gtid, int nthr) {
    for (size_t it = gtid; it < (size_t)T * D_PLE / 8; it += nthr) {
        const size_t e = it * 8; const int row = (int)(e / D_PLE), c = (int)(e % D_PLE);
        const float* src = row < NP ? a.in[I_PP] + ((size_t)l * NP + row) * D_PLE + c : a.in[I_PS] + ((size_t)l * NS + (row - NP)) * D_PLE + c;
        const f32x4 x = *(const f32x4*)src, y = *(const f32x4*)(src + 4);
        u32x4 w; w.x = pk2(x[0], x[1]); w.y = pk2(x[2], x[3]); w.z = pk2(y[0], y[1]); w.w = pk2(y[2], y[3]);
        *(u32x4*)(PB + e) = w;
    }
}
DEVFN int t5_bucket(int rel) {
    const int ret = rel > 0 ? 16 : 0; const int n = rel < 0 ? -rel : rel;
    if (n < 8) return ret + n;
    int large = 8 + (int)(logf((float)n / 8.0f) / logf(128.0f) * 8.0f);
    large = large < 15 ? large : 15;
    return ret + large;
}
DEVFN void prologue_tables(const Args& a, float* rope, float* biasT, float* lbs, int gtid, int nthr) {
    for (int it = gtid; it < 4096 * 64; it += nthr) { const int pos = it >> 6, i = it & 63;
        const float inv = powf(10000.0f, -(float)i / 64.0f); const float ang = (float)pos * inv;
        rope[it] = cosf(ang); rope[4096 * 64 + it] = sinf(ang); }
    for (int it = gtid; it < 3 * 4 * 160; it += nthr) { const int idx = it % 160, gh = it / 160, g = gh >> 2, hh = gh & 3; const int o = idx - 16; const int dil = g == 0 ? 1 : (g == 1 ? 4 : 16);
        biasT[it] = (o >= 0 && o <= 128) ? a.in[I_RELB][t5_bucket((o - 64) * dil) * 12 + 4 * g + hh] : -1e30f; }
    for (int c = gtid; c < 512; c += nthr) {
        float mx = -3.0e38f; for (int l = 0; l < DEPTH; ++l) mx = fmaxf(mx, a.in[I_HLB][l * 512 + c]);
        float den = 0.f; for (int l = 0; l < DEPTH; ++l) den += expf(a.in[I_HLB][l * 512 + c] - mx);
        float cum = 0.f, first = 0.f;
        for (int l = 0; l < DEPTH; ++l) { cum += expf(a.in[I_HLB][l * 512 + c] - mx) / den; if (l == 0) first = cum; lbs[l * 512 + c] = cum - first; }
    }
}
DEVFN int rowmap(int mode, int nl) {
    if (mode == 1) return (nl >> 7) * 256 + (nl & 127);
    if (mode == 2) return (nl >> 7) * 256 + 128 + (nl & 127);
    if (mode == 3) { const int dl = nl & 127, nn = dl >> 6, rem = dl & 63; return (nl & ~127) + 8 * (rem >> 2) + 4 * nn + (rem & 3); }
    return nl;
}
struct CvtDesc { const float* W; int K, ldw, col0, ncols; bf16_t* dst; int ldd, koff, mode, row_off; const float* gain; float cscale; };
DEVFN void cvt_item(const CvtDesc& d, int item, LAS float* scr, int lane) {
    const int nblk = d.ncols / 32, kb = item / nblk, nb = item % nblk, k0 = 64 * kb, n0 = 32 * nb;
#pragma unroll 8
    for (int i = 0; i < 32; ++i) { const int kk = 2 * i + (lane >> 5); const float gsc = (d.gain ? d.gain[k0 + kk] : 1.0f) * d.cscale;
        scr[kk * 33 + (lane & 31)] = d.W[(size_t)(k0 + kk) * d.ldw + d.col0 + n0 + (lane & 31)] * gsc; }
    __builtin_amdgcn_wave_barrier();
    const int c = lane & 7;
#pragma unroll
    for (int j = 0; j < 4; ++j) { const int n = (lane >> 3) + 8 * j; const LAS float* s = scr + (8 * c) * 33 + n;
        u32x4 o; o.x = pk2(s[0 * 33], s[1 * 33]); o.y = pk2(s[2 * 33], s[3 * 33]); o.z = pk2(s[4 * 33], s[5 * 33]); o.w = pk2(s[6 * 33], s[7 * 33]);
        *(u32x4*)(d.dst + (size_t)(d.row_off + rowmap(d.mode, n0 + n)) * d.ldd + d.koff + k0 + 8 * c) = o; }
    __builtin_amdgcn_wave_barrier();
}
constexpr int N_CVT = 18;
DEVFN CvtDesc cvt_desc(const Args& a, int l, bf16_t* WB, int i) {
    CvtDesc d; d.col0 = 0; d.koff = 0; d.mode = 0; d.row_off = 0; d.gain = nullptr; d.cscale = 1.0f;
    const float* win = a.in[I_WIN] + (size_t)l * D * N_IN;
    switch (i) {
    case 0: d.W = a.in[I_F1G] + (size_t)l * D * FF; d.K = D; d.ldw = FF; d.ncols = FF; d.dst = WB + WE_GU1; d.ldd = D; d.mode = 1; d.gain = a.in[I_F1N] + l * D; break;
    case 1: d.W = a.in[I_F1U] + (size_t)l * D * FF; d.K = D; d.ldw = FF; d.ncols = FF; d.dst = WB + WE_GU1; d.ldd = D; d.mode = 2; d.gain = a.in[I_F1N] + l * D; break;
    case 2: d.W = a.in[I_F1D] + (size_t)l * FF * D; d.K = FF; d.ldw = D; d.ncols = D; d.dst = WB + WE_D1; d.ldd = FF; break;
    case 3: d.W = win; d.K = D; d.ldw = N_IN; d.col0 = 0; d.ncols = 768; d.dst = WB + WE_IN; d.ldd = D; d.gain = a.in[I_MIXN] + l * D; d.cscale = 0.125f; break;
    case 4: d.W = win; d.K = D; d.ldw = N_IN; d.col0 = 768; d.ncols = 1536; d.dst = WB + WE_IN; d.ldd = D; d.row_off = 768; d.gain = a.in[I_MIXN] + l * D; break;
    case 5: d.W = win; d.K = D; d.ldw = N_IN; d.col0 = OFF_QB; d.ncols = 512; d.dst = WB + WE_IN; d.ldd = D; d.row_off = OFF_QB; d.mode = 3; d.gain = a.in[I_MIXN] + l * D; break;
    case 6: d.W = win; d.K = D; d.ldw = N_IN; d.col0 = OFF_KB; d.ncols = 512; d.dst = WB + WE_IN; d.ldd = D; d.row_off = OFF_KB; d.mode = 3; d.gain = a.in[I_MIXN] + l * D; d.cscale = 0.08838834764831845f; break;
    case 7: d.W = win; d.K = D; d.ldw = N_IN; d.col0 = OFF_VB; d.ncols = N_IN - OFF_VB; d.dst = WB + WE_IN; d.ldd = D; d.row_off = OFF_VB; d.gain = a.in[I_MIXN] + l * D; break;
    case 8: d.W = a.in[I_WMG] + (size_t)l * D * 3 * D; d.K = D; d.ldw = 3 * D; d.ncols = 3 * D; d.dst = WB + WE_IN; d.ldd = D; d.row_off = OFF_MG; d.gain = a.in[I_MIXN] + l * D; break;
    case 9: d.W = a.in[I_WBA] + (size_t)l * 256 * D; d.K = 256; d.ldw = D; d.ncols = D; d.dst = WB + WE_BR; d.ldd = MIXW; d.koff = 0; break;
    case 10: d.W = a.in[I_WBB] + (size_t)l * 512 * D; d.K = 512; d.ldw = D; d.ncols = D; d.dst = WB + WE_BR; d.ldd = MIXW; d.koff = 256; break;
    case 11: d.W = a.in[I_WBC] + (size_t)l * 512 * D; d.K = 512; d.ldw = D; d.ncols = D; d.dst = WB + WE_BR; d.ldd = MIXW; d.koff = 768; break;
    case 12: d.W = a.in[I_WOUT] + (size_t)l * D * D; d.K = D; d.ldw = D; d.ncols = D; d.dst = WB + WE_OUT; d.ldd = D; break;
    case 13: d.W = a.in[I_F2G] + (size_t)l * D * FF; d.K = D; d.ldw = FF; d.ncols = FF; d.dst = WB + WE_GU2; d.ldd = D; d.mode = 1; d.gain = a.in[I_F2N] + l * D; break;
    case 14: d.W = a.in[I_F2U] + (size_t)l * D * FF; d.K = D; d.ldw = FF; d.ncols = FF; d.dst = WB + WE_GU2; d.ldd = D; d.mode = 2; d.gain = a.in[I_F2N] + l * D; break;
    case 15: d.W = a.in[I_F2D] + (size_t)l * FF * D; d.K = FF; d.ldw = D; d.ncols = D; d.dst = WB + WE_D2; d.ldd = FF; break;
    case 16: d.W = a.in[I_WPG] + (size_t)l * D * D; d.K = D; d.ldw = D; d.ncols = D; d.dst = WB + WE_PG; d.ldd = D; d.gain = a.in[I_PLEN] + l * D; break;
    default: d.W = a.in[I_WPP] + (size_t)l * D_PLE * D; d.K = D_PLE; d.ldw = D; d.ncols = D; d.dst = WB + WE_PP; d.ldd = D_PLE; break;
    }
    return d;
}
DEVFN void convert_weights(const Args& a, int l, bf16_t* WB, LAS unsigned char* lds, int gw, int ngw, int wave, int lane) {
    LAS float* scr = (LAS float*)(lds + wave * 8704);
    for (int i = 0; i < N_CVT; ++i) {
        const CvtDesc d = cvt_desc(a, l, WB, i);
        const int nitems = (d.K / 64) * (d.ncols / 32);
        for (int it = gw; it < nitems; it += ngw) cvt_item(d, it, scr, lane);
    }
}

#ifndef CPU_EMU
DEVFN s16x4 lds_tr(const LAS bf16_t* p) { return __builtin_amdgcn_ds_read_tr16_b64_v4i16((LAS s16x4*)p); }
#else
s16x4 lds_tr(const bf16_t* p);
#endif
DEVFN bf16x8 tr8(const LAS bf16_t* X, int stride, int r0, int col0, int c16, int g4) {
    const LAS bf16_t* p = X + (r0 + 8 * g4 + (c16 >> 2)) * stride + col0 + 4 * (c16 & 3);
    return cat8(lds_tr(p), lds_tr(p + 4 * stride));
}
DEVFN bf16x8 tr8p(const LAS bf16_t* X, int stride, int r0, int col0, int c16, int g4) {
    const LAS bf16_t* p = X + (r0 + 4 * g4 + (c16 >> 2)) * stride + col0 + 4 * (c16 & 3);
    return cat8(lds_tr(p), lds_tr(p + 16 * stride));
}
DEVFN u32x4 scale8(u32x4 v, float s) {
    u32x4 o; o.x = pk2(bflo(v.x) * s, bfhi(v.x) * s); o.y = pk2(bflo(v.y) * s, bfhi(v.y) * s); o.z = pk2(bflo(v.z) * s, bfhi(v.z) * s); o.w = pk2(bflo(v.w) * s, bfhi(v.w) * s); return o;
}
template <class U> DEVFN void run_units(LAS unsigned char* lds, const U& ctx, int u0, int u1) {
    if (u0 >= u1) return;
    typename U::Regs L = ctx.load(u0);
    for (int u = u0; u < u1; ++u) {
        __syncthreads();
        ctx.stage(lds, L);
        const typename U::Regs N = ctx.load(u + 1 < u1 ? u + 1 : u);
        __syncthreads();
        ctx.compute(lds, L, u);
        L = N;
    }
}

template <class U> DEVFN void run_units2(LAS unsigned char* lds, const U& ctx, int u0, int u1) {
    if (u0 >= u1) return;
    typename U::Regs L; ctx.load1(L, u0); ctx.load2(L, u0);
    for (int u = u0; u < u1; ++u) {
        __syncthreads();
        ctx.stage(lds, L);
        typename U::Regs N; const int nu = u + 1 < u1 ? u + 1 : u;
        ctx.load1(N, nu);
        __syncthreads();
        ctx.compute(lds, L, u, N, nu);
        L = N;
    }
}
struct AUnit {
    const bf16_t* Z; bf16_t* AO; float* LSE; const float* biasT; int S; int w0;
    struct Regs { u32x4 kv[4], vv[4]; bf16x8 bq[2]; f32x4 b; };
    struct Idx { int hh, g, dil, L, cb, head, rowbase, k0; };
    DEVFN Idx decode(int unit) const {
        Idx x; const int upb = S / 128; const int ub = unit % upb; int t = unit / upb; x.hh = t & 3; t >>= 2; x.g = t % 3; const int seq = t / 3;
        x.dil = x.g == 0 ? 1 : (x.g == 1 ? 4 : 16); x.L = S / x.dil; const int bpr = x.L / 128; const int r = ub / bpr; x.cb = ub % bpr;
        x.head = 4 * x.g + x.hh; x.rowbase = seq * S + r; x.k0 = 128 * x.cb - 64; return x;
    }
    DEVFN Regs load(int unit) const {
        const int tid = opaque_tid(w0), lane = tid & 63, w = tid >> 6, c16 = lane & 15, g4 = lane >> 4; const Idx x = decode(unit); Regs R;
#pragma unroll
        for (int i = 0; i < 4; ++i) {
            const int id = tid + 512 * i, key = id >> 3, ch = id & 7, ik = x.k0 + key;
            R.kv[i] = (u32x4){0u, 0u, 0u, 0u}; R.vv[i] = (u32x4){0u, 0u, 0u, 0u};
            if (ik >= 0 && ik < x.L) { const bf16_t* zr = Z + (size_t)(x.rowbase + ik * x.dil) * ZW + x.head * 64 + 8 * ch; R.kv[i] = *(const u32x4*)(zr + OFF_KA); R.vv[i] = *(const u32x4*)(zr + OFF_VA); }
        }
        R.b = (f32x4){tid < 160 ? biasT[(x.g * 4 + x.hh) * 160 + tid] : 0.f, 0.f, 0.f, 0.f};
        const size_t qrow = (size_t)(x.rowbase + (128 * x.cb + 16 * w + c16) * x.dil);
#pragma unroll
        for (int ks = 0; ks < 2; ++ks) R.bq[ks] = *(const bf16x8*)(Z + qrow * ZW + OFF_QA + x.head * 64 + 32 * ks + 8 * g4);
        return R;
    }
    DEVFN void stage(LAS unsigned char* lds, const Regs& R) const {
        const int tid = opaque_tid(w0);
        LAS bf16_t* Ks = (LAS bf16_t*)lds; LAS bf16_t* Vs = (LAS bf16_t*)(lds + 256 * 72 * 2); LAS float* bs = (LAS float*)(lds + 2 * 256 * 72 * 2);
#pragma unroll
        for (int i = 0; i < 4; ++i) { const int id = tid + 512 * i, key = id >> 3, ch = id & 7; *(LAS u32x4*)(Ks + key * 72 + 8 * ch) = R.kv[i]; *(LAS u32x4*)(Vs + key * 72 + 8 * ch) = R.vv[i]; }
        if (tid < 160) bs[tid] = R.b[0];
    }
    DEVFN void compute(LAS unsigned char* lds, const Regs& R, int unit) const {
        const int tid = opaque_tid(w0), lane = tid & 63, w = tid >> 6, c16 = lane & 15, g4 = lane >> 4; const Idx x = decode(unit);
        const LAS bf16_t* Ks = (const LAS bf16_t*)lds; const LAS bf16_t* Vs = (const LAS bf16_t*)(lds + 256 * 72 * 2); const LAS float* bs = (const LAS float*)(lds + 2 * 256 * 72 * 2);
        const size_t qrow = (size_t)(x.rowbase + (128 * x.cb + 16 * w + c16) * x.dil);
        f32x4 sc[9]; float mx = -3.0e38f;
#pragma unroll
        for (int kt = 0; kt < 9; ++kt) {
            f32x4 acc = {0.f, 0.f, 0.f, 0.f};
#pragma unroll
            for (int ks = 0; ks < 2; ++ks) acc = mfma16(*(const LAS bf16x8*)(Ks + (16 * (w + kt) + c16) * 72 + 32 * ks + 8 * g4), R.bq[ks], acc);
#pragma unroll
            for (int rr = 0; rr < 4; ++rr) {
                const int o = 16 * kt + 4 * g4 + rr - c16;
                const int ik = x.k0 + 16 * (w + kt) + 4 * g4 + rr;
                float s = acc[rr] + bs[o + 16];
                if (ik < 0 || ik >= x.L) s = -1e30f;
                acc[rr] = s; mx = fmaxf(mx, s);
            }
            sc[kt] = acc;
        }
        mx = fmaxf(mx, __shfl_xor(mx, 16)); mx = fmaxf(mx, __shfl_xor(mx, 32));
        float sum = 0.f;
#pragma unroll
        for (int kt = 0; kt < 9; ++kt)
#pragma unroll
            for (int rr = 0; rr < 4; ++rr) { const float p = fexp(sc[kt][rr] - mx); sc[kt][rr] = p; sum += p; }
        sum += __shfl_xor(sum, 16); sum += __shfl_xor(sum, 32);
        bf16x8 bp[5];
        const f32x4 zero4 = {0.f, 0.f, 0.f, 0.f};
#pragma unroll
        for (int pp = 0; pp < 5; ++pp) bp[pp] = pack8(sc[2 * pp], pp < 4 ? sc[2 * pp + 1] : zero4);
        const float inv = 1.0f / sum;
#pragma unroll
        for (int dt = 0; dt < 4; ++dt) {
            f32x4 acc = {0.f, 0.f, 0.f, 0.f};
#pragma unroll
            for (int pp = 0; pp < 5; ++pp) {
                const LAS bf16_t* p = Vs + (16 * (w + 2 * pp) + 4 * g4 + (c16 >> 2)) * 72 + 16 * dt + 4 * (c16 & 3);
                acc = mfma16(cat8(lds_tr(p), lds_tr(p + (pp < 4 ? 16 * 72 : 0))), bp[pp], acc);
            }
            *(u32x2*)(AO + qrow * AOW + x.head * 64 + 16 * dt + 4 * g4) = pk4(acc * inv);
        }
        if (g4 == 0) LSE[qrow * 12 + x.head] = mx + logf(sum);
    }
};
DEVFN void mixer_a_merge(const bf16_t* AO, const float* LSE, bf16_t* MIX, int gtid, int nthr) {
    for (int it = gtid; it < SLAB * 32; it += nthr) {
        const int row = it >> 5, hh = (it >> 3) & 3, c = it & 7;
        const float l0 = LSE[(size_t)row * 12 + hh], l1 = LSE[(size_t)row * 12 + 4 + hh], l2 = LSE[(size_t)row * 12 + 8 + hh];
        const float m = fmaxf(l0, fmaxf(l1, l2)); float w0 = fexp(l0 - m), w1 = fexp(l1 - m), w2 = fexp(l2 - m); const float inv = 1.0f / (w0 + w1 + w2); w0 *= inv; w1 *= inv; w2 *= inv;
        const u32x4 a0 = *(const u32x4*)(AO + (size_t)row * AOW + hh * 64 + 8 * c), a1 = *(const u32x4*)(AO + (size_t)row * AOW + (4 + hh) * 64 + 8 * c), a2 = *(const u32x4*)(AO + (size_t)row * AOW + (8 + hh) * 64 + 8 * c);
        u32x4 o;
        o.x = pk2(w0 * bflo(a0.x) + w1 * bflo(a1.x) + w2 * bflo(a2.x), w0 * bfhi(a0.x) + w1 * bfhi(a1.x) + w2 * bfhi(a2.x));
        o.y = pk2(w0 * bflo(a0.y) + w1 * bflo(a1.y) + w2 * bflo(a2.y), w0 * bfhi(a0.y) + w1 * bfhi(a1.y) + w2 * bfhi(a2.y));
        o.z = pk2(w0 * bflo(a0.z) + w1 * bflo(a1.z) + w2 * bflo(a2.z), w0 * bfhi(a0.z) + w1 * bfhi(a1.z) + w2 * bfhi(a2.z));
        o.w = pk2(w0 * bflo(a0.w) + w1 * bflo(a1.w) + w2 * bflo(a2.w), w0 * bfhi(a0.w) + w1 * bfhi(a1.w) + w2 * bfhi(a2.w));
        *(u32x4*)(MIX + (size_t)row * MIXW + hh * 64 + 8 * c) = o;
    }
}

struct BKvUnit {
    const bf16_t* Z; bf16_t* SB; int w0;
    struct Regs { u32x4 kv[4], vv[4]; };
    DEVFN Regs load(int unit) const {
        const int tid = opaque_tid(w0); const int h = unit & 3, row0 = (unit >> 2) * 128; Regs R;
#pragma unroll
        for (int i = 0; i < 4; ++i) { const int id = tid + 512 * i, j = id >> 4, ch = id & 15; const bf16_t* zr = Z + (size_t)(row0 + j) * ZW + h * 128 + 8 * ch; R.kv[i] = *(const u32x4*)(zr + OFF_KB); R.vv[i] = *(const u32x4*)(zr + OFF_VB); }
        return R;
    }
    DEVFN void stage(LAS unsigned char* lds, const Regs& R) const { (void)lds; (void)R; }
    DEVFN void compute(LAS unsigned char* lds, const Regs& R, int unit) const {
        const int tid = opaque_tid(w0), lane = tid & 63, w = tid >> 6, c16 = lane & 15, g4 = lane >> 4;
        const int h = unit & 3;
        LAS bf16_t* Ks = (LAS bf16_t*)lds;
        LAS bf16_t* Vf = (LAS bf16_t*)(lds + 128 * 136 * 2);
        LAS bf16_t* Vb = (LAS bf16_t*)(lds + 2 * 128 * 136 * 2);
        const float l2f = ret_l2(0, h), l2b = ret_l2(1, h);
#pragma unroll
        for (int i = 0; i < 4; ++i) {
            const int id = tid + 512 * i, j = id >> 4, ch = id & 15;
            *(LAS u32x4*)(Ks + j * 136 + 8 * ch) = R.kv[i];
            *(LAS u32x4*)(Vf + j * 136 + 8 * ch) = scale8(R.vv[i], exp2f((float)(127 - j) * l2f));
            *(LAS u32x4*)(Vb + j * 136 + 8 * ch) = scale8(R.vv[i], exp2f((float)j * l2b));
        }
        __syncthreads();
        bf16x8 af[4];
#pragma unroll
        for (int ks = 0; ks < 4; ++ks) af[ks] = tr8(Ks, 136, 32 * ks, 16 * w, c16, g4);
#pragma unroll
        for (int dir = 0; dir < 2; ++dir) {
            const LAS bf16_t* V = dir ? Vb : Vf;
            bf16_t* dst = SB + ((size_t)unit * 2 + dir) * 16384;
#pragma unroll
            for (int b = 0; b < 8; ++b) {
                f32x4 acc = {0.f, 0.f, 0.f, 0.f};
#pragma unroll
                for (int ks = 0; ks < 4; ++ks) acc = mfma16(af[ks], tr8(V, 136, 32 * ks, 16 * b, c16, g4), acc);
                *(u32x2*)(dst + (16 * b + c16) * 128 + 16 * w + 4 * g4) = pk4(acc);
            }
        }
    }
};
DEVFN void mixer_scan(bf16_t* SB, bf16_t* SC, const float* GC, int nseq, int S, int gtid, int nthr) {
    const int nb = S / 128, nc = S / 64;
    for (int it = gtid; it < nseq * 8 * 2048; it += nthr) {
        const int e8 = it & 2047; int t = it >> 11; const int dir = t & 1, h = (t >> 1) & 3, seq = t >> 3;
        const float G = exp2f(128.0f * ret_l2(dir, h));
        float carry[8];
#pragma unroll
        for (int j = 0; j < 8; ++j) carry[j] = 0.f;
        for (int cc = 0; cc < nb; ++cc) {
            const int c = dir ? nb - 1 - cc : cc;
            bf16_t* p = SB + ((size_t)((seq * nb + c) * 4 + h) * 2 + dir) * 16384 + e8 * 8;
            const u32x4 v = *(const u32x4*)p;
            u32x4 o; o.x = pk2(carry[0], carry[1]); o.y = pk2(carry[2], carry[3]); o.z = pk2(carry[4], carry[5]); o.w = pk2(carry[6], carry[7]);
            *(u32x4*)p = o;
            carry[0] = carry[0] * G + bflo(v.x); carry[1] = carry[1] * G + bfhi(v.x); carry[2] = carry[2] * G + bflo(v.y); carry[3] = carry[3] * G + bfhi(v.y);
            carry[4] = carry[4] * G + bflo(v.z); carry[5] = carry[5] * G + bfhi(v.z); carry[6] = carry[6] * G + bflo(v.w); carry[7] = carry[7] * G + bfhi(v.w);
        }
    }
    for (int it = gtid; it < nseq * 8 * 2048; it += nthr) {
        const int e8 = it & 2047; int t = it >> 11; const int dir = t & 1, h = (t >> 1) & 3, seq = t >> 3;
        const int dk0 = (e8 & 15) * 8;
        float carry[8];
#pragma unroll
        for (int j = 0; j < 8; ++j) carry[j] = 0.f;
        for (int cc = 0; cc < nc; ++cc) {
            const int c = dir ? nc - 1 - cc : cc;
            const size_t ui = (size_t)((seq * nc + c) * 4 + h) * 2 + dir;
            bf16_t* p = SC + ui * 16384 + e8 * 8;
            const f32x4 g0 = *(const f32x4*)(GC + ui * 128 + dk0), g1 = *(const f32x4*)(GC + ui * 128 + dk0 + 4);
            const u32x4 v = *(const u32x4*)p;
            u32x4 o; o.x = pk2(carry[0], carry[1]); o.y = pk2(carry[2], carry[3]); o.z = pk2(carry[4], carry[5]); o.w = pk2(carry[6], carry[7]);
            *(u32x4*)p = o;
            carry[0] = carry[0] * g0[0] + bflo(v.x); carry[1] = carry[1] * g0[1] + bfhi(v.x); carry[2] = carry[2] * g0[2] + bflo(v.y); carry[3] = carry[3] * g0[3] + bfhi(v.y);
            carry[4] = carry[4] * g1[0] + bflo(v.z); carry[5] = carry[5] * g1[1] + bfhi(v.z); carry[6] = carry[6] * g1[2] + bflo(v.w); carry[7] = carry[7] * g1[3] + bfhi(v.w);
        }
    }
}
struct BOutUnit {
    const bf16_t* Z; const bf16_t* SB; bf16_t* MIX; const float* gain; int w0;
    struct Regs { u32x4 kv[4], vv[4], sf[4], sb[4]; bf16x8 bq[4]; f32x4 gn; };
    DEVFN Regs load(int unit) const {
        const int tid = opaque_tid(w0), lane = tid & 63, w = tid >> 6, c16 = lane & 15, g4 = lane >> 4; const int h = unit & 3, row0 = (unit >> 2) * 128; Regs R;
        const bf16_t* gSf = SB + ((size_t)unit * 2 + 0) * 16384; const bf16_t* gSb = SB + ((size_t)unit * 2 + 1) * 16384;
#pragma unroll
        for (int i = 0; i < 4; ++i) {
            const int id = tid + 512 * i, j = id >> 4, ch = id & 15; const bf16_t* zr = Z + (size_t)(row0 + j) * ZW + h * 128 + 8 * ch;
            R.kv[i] = *(const u32x4*)(zr + OFF_KB); R.vv[i] = *(const u32x4*)(zr + OFF_VB); R.sf[i] = *(const u32x4*)(gSf + j * 128 + 8 * ch); R.sb[i] = *(const u32x4*)(gSb + j * 128 + 8 * ch);
        }
        const size_t row = (size_t)(row0 + 16 * w + c16);
#pragma unroll
        for (int ks = 0; ks < 4; ++ks) R.bq[ks] = *(const bf16x8*)(Z + row * ZW + OFF_QB + h * 128 + 32 * ks + 8 * g4);
        R.gn = (f32x4){gain[h * 128 + (tid & 127)], 0.f, 0.f, 0.f};
        return R;
    }
    DEVFN void stage(LAS unsigned char* lds, const Regs& R) const {
        const int tid = opaque_tid(w0);
        LAS bf16_t* Ks = (LAS bf16_t*)lds; LAS bf16_t* Vs = (LAS bf16_t*)(lds + 128 * 136 * 2); LAS bf16_t* Sf = (LAS bf16_t*)(lds + 2 * 128 * 136 * 2); LAS bf16_t* Sb = (LAS bf16_t*)(lds + 3 * 128 * 136 * 2);
#pragma unroll
        for (int i = 0; i < 4; ++i) { const int id = tid + 512 * i, j = id >> 4, ch = id & 15; const int o = j * 136 + 8 * ch;
            *(LAS u32x4*)(Ks + o) = R.kv[i]; *(LAS u32x4*)(Vs + o) = R.vv[i]; *(LAS u32x4*)(Sf + o) = R.sf[i]; *(LAS u32x4*)(Sb + o) = R.sb[i]; }
        if (tid < 128) ((LAS float*)(lds + 4 * 128 * 136 * 2))[tid] = R.gn[0];
    }
    DEVFN void compute(LAS unsigned char* lds, const Regs& R, int unit) const {
        const int tid = opaque_tid(w0), lane = tid & 63, w = tid >> 6, c16 = lane & 15, g4 = lane >> 4;
        const int h = unit & 3, row0 = (unit >> 2) * 128;
        const LAS bf16_t* Ks = (const LAS bf16_t*)lds;
        const LAS bf16_t* Vs = (const LAS bf16_t*)(lds + 128 * 136 * 2);
        const LAS bf16_t* Sf = (const LAS bf16_t*)(lds + 2 * 128 * 136 * 2);
        const LAS bf16_t* Sb = (const LAS bf16_t*)(lds + 3 * 128 * 136 * 2);
        const LAS float* gtab = (const LAS float*)(lds + 4 * 128 * 136 * 2);
        const float l2f = ret_l2(0, h), l2b = ret_l2(1, h);
        const int i = 16 * w + c16; const size_t row = (size_t)(row0 + i);
        u32x2 gwv[8];
#pragma unroll
        for (int dvt = 0; dvt < 8; ++dvt) gwv[dvt] = *(const u32x2*)(Z + row * ZW + OFF_GB + h * 128 + 16 * dvt + 4 * g4);
        f32x4 P[8];
#pragma unroll
        for (int jt = 0; jt < 8; ++jt) {
            f32x4 acc = {0.f, 0.f, 0.f, 0.f};
#pragma unroll
            for (int ks = 0; ks < 4; ++ks) acc = mfma16(*(const LAS bf16x8*)(Ks + (16 * jt + c16) * 136 + 32 * ks + 8 * g4), R.bq[ks], acc);
#pragma unroll
            for (int rr = 0; rr < 4; ++rr) { const int d = i - (16 * jt + 4 * g4 + rr); const float wgt = d > 0 ? exp2f((float)d * l2f) : (d < 0 ? exp2f((float)(-d) * l2b) : 2.0f); acc[rr] *= wgt; }
            P[jt] = acc;
        }
        bf16x8 bp[4];
#pragma unroll
        for (int k2 = 0; k2 < 4; ++k2) bp[k2] = pack8(P[2 * k2], P[2 * k2 + 1]);
        const float cf = exp2f((float)(i + 1) * l2f), cb = exp2f((float)(128 - i) * l2b);
        f32x4 o[8]; float s1 = 0.f;
#pragma unroll
        for (int dvt = 0; dvt < 8; ++dvt) {
            f32x4 aO = {0.f, 0.f, 0.f, 0.f}, aF = {0.f, 0.f, 0.f, 0.f}, aB = {0.f, 0.f, 0.f, 0.f};
#pragma unroll
            for (int k2 = 0; k2 < 4; ++k2) aO = mfma16(tr8p(Vs, 136, 32 * k2, 16 * dvt, c16, g4), bp[k2], aO);
#pragma unroll
            for (int ks = 0; ks < 4; ++ks) {
                aF = mfma16(*(const LAS bf16x8*)(Sf + (16 * dvt + c16) * 136 + 32 * ks + 8 * g4), R.bq[ks], aF);
                aB = mfma16(*(const LAS bf16x8*)(Sb + (16 * dvt + c16) * 136 + 32 * ks + 8 * g4), R.bq[ks], aB);
            }
            o[dvt] = aO + aF * cf + aB * cb;
            s1 += (o[dvt][0] + o[dvt][1]) + (o[dvt][2] + o[dvt][3]);
            EPI_FENCE();
        }
        s1 += __shfl_xor(s1, 16); s1 += __shfl_xor(s1, 32);
        const float mu = s1 * (1.0f / 128.0f); float s2 = 0.f;
#pragma unroll
        for (int dvt = 0; dvt < 8; ++dvt) { o[dvt] = o[dvt] - mu; s2 += (o[dvt][0] * o[dvt][0] + o[dvt][1] * o[dvt][1]) + (o[dvt][2] * o[dvt][2] + o[dvt][3] * o[dvt][3]); }
        s2 += __shfl_xor(s2, 16); s2 += __shfl_xor(s2, 32);
        const float rstd = 1.0f / sqrtf(s2 * (1.0f / 128.0f) + EPS);
#pragma unroll
        for (int dvt = 0; dvt < 8; ++dvt) {
            const int col = h * 128 + 16 * dvt + 4 * g4;
            const f32x4 gn = *(const LAS f32x4*)(gtab + 16 * dvt + 4 * g4); const u32x2 gw = gwv[dvt];
            f32x4 v = o[dvt] * rstd * gn; v[0] *= bflo(gw.x); v[1] *= bfhi(gw.x); v[2] *= bflo(gw.y); v[3] *= bfhi(gw.y);
            *(u32x2*)(MIX + row * MIXW + 256 + col) = pk4(v);
        }
    }
};

struct CRegs { u32x4 lf[4], v[2]; };
DEVFN CRegs c_load_common(const bf16_t* Z, int row0, int h, int tid) {
    CRegs R;
#pragma unroll
    for (int i = 0; i < 4; ++i) { const int id = tid + 512 * i, dir = id >> 10, j = (id >> 4) & 63, ch = id & 15; R.lf[i] = *(const u32x4*)(Z + (size_t)(row0 + j) * ZW + OFF_FCF + dir * 512 + h * 128 + 8 * ch); }
#pragma unroll
    for (int i = 0; i < 2; ++i) { const int id = tid + 512 * i, j = id >> 4, ch = id & 15; R.v[i] = *(const u32x4*)(Z + (size_t)(row0 + j) * ZW + OFF_IC + h * 128 + 8 * ch); }
    return R;
}
DEVFN void c_stage_common(LAS float* LF, LAS bf16_t* Vs, const CRegs& R, int tid) {
#pragma unroll
    for (int i = 0; i < 4; ++i) {
        const int id = tid + 512 * i, dir = id >> 10, j = (id >> 4) & 63, ch = id & 15; const u32x4 v = R.lf[i];
        LAS float* d = LF + (dir * 64 + j) * 128 + 8 * ch;
        f32x4 a, b; a[0] = h2f(v.x & 0xffffu); a[1] = h2f(v.x >> 16); a[2] = h2f(v.y & 0xffffu); a[3] = h2f(v.y >> 16); b[0] = h2f(v.z & 0xffffu); b[1] = h2f(v.z >> 16); b[2] = h2f(v.w & 0xffffu); b[3] = h2f(v.w >> 16);
        *(LAS f32x4*)d = a; *(LAS f32x4*)(d + 4) = b;
    }
#pragma unroll
    for (int i = 0; i < 2; ++i) { const int id = tid + 512 * i, j = id >> 4, ch = id & 15; *(LAS u32x4*)(Vs + j * 136 + 8 * ch) = R.v[i]; }
}
struct CKvUnit {
    const bf16_t* Z; bf16_t* SC; float* GC; int w0;
    struct Regs { CRegs c; };
    DEVFN Regs load(int unit) const { Regs R; R.c = c_load_common(Z, (unit >> 2) * 64, unit & 3, opaque_tid(w0)); return R; }
    DEVFN void stage(LAS unsigned char* lds, const Regs& R) const { c_stage_common((LAS float*)lds, (LAS bf16_t*)(lds + 65536 + 2 * 64 * 136 * 2), R.c, opaque_tid(w0)); }
    DEVFN void compute(LAS unsigned char* lds, const Regs& R, int unit) const {
        (void)R; const int tid = opaque_tid(w0), lane = tid & 63, w = tid >> 6, c16 = lane & 15, g4 = lane >> 4;
        LAS float* LF = (LAS float*)lds;
        LAS bf16_t* Kx = (LAS bf16_t*)(lds + 65536);
        LAS bf16_t* Vs = (LAS bf16_t*)(lds + 65536 + 2 * 64 * 136 * 2);
        LAS float* tot = (LAS float*)(lds + 65536 + 3 * 64 * 136 * 2);
        {
            const int dir = tid >> 8, half = (tid >> 7) & 1, dk = tid & 127;
            LAS float* lf = LF + (dir * 64 + half * 32) * 128 + dk;
            float run = 0.f;
            if (dir == 0) { for (int j = 31; j >= 0; --j) { const float x = lf[j * 128]; lf[j * 128] = (1.0f - fexp(x)) * fexp(run); run += x; } }
            else { for (int j = 0; j < 32; ++j) { const float x = lf[j * 128]; lf[j * 128] = (1.0f - fexp(x)) * fexp(run); run += x; } }
            tot[(dir * 2 + half) * 128 + dk] = run;
        }
        __syncthreads();
#pragma unroll
        for (int i = 0; i < 4; ++i) {
            const int id = tid + 512 * i, dir = id >> 10, j = (id >> 4) & 63, ch = id & 15, half = j >> 5;
            const LAS float* s = LF + (dir * 64 + j) * 128 + 8 * ch; f32x4 a = *(const LAS f32x4*)s, b = *(const LAS f32x4*)(s + 4);
            if (half == dir) {
                const LAS float* tp = tot + (dir * 2 + (1 - half)) * 128 + 8 * ch; const f32x4 t0 = *(const LAS f32x4*)tp, t1 = *(const LAS f32x4*)(tp + 4);
#pragma unroll
                for (int e = 0; e < 4; ++e) { a[e] *= fexp(t0[e]); b[e] *= fexp(t1[e]); }
            }
            *(LAS bf16x8*)(Kx + (dir * 64 + j) * 136 + 8 * ch) = pack8(a, b);
        }
        if (tid < 256) { const int dir = tid >> 7, dk = tid & 127; GC[((size_t)unit * 2 + dir) * 128 + dk] = fexp(tot[(dir * 2) * 128 + dk] + tot[(dir * 2 + 1) * 128 + dk]); }
        __syncthreads();
#pragma unroll
        for (int dir = 0; dir < 2; ++dir) {
            bf16x8 af[2];
#pragma unroll
            for (int ks = 0; ks < 2; ++ks) af[ks] = tr8(Kx + dir * 64 * 136, 136, 32 * ks, 16 * w, c16, g4);
            bf16_t* dst = SC + ((size_t)unit * 2 + dir) * 16384;
#pragma unroll
            for (int b = 0; b < 8; ++b) {
                f32x4 acc = {0.f, 0.f, 0.f, 0.f};
#pragma unroll
                for (int ks = 0; ks < 2; ++ks) acc = mfma16(af[ks], tr8(Vs, 136, 32 * ks, 16 * b, c16, g4), acc);
                *(u32x2*)(dst + (16 * b + c16) * 128 + 16 * w + 4 * g4) = pk4(acc);
            }
        }
    }
};
struct COutUnit {
    const bf16_t* Z; const bf16_t* SC; bf16_t* MIX; const float* gain; int w0;
    struct Regs { CRegs c; u32x4 qv[4], sf[4], sb[4]; u32x2 gw[4]; f32x4 gn; };
    DEVFN void load1(Regs& R, int unit) const {
        const int tid = opaque_tid(w0), lane = tid & 63, w = tid >> 6, c16 = lane & 15, g4 = lane >> 4; const int h = unit & 3, row0 = (unit >> 2) * 64; R.c = c_load_common(Z, row0, h, tid);
        const size_t row = (size_t)(row0 + 16 * (w & 3) + c16);
#pragma unroll
        for (int ks = 0; ks < 4; ++ks) R.qv[ks] = *(const u32x4*)(Z + row * ZW + OFF_QC + h * 128 + 32 * ks + 8 * g4);
    }
    DEVFN void load2(Regs& R, int unit) const {
        const int tid = opaque_tid(w0), lane = tid & 63, w = tid >> 6, c16 = lane & 15, g4 = lane >> 4; const int h = unit & 3, row0 = (unit >> 2) * 64;
        const size_t row = (size_t)(row0 + 16 * (w & 3) + c16);
        const bf16_t* gSf = SC + ((size_t)unit * 2 + 0) * 16384; const bf16_t* gSb = SC + ((size_t)unit * 2 + 1) * 16384;
#pragma unroll
        for (int i = 0; i < 4; ++i) { const int id = tid + 512 * i; R.sf[i] = *(const u32x4*)(gSf + id * 8); R.sb[i] = *(const u32x4*)(gSb + id * 8); }
#pragma unroll
        for (int dd = 0; dd < 4; ++dd) R.gw[dd] = *(const u32x2*)(Z + row * ZW + OFF_GC + h * 128 + 16 * (4 * (w >> 2) + dd) + 4 * g4);
        R.gn = (f32x4){gain[h * 128 + (tid & 127)], 0.f, 0.f, 0.f};
    }
    DEVFN void stage(LAS unsigned char* lds, const Regs& R) const { const int tid = opaque_tid(w0); c_stage_common((LAS float*)lds, (LAS bf16_t*)(lds + 65536 + 2 * 64 * 136 * 2), R.c, tid);
        }
    DEVFN void compute(LAS unsigned char* lds, const Regs& R, int unit, Regs& N, int next) const {
        const int tid = opaque_tid(w0), lane = tid & 63, w = tid >> 6, c16 = lane & 15, g4 = lane >> 4;
        const int h = unit & 3, row0 = (unit >> 2) * 64;
        const LAS float* gtab = (const LAS float*)(lds + 65536 + 3 * 64 * 136 * 2 + 2048);
        LAS float* LF = (LAS float*)lds;
        LAS bf16_t* Kx = (LAS bf16_t*)(lds + 65536);
        LAS bf16_t* Vs = (LAS bf16_t*)(lds + 65536 + 2 * 64 * 136 * 2);
        LAS float* bref = (LAS float*)(lds + 65536 + 3 * 64 * 136 * 2);
        LAS float* ssq = bref + 256;
        {
            const int dir = tid >> 8, half = (tid >> 7) & 1, dk = tid & 127;
            LAS float* lf = LF + dir * 64 * 128 + dk; LAS bf16_t* kx = Kx + dir * 64 * 136 + dk;
            float run = 0.f;
            if (dir == 0) {
                if (half == 1) { for (int i = 32; i < 64; ++i) { const float x = lf[i * 128]; run += x; lf[i * 128] = run; kx[i * 136] = (bf16_t)f2bf((1.0f - fexp(x)) * fexp(-run)); } }
                else { for (int i = 31; i >= 0; --i) { const float x = lf[i * 128]; lf[i * 128] = run; kx[i * 136] = (bf16_t)f2bf((1.0f - fexp(x)) * fexp(-run)); run -= x; } bref[dk] = -run; }
            } else {
                if (half == 0) { for (int i = 31; i >= 0; --i) { const float x = lf[i * 128]; run += x; lf[i * 128] = run; kx[i * 136] = (bf16_t)f2bf((1.0f - fexp(x)) * fexp(-run)); } }
                else { for (int i = 32; i < 64; ++i) { const float x = lf[i * 128]; lf[i * 128] = run; kx[i * 136] = (bf16_t)f2bf((1.0f - fexp(x)) * fexp(-run)); run -= x; } bref[128 + dk] = -run; }
            }
        }
        const int it = w & 3, dvh = w >> 2, i = 16 * it + c16; const size_t row = (size_t)(row0 + i);
        __syncthreads();
        bf16x8 Qpf[4], Qpb[4];
#pragma unroll
        for (int ks = 0; ks < 4; ++ks) {
            const int dk0 = 32 * ks + 8 * g4; const u32x4 qv = R.qv[ks];
            f32x4 q0, q1; q0[0] = bflo(qv.x); q0[1] = bfhi(qv.x); q0[2] = bflo(qv.y); q0[3] = bfhi(qv.y); q1[0] = bflo(qv.z); q1[1] = bfhi(qv.z); q1[2] = bflo(qv.w); q1[3] = bfhi(qv.w);
            const f32x4 df0 = *(const LAS f32x4*)(LF + i * 128 + dk0), df1 = *(const LAS f32x4*)(LF + i * 128 + dk0 + 4);
            const f32x4 db0 = *(const LAS f32x4*)(LF + (64 + i) * 128 + dk0), db1 = *(const LAS f32x4*)(LF + (64 + i) * 128 + dk0 + 4);
            f32x4 a0, a1, e0, e1;
#pragma unroll
            for (int j = 0; j < 4; ++j) { a0[j] = q0[j] * fexp(df0[j]); a1[j] = q1[j] * fexp(df1[j]); e0[j] = q0[j] * fexp(db0[j]); e1[j] = q1[j] * fexp(db1[j]); }
            Qpf[ks] = pack8(a0, a1); Qpb[ks] = pack8(e0, e1);
            EPI_FENCE();
        }
        f32x4 P[4];
#pragma unroll
        for (int jt = 0; jt < 4; ++jt) {
            f32x4 af = {0.f, 0.f, 0.f, 0.f}, ab = {0.f, 0.f, 0.f, 0.f};
#pragma unroll
            for (int ks = 0; ks < 4; ++ks) {
                af = mfma16(*(const LAS bf16x8*)(Kx + (16 * jt + c16) * 136 + 32 * ks + 8 * g4), Qpf[ks], af);
                ab = mfma16(*(const LAS bf16x8*)(Kx + (64 + 16 * jt + c16) * 136 + 32 * ks + 8 * g4), Qpb[ks], ab);
            }
#pragma unroll
            for (int rr = 0; rr < 4; ++rr) { const int j = 16 * jt + 4 * g4 + rr; P[jt][rr] = (j <= i ? af[rr] : 0.f) + (j >= i ? ab[rr] : 0.f); }
        }
        bf16x8 bp[2];
#pragma unroll
        for (int k2 = 0; k2 < 2; ++k2) bp[k2] = pack8(P[2 * k2], P[2 * k2 + 1]);
        LAS bf16_t* Sl = (LAS bf16_t*)lds;
        __syncthreads();
#pragma unroll
        for (int q = 0; q < 4; ++q) { const int id = tid + 512 * q, r = id >> 4, ch = id & 15; const int o = r * 128 + ((ch ^ (r & 15)) * 8);
            *(LAS u32x4*)(Sl + o) = R.sf[q]; *(LAS u32x4*)(Sl + 16384 + o) = R.sb[q]; }
        if (tid < 128) ((LAS float*)(lds + 65536 + 3 * 64 * 136 * 2 + 2048))[tid] = R.gn[0];
        const u32x2 gw0 = R.gw[0], gw1 = R.gw[1], gw2 = R.gw[2], gw3 = R.gw[3];
        load2(N, next);
        __syncthreads();
        bf16x8 Qqf[4], Qqb[4];
#pragma unroll
        for (int ks = 0; ks < 4; ++ks) {
            const int dk0 = 32 * ks + 8 * g4;
            const f32x4 rf0 = *(const LAS f32x4*)(bref + dk0), rf1 = *(const LAS f32x4*)(bref + dk0 + 4), rb0 = *(const LAS f32x4*)(bref + 128 + dk0), rb1 = *(const LAS f32x4*)(bref + 128 + dk0 + 4);
            const u32x4 pf = __builtin_bit_cast(u32x4, Qpf[ks]), pb = __builtin_bit_cast(u32x4, Qpb[ks]);
            f32x4 c0, c1, f0, f1;
            c0[0] = bflo(pf.x) * fexp(rf0[0]); c0[1] = bfhi(pf.x) * fexp(rf0[1]); c0[2] = bflo(pf.y) * fexp(rf0[2]); c0[3] = bfhi(pf.y) * fexp(rf0[3]);
            c1[0] = bflo(pf.z) * fexp(rf1[0]); c1[1] = bfhi(pf.z) * fexp(rf1[1]); c1[2] = bflo(pf.w) * fexp(rf1[2]); c1[3] = bfhi(pf.w) * fexp(rf1[3]);
            f0[0] = bflo(pb.x) * fexp(rb0[0]); f0[1] = bfhi(pb.x) * fexp(rb0[1]); f0[2] = bflo(pb.y) * fexp(rb0[2]); f0[3] = bfhi(pb.y) * fexp(rb0[3]);
            f1[0] = bflo(pb.z) * fexp(rb1[0]); f1[1] = bfhi(pb.z) * fexp(rb1[1]); f1[2] = bflo(pb.w) * fexp(rb1[2]); f1[3] = bfhi(pb.w) * fexp(rb1[3]);
            Qqf[ks] = pack8(c0, c1); Qqb[ks] = pack8(f0, f1);
        }
        f32x4 o[4]; float s2 = 0.f;
#pragma unroll
        for (int dd = 0; dd < 4; ++dd) {
            const int dvt = 4 * dvh + dd;
            f32x4 acc = {0.f, 0.f, 0.f, 0.f};
#pragma unroll
            for (int k2 = 0; k2 < 2; ++k2) acc = mfma16(tr8p(Vs, 136, 32 * k2, 16 * dvt, c16, g4), bp[k2], acc);
#pragma unroll
            for (int ks = 0; ks < 4; ++ks) {
                const int so = (16 * dvt + c16) * 128 + (((4 * ks + g4) ^ c16) * 8);
                acc = mfma16(*(const LAS bf16x8*)(Sl + so), Qqf[ks], acc);
                acc = mfma16(*(const LAS bf16x8*)(Sl + 16384 + so), Qqb[ks], acc);
            }
            o[dd] = acc; s2 += (acc[0] * acc[0] + acc[1] * acc[1]) + (acc[2] * acc[2] + acc[3] * acc[3]);
            EPI_FENCE();
        }
        s2 += __shfl_xor(s2, 16); s2 += __shfl_xor(s2, 32);
        if (g4 == 0) ssq[w * 16 + c16] = s2;
        __syncthreads();
        const float rinv = 1.0f / sqrtf((ssq[w * 16 + c16] + ssq[(w ^ 4) * 16 + c16]) * (1.0f / 128.0f) + EPS);
#pragma unroll
        for (int dd = 0; dd < 4; ++dd) {
            const int col = h * 128 + 16 * (4 * dvh + dd) + 4 * g4;
            const f32x4 gn = *(const LAS f32x4*)(gtab + 16 * (4 * dvh + dd) + 4 * g4); const u32x2 gw = dd == 0 ? gw0 : (dd == 1 ? gw1 : (dd == 2 ? gw2 : gw3));
            f32x4 v = o[dd] * rinv * gn; v[0] *= bflo(gw.x); v[1] *= bfhi(gw.x); v[2] *= bflo(gw.y); v[3] *= bfhi(gw.y);
            *(u32x2*)(MIX + row * MIXW + 768 + col) = pk4(v);
        }
    }
};

#ifndef CPU_EMU
#define KERNEL_LDS extern __shared__ __attribute__((aligned(16))) unsigned char lds_raw[]; LAS unsigned char* lds = (LAS unsigned char*)lds_raw;
__global__ void __launch_bounds__(512, 2) fwd_kernel(Args args)
#else
#define KERNEL_LDS unsigned char* lds = emu_lds();
void fwd_kernel(Args args)
#endif
{
    KERNEL_LDS
    const int G = gridDim.x, bx = blockIdx.x;
#ifndef CPU_EMU
    const int w0 = __builtin_amdgcn_readfirstlane((int)threadIdx.x >> 6);
#else
    const int w0 = 0;
#endif
#ifndef CPU_EMU
#define PH_IDS const int tid = opaque_tid(w0), lane = tid & 63, wave = __builtin_amdgcn_readfirstlane(tid >> 6), gw = bx * 8 + wave, gtid = bx * 512 + tid; int Gs_ = G; asm volatile("" : "+s"(Gs_)); const int ngw = Gs_ * 8, nthr = Gs_ * 512; (void)lane; (void)gw; (void)gtid; (void)ngw; (void)nthr;
#else
#define PH_IDS const int tid = opaque_tid(w0), lane = tid & 63, wave = tid >> 6, gw = bx * 8 + wave, gtid = bx * 512 + tid; const int ngw = G * 8, nthr = G * 512; (void)lane; (void)gw; (void)gtid; (void)ngw; (void)nthr;
#endif
#ifndef CPU_EMU
#define OPAQUE_S(p) asm volatile("" : "+s"(p))
#else
#define OPAQUE_S(p)
#endif
#define PH_PTRS unsigned char* ws = args.ws; OPAQUE_S(ws); float* h = args.out; OPAQUE_S(h); \
    float* rope = (float*)(ws + WS_ROPE); float* biasT = (float*)(ws + WS_BIAS); float* lbs = (float*)(ws + WS_LBS); \
    bf16_t* WB = (bf16_t*)(ws + WS_WB); bf16_t* XN = (bf16_t*)(ws + WS_XN); unsigned char* R = ws + WS_R; bf16_t* ACT = (bf16_t*)(R + R_ACT); \
    bf16_t* Zs = (bf16_t*)(R + R_Z); bf16_t* AO = (bf16_t*)(R + R_AO); float* LSE = (float*)(R + R_LSE); bf16_t* MIX = (bf16_t*)(R + R_MIX); \
    bf16_t* MH = (bf16_t*)(R + R_MH); bf16_t* SB = (bf16_t*)(R + R_SB); bf16_t* SC = (bf16_t*)(R + R_SC); float* GC = (float*)(R + R_GC); \
    bf16_t* PB = (bf16_t*)(ws + WS_PB); bf16_t* SG = (bf16_t*)(R + R_SG); bf16_t* XN2 = (bf16_t*)(ws + WS_XN2); float* SSQ = (float*)(ws + WS_SSQ); \
    (void)h; (void)rope; (void)biasT; (void)lbs; (void)WB; (void)XN; (void)ACT; (void)Zs; (void)AO; (void)LSE; (void)MIX; (void)MH; (void)SB; (void)SC; (void)GC; (void)PB; (void)SG; (void)XN2; (void)SSQ;
    const int lo = args.lo, hi = args.hi;
#ifndef CPU_EMU
    LAS unsigned* misc = (LAS unsigned*)(lds + LDS_BYTES - 64);
    if (threadIdx.x < 4) misc[threadIdx.x] = 0u;
    __syncthreads();
    XcdBarrier bar = xcd_barrier_post((unsigned*)(args.ws + WS_CTL) + 1024, (volatile LAS unsigned*)misc);
#define GRID_BAR() xcd_barrier(bar, w0)
#else
#define GRID_BAR() emu_grid_barrier()
#endif
    int ph = 0;
#define PH_OPEN if (ph >= lo && ph < hi) { PH_IDS PH_PTRS
#define PH_CLOSE if (ph + 1 < hi) GRID_BAR(); } ++ph;

    PH_OPEN
        prologue_tables(args, rope, biasT, lbs, gtid, nthr);
    PH_CLOSE

    for (int l = 0; l < DEPTH; ++l) {
        PH_OPEN
            convert_weights(args, l, WB, lds, gw, ngw, wave, lane);
            cvt_ple(args, l, PB, gtid, nthr);
            if (l == 0) init_rows(args, h, XN2, SSQ, gw, ngw, lane);
        PH_CLOSE
        for (int half = 0; half < 2; ++half) {
            const int nA = 4 * l + 2 * half;
            for (int q = 0; q <= NFP; ++q) {
            PH_OPEN
                for (int step = 0; step < 2; ++step) {
                    if ((step ^ (bx & 1)) == 0) {
                        if (q > 0) {
                            const size_t r0 = (size_t)(q - 1) * TP;
                            pg8::Gemm g{ACT + r0 * FF, WB + (half ? WE_D2 : WE_D1), TP, D, FF, FF, FF}; pg8::StaticOrder S; S.init(TP, D, G, bx);
                            pg8::EpiResAdd E{h + r0 * D, XN + r0 * D, SSQ + ((size_t)((nA + 1) % 3) * T + r0) * 4, D, 1, lds};
                            pg8::gemm_phase<pg8::EpiResAdd, pg8::StaticOrder>(w0, lds, g, S, E);
                        }
                    } else if (q < NFP) {
                        const size_t r0 = (size_t)q * TP;
                        pg8::Gemm g{(half ? XN : XN2) + r0 * D, WB + (half ? WE_GU2 : WE_GU1), TP, 2 * FF, D, D, D}; pg8::StaticOrder S; S.init(TP, 2 * FF, G, bx);
                        pg8::EpiSwiglu E{ACT + r0 * FF, FF, SSQ + ((size_t)(nA % 3) * T + r0) * 4, lds};
                        pg8::gemm_phase<pg8::EpiSwiglu, pg8::StaticOrder>(w0, lds, g, S, E);
                    }
                }
            PH_CLOSE
            }
            if (half == 0) {
                for (int s = 0; s <= NSLAB; ++s) {
                    const int srow0 = (s < NSLAB ? s : NSLAB - 1) * SLAB; const int S_len = srow0 < NP ? SEQ : DEC_SEQ; const int nseq = SLAB / S_len;
                    PH_OPEN
                        for (int step = 0; step < 2; ++step) {
                            if ((step ^ (bx & 1)) == 0) {
                                if (s > 0) {
                                    const int prow0 = (s - 1) * SLAB;
                                    pg8::Gemm g{MH, WB + WE_OUT, SLAB, D, D, D, D}; pg8::StaticOrder S; S.init(SLAB, D, G, bx);
                                    pg8::EpiResAdd E{h + (size_t)prow0 * D, XN + (size_t)prow0 * D, SSQ + ((size_t)((nA + 2) % 3) * T + prow0) * 4, D, 0, lds};
                                    pg8::gemm_phase<pg8::EpiResAdd, pg8::StaticOrder>(w0, lds, g, S, E);
                                }
                            } else if (s < NSLAB) {
                                pg8::Gemm g{XN + (size_t)srow0 * D, WB + WE_IN, SLAB, ZW, D, D, D}; pg8::StaticOrder S; S.init(SLAB, ZW, G, bx);
                                pg8::EpiInProj E{Zs, rope, rope + 4096 * 64, lbs + l * 512, srow0, SSQ + ((size_t)((nA + 1) % 3) * T + srow0) * 4, lds};
                                pg8::gemm_phase<pg8::EpiInProj, pg8::StaticOrder>(w0, lds, g, S, E);
                            }
                        }
                    PH_CLOSE
                    if (s == NSLAB) break;
                    for (int mrep = 0; mrep < MIXREP; ++mrep) {
                    PH_OPEN
                        { const int nu = (SLAB / 128) * 12, per = (nu + G - 1) / G; const int u1 = (bx + 1) * per < nu ? (bx + 1) * per : nu;
                          const AUnit U{Zs, AO, LSE, biasT, S_len, w0}; run_units(lds, U, bx * per, u1); }
                        { const int nu = (SLAB / 128) * 4, per = (nu + G - 1) / G; const int u1 = (bx + 1) * per < nu ? (bx + 1) * per : nu;
                          const BKvUnit U{Zs, SB, w0}; run_units(lds, U, bx * per, u1); }
                        { const int nu = (SLAB / 64) * 4, per = (nu + G - 1) / G; const int u1 = (bx + 1) * per < nu ? (bx + 1) * per : nu;
                          const CKvUnit U{Zs, SC, GC, w0}; run_units(lds, U, bx * per, u1); }
                    PH_CLOSE
                    PH_OPEN
                        mixer_scan(SB, SC, GC, nseq, S_len, gtid, nthr);
                    PH_CLOSE
                    PH_OPEN
                        mixer_a_merge(AO, LSE, MIX, gtid, nthr);
                        { const int nu = (SLAB / 128) * 4, per = (nu + G - 1) / G; const int u1 = (bx + 1) * per < nu ? (bx + 1) * per : nu;
                          const BOutUnit U{Zs, SB, MIX, args.in[I_RETN] + l * 512, w0}; run_units(lds, U, bx * per, u1); }
                        { const int nu = (SLAB / 64) * 4, per = (nu + G - 1) / G; const int u1 = (bx + 1) * per < nu ? (bx + 1) * per : nu;
                          const COutUnit U{Zs, SC, MIX, args.in[I_HGN] + l * 512, w0}; run_units2(lds, U, bx * per, u1); }
                    PH_CLOSE
                    }
                    PH_OPEN
                        pg8::Gemm g{MIX, WB + WE_BR, SLAB, D, MIXW, MIXW, MIXW}; pg8::StaticOrder S; S.init(SLAB, D, G, bx);
                        pg8::EpiMerge E{MH, Zs + OFF_MG, ZW};
                        pg8::gemm_phase<pg8::EpiMerge, pg8::StaticOrder>(w0, lds, g, S, E);
                    PH_CLOSE
                }
            } else {
                PH_OPEN
                    { pg8::Gemm g{XN, WB + WE_PG, T, D, D, D, D}; pg8::StaticOrder S; S.init(T, D, G, bx);
                      pg8::EpiGateBf16 E{SG, D, SSQ + (size_t)((nA + 1) % 3) * T * 4, lds};
                      pg8::gemm_phase<pg8::EpiGateBf16, pg8::StaticOrder>(w0, lds, g, S, E); }
                    { pg8::Gemm g{PB, WB + WE_PP, T, D, D_PLE, D_PLE, D_PLE}; pg8::StaticOrder S; S.init(T, D, G, bx);
                      pg8::EpiPle E{h, SG, D, XN2, SSQ + (size_t)((nA + 2) % 3) * T * 4, lds};
                      pg8::gemm_phase<pg8::EpiPle, pg8::StaticOrder>(w0, lds, g, S, E); }
                PH_CLOSE
            }
        }
    }
    PH_OPEN
        final_norm_rows(h, args.in[I_FINN], gw, ngw, lane);
    PH_CLOSE
#undef PH_OPEN
#undef PH_CLOSE
}

extern "C" void kernel_launch(void* const* d_in, const int* in_sizes, int n_in, void* d_out, int out_size, void* d_ws, size_t ws_size, hipStream_t stream) {
    static int grid = 0;
    if (grid == 0) {
        if (n_in != N_INPUTS || out_size != T * D || ws_size < WS_END) { fprintf(stderr, "kernel_launch: unexpected sizes (n_in %d, out %d, ws %zu, need %zu)\n", n_in, out_size, ws_size, (size_t)WS_END); grid = -1; return; }
        int dev = 0, cus = 0;
        if (hipGetDevice(&dev) != hipSuccess || hipDeviceGetAttribute(&cus, hipDeviceAttributeMultiprocessorCount, dev) != hipSuccess) { grid = -1; return; }
        if (hipFuncSetAttribute((const void*)fwd_kernel, hipFuncAttributeMaxDynamicSharedMemorySize, LDS_BYTES) != hipSuccess) { fprintf(stderr, "kernel_launch: hipFuncSetAttribute failed\n"); grid = -1; return; }
        int per_cu = 0;
        if (hipOccupancyMaxActiveBlocksPerMultiprocessor(&per_cu, (const void*)fwd_kernel, 512, LDS_BYTES) != hipSuccess || per_cu < 1) fprintf(stderr, "kernel_launch: occupancy query reports %d\n", per_cu);
        (void)hipGetLastError();
        grid = cus;
    }
    if (grid < 0) return;
    (void)in_sizes;
    hipMemsetAsync((char*)d_ws + WS_CTL, 0, CTL_BYTES, stream);
    Args a{};
    for (int i = 0; i < N_INPUTS; ++i) a.in[i] = (const float*)d_in[i];
    a.out = (float*)d_out; a.ws = (unsigned char*)d_ws;
#if ONE_LAUNCH
    a.lo = 0; a.hi = NPH;
    hipLaunchKernelGGL(fwd_kernel, dim3(grid), dim3(512), LDS_BYTES, stream, a);
#else
    for (int p = 0; p < NPH; ++p) { a.lo = p; a.hi = p + 1; hipLaunchKernelGGL(fwd_kernel, dim3(grid), dim3(512), LDS_BYTES, stream, a); }
#endif
}
```

```cpp
#ifndef CPU_EMU
#include <hip/hip_runtime.h>
#include <cstdio>
#include <cstdint>
#define LAS __attribute__((address_space(3)))
#define DEVFN __device__ __forceinline__
#define HDFN __host__ __device__ __forceinline__
#define EPI_FENCE() asm volatile("" ::: "memory")
#define OPAQUE_V(x) asm volatile("" : "+v"(x))
#define OPAQUE_V4(x) asm volatile("" : "+v"(x))
#define OPAQUE_V9(a) asm volatile("" : "+v"(a[0]), "+v"(a[1]), "+v"(a[2]), "+v"(a[3]), "+v"(a[4]), "+v"(a[5]), "+v"(a[6]), "+v"(a[7]), "+v"(a[8]))
#define OPAQUE_SI(x) asm volatile("" : "+s"(x))
#else
#define OPAQUE_SI(x)
#define EPI_FENCE()
#define OPAQUE_V(x)
#define OPAQUE_V4(x)
#define OPAQUE_V9(a)
#endif

#ifdef SMALL_CFG
constexpr int D = 256, FF = 256, BATCH = 2, SEQ = 2048, DEC_BATCH = 1, DEC_SEQ = 4096, DEPTH = 2, SLAB = 4096;
#else
constexpr int D = 1024, FF = 2816, BATCH = 32, SEQ = 2048, DEC_BATCH = 8, DEC_SEQ = 4096, DEPTH = 4, SLAB = 16384;
#endif
#ifndef ONE_LAUNCH
#define ONE_LAUNCH 1
#endif
constexpr int NP = BATCH * SEQ, NS = DEC_BATCH * DEC_SEQ, T = NP + NS, NSLAB = T / SLAB;
constexpr int D_PLE = 256, N_IN = 6912, ZW = N_IN + 3 * D, MIXW = 1280, AOW = 768;
constexpr int OFF_QA = 0, OFF_KA = 768, OFF_VA = 1536, OFF_QB = 2304, OFF_KB = 2816, OFF_VB = 3328, OFF_GB = 3840, OFF_QC = 4352, OFF_FCF = 4864, OFF_IC = 5888, OFF_GC = 6400, OFF_MG = 6912;
constexpr float EPS = 1e-6f;
static_assert(NP % SLAB == 0 && NS % SLAB == 0 && SLAB % SEQ == 0 && SLAB % DEC_SEQ == 0 && T % 256 == 0 && (2 * FF) % 256 == 0 && FF % 128 == 0 && D % 256 == 0, "shape");

constexpr size_t MiB = 1u << 20;
constexpr size_t al(size_t x) { return (x + 255) & ~(size_t)255; }
constexpr size_t WS_CTL = 0, CTL_BYTES = 1 * MiB;
constexpr size_t WS_ROPE = WS_CTL + CTL_BYTES;
constexpr size_t WS_BIAS = WS_ROPE + 2 * MiB;
constexpr size_t WS_LBS = WS_BIAS + 16384;
constexpr size_t WS_WB = WS_LBS + 16384;
constexpr size_t WE_GU1 = 0, WE_D1 = WE_GU1 + (size_t)2 * FF * D, WE_IN = WE_D1 + (size_t)D * FF, WE_BR = WE_IN + (size_t)ZW * D, WE_OUT = WE_BR + (size_t)D * MIXW,
                 WE_GU2 = WE_OUT + (size_t)D * D, WE_D2 = WE_GU2 + (size_t)2 * FF * D, WE_PG = WE_D2 + (size_t)D * FF, WE_PP = WE_PG + (size_t)D * D, WE_END = WE_PP + (size_t)D * D_PLE;
constexpr size_t WS_XN = al(WS_WB + WE_END * 2);
constexpr size_t WS_XN2 = al(WS_XN + (size_t)T * D * 2);
constexpr size_t WS_SSQ = al(WS_XN2 + (size_t)T * D * 2);
constexpr size_t WS_PB = al(WS_SSQ + (size_t)3 * T * 16);
constexpr size_t WS_R = al(WS_PB + (size_t)T * D_PLE * 2);
constexpr size_t R_ACT = 0, R_ACT_END = (size_t)T * FF * 2;
constexpr size_t R_Z = 0, R_AO = al(R_Z + (size_t)SLAB * ZW * 2), R_LSE = al(R_AO + (size_t)SLAB * AOW * 2), R_MIX = al(R_LSE + (size_t)SLAB * 12 * 4),
                 R_MH = al(R_MIX + (size_t)SLAB * MIXW * 2), R_SB = al(R_MH + (size_t)SLAB * D * 2),
                 R_SC = al(R_SB + (size_t)(SLAB / 128) * 4 * 2 * 16384 * 2), R_GC = al(R_SC + (size_t)(SLAB / 64) * 4 * 2 * 16384 * 2), R_MIX_END = al(R_GC + (size_t)(SLAB / 64) * 4 * 2 * 128 * 4);
constexpr size_t R_SG = 0, R_PLE_END = al(R_SG + (size_t)T * D * 2);
constexpr size_t cmax(size_t a, size_t b) { return a > b ? a : b; }
constexpr size_t WS_END = WS_R + cmax(cmax(R_ACT_END, R_MIX_END), R_PLE_END);
constexpr int LDS_BYTES = 147456;
#ifndef MIXREP
#define MIXREP 1
#endif
#ifndef REP_A
#define REP_A 1
#endif
#ifndef REP_KV
#define REP_KV 1
#endif
#ifndef REP_OUT
#define REP_OUT 1
#endif
constexpr int NFP = (T % 768 == 0) ? 3 : 2, TP = T / NFP;
static_assert(TP % 256 == 0, "FFN parts");
constexpr int NPH = 2 + DEPTH * (2 + 2 * (NFP + 1) + (NSLAB + 1) + NSLAB * (1 + 3 * MIXREP));

typedef unsigned short bf16_t;
typedef short bf16x8 __attribute__((ext_vector_type(8)));
typedef short s16x4 __attribute__((ext_vector_type(4)));
typedef float f32x4 __attribute__((ext_vector_type(4)));
typedef unsigned u32x4 __attribute__((ext_vector_type(4)));
typedef unsigned u32x2 __attribute__((ext_vector_type(2)));

#ifndef CPU_EMU
DEVFN int lane_id_v() { int l; asm volatile("v_mbcnt_lo_u32_b32 %0, -1, 0\n\tv_mbcnt_hi_u32_b32 %0, -1, %0" : "=v"(l)); return l; }
DEVFN int opaque_tid(int w0) { return w0 * 64 + lane_id_v(); }
#else
DEVFN int opaque_tid(int) { return threadIdx.x; }
#endif
DEVFN unsigned f2bf(float f) { unsigned u = __builtin_bit_cast(unsigned, f); return (u + 0x7fffu + ((u >> 16) & 1u)) >> 16; }
#ifndef CPU_EMU
typedef float f32x2_t __attribute__((ext_vector_type(2)));
typedef __bf16 bf16x2_t __attribute__((ext_vector_type(2)));
DEVFN unsigned pk2(float lo, float hi) { const f32x2_t v = {lo, hi}; return __builtin_bit_cast(unsigned, __builtin_convertvector(v, bf16x2_t)); }
#else
DEVFN unsigned pk2(float lo, float hi) { return f2bf(lo) | (f2bf(hi) << 16); }
#endif
DEVFN float bf2f(unsigned b) { return __builtin_bit_cast(float, b << 16); }
DEVFN float bflo(unsigned w) { return __builtin_bit_cast(float, w << 16); }
DEVFN float bfhi(unsigned w) { return __builtin_bit_cast(float, w & 0xffff0000u); }
DEVFN unsigned f2h(float f) { _Float16 h = (_Float16)f; return (unsigned)__builtin_bit_cast(unsigned short, h); }
DEVFN float h2f(unsigned b) { return (float)__builtin_bit_cast(_Float16, (unsigned short)b); }
DEVFN u32x2 pk4(f32x4 v) { u32x2 r; r.x = pk2(v[0], v[1]); r.y = pk2(v[2], v[3]); return r; }
#ifndef CPU_EMU
DEVFN f32x4 mfma16(bf16x8 a, bf16x8 b, f32x4 c) { return __builtin_amdgcn_mfma_f32_16x16x32_bf16(a, b, c, 0, 0, 0); }
DEVFN float fexp(float x) { return __expf(x); }
DEVFN float flog(float x) { return __logf(x); }
DEVFN float frcp(float x) { return __builtin_amdgcn_rcpf(x); }
#else
f32x4 mfma16(bf16x8 a, bf16x8 b, f32x4 c);
DEVFN float fexp(float x) { return expf(x); }
DEVFN float flog(float x) { return logf(x); }
DEVFN float frcp(float x) { return 1.0f / x; }
#endif
#ifndef CPU_EMU
DEVFN float rms_rinv(float ssq) { return __builtin_amdgcn_rsqf(ssq * (1.0f / D) + EPS); }
#else
DEVFN float rms_rinv(float ssq) { return 1.0f / sqrtf(ssq * (1.0f / D) + EPS); }
#endif
DEVFN float row_rinv(const float* ssqp, unsigned row) { const f32x4 q = *(const f32x4*)(ssqp + 4 * row); float t = q[0]; if (D >= 512) t += q[1]; if (D >= 768) t += q[2]; if (D >= 1024) t += q[3]; return rms_rinv(t); }
#ifndef CPU_EMU
#define EPI_BARRIER() do { asm volatile("s_waitcnt lgkmcnt(0)" ::: "memory"); __builtin_amdgcn_s_barrier(); asm volatile("" ::: "memory"); } while (0)
#else
#define EPI_BARRIER() __syncthreads()
#endif
constexpr int EPI_RED_OFF = 131072;
constexpr int EPI_RINV_OFF = EPI_RED_OFF + 4096;
DEVFN void rinv_pre(const float* ssqp, LAS unsigned char* lds, int pm, int par, int tid) {
#ifndef CPU_EMU
    asm volatile("" : "+v"(tid));
    const int wv = __builtin_amdgcn_readfirstlane(tid >> 6);
    if (wv < 4) __builtin_amdgcn_global_load_lds((const unsigned*)(ssqp + 4 * (unsigned)(pm * 256 + tid)), (LAS unsigned*)(lds + EPI_RINV_OFF + par * 4096 + wv * 1024), 16, 0, 0);
#else
    if (tid < 256) *(f32x4*)(lds + EPI_RINV_OFF + par * 4096 + tid * 16) = *(const f32x4*)(ssqp + 4 * (unsigned)(pm * 256 + tid));
#endif
}
DEVFN float rinv_get(const LAS unsigned char* lds, int par, int r) { const f32x4 q = *(const LAS f32x4*)(lds + EPI_RINV_OFF + par * 4096 + r * 16); float t = q[0]; if (D >= 512) t += q[1]; if (D >= 768) t += q[2]; if (D >= 1024) t += q[3]; return rms_rinv(t); }
#ifndef CPU_EMU
DEVFN f32x4 swiglu4(f32x4 g, f32x4 u, float ri2, float nl) {
    const f32x4 t = g * nl; f32x4 e; e[0] = __builtin_amdgcn_exp2f(t[0]); e[1] = __builtin_amdgcn_exp2f(t[1]); e[2] = __builtin_amdgcn_exp2f(t[2]); e[3] = __builtin_amdgcn_exp2f(t[3]);
    const f32x4 d = e + 1.0f; f32x4 r; r[0] = __builtin_amdgcn_rcpf(d[0]); r[1] = __builtin_amdgcn_rcpf(d[1]); r[2] = __builtin_amdgcn_rcpf(d[2]); r[3] = __builtin_amdgcn_rcpf(d[3]);
    return (g * u) * (r * ri2);
}
#else
DEVFN f32x4 swiglu4(f32x4 g, f32x4 u, float ri2, float nl) { f32x4 o; for (int j = 0; j < 4; ++j) o[j] = (g[j] * u[j]) * ri2 / (1.0f + exp2f(g[j] * nl)); return o; }
#endif
DEVFN float fsigmoid(float x) { return frcp(1.0f + fexp(-x)); }
DEVFN float fsilu(float x) { return x * fsigmoid(x); }
DEVFN bf16x8 cat8(s16x4 lo, s16x4 hi) { return __builtin_shufflevector(lo, hi, 0, 1, 2, 3, 4, 5, 6, 7); }
DEVFN bf16x8 pack8(f32x4 a, f32x4 b) { u32x4 w; w.x = pk2(a[0], a[1]); w.y = pk2(a[2], a[3]); w.z = pk2(b[0], b[1]); w.w = pk2(b[2], b[3]); return __builtin_bit_cast(bf16x8, w); }
DEVFN unsigned zoff(int sec, int hd, int head, int row, int d) { return (unsigned)SLAB * (unsigned)sec + ((unsigned)head * (unsigned)SLAB + (unsigned)row) * (unsigned)hd + (unsigned)d; }
DEVFN int pos_of(int row) { return row < NP ? (row & (SEQ - 1)) : ((row - NP) & (DEC_SEQ - 1)); }
DEVFN float ret_l2(int dir, int h) {
    return dir ? (h == 0 ? -0.03223685441264423f : h == 1 ? -0.01602838797991282f : h == 2 ? -0.007991934616642016f : -0.003990433313311714f)
               : (h == 0 ? -0.04580368961312479f : h == 1 ? -0.02272007650008353f : h == 2 ? -0.011315313227834146f : -0.005646563141142063f);
}

namespace pg8 {
constexpr int BM = 256, BK = 64, HALF = 128, HTB = HALF * BK * 2, STAGE_BYTES = 8 * HTB, NXCD = 8, WGM = 8;
HDFN int lds_byte(int r, int c) { const int st = (r >> 4) * 2 + (c >> 5), rr = r & 15, cc = c & 31, ob = rr * 64 + cc * 2; return st * 1024 + (ob ^ (((ob >> 9) & 1) << 5)); }
HDFN void stage_rc(int b, int& R, int& C) { const int st = b / 1024, sb = b % 1024, swz = sb ^ (((sb >> 9) & 1) << 5); R = (st >> 1) * 16 + swz / 64; C = (st & 1) * 32 + (swz % 64) / 2; }
HDFN int perm32(int rho) { const int n = rho >> 4, i = rho & 15; return 8 * (i >> 2) + 4 * n + (i & 3); }
struct Unit { int pm, pn; };
struct Gemm { const bf16_t* A; const bf16_t* Bt; int M, N, K, lda, ldb; };
struct StaticOrder {
    int nM, nN, nwg, G, c;
    HDFN void init(int M, int N, int G_, int c_) { nM = M / BM; nN = N / BM; nwg = nM * nN; G = G_; c = c_; }
    HDFN bool next(int i, Unit& u) const {
        const long L = (long)i * G + c; if (L >= nwg) return false;
        int wgid = (int)L; { const int q = nwg / NXCD, r = nwg % NXCD, xcd = wgid % NXCD, off = wgid / NXCD; wgid = (xcd < r ? xcd * (q + 1) : r * (q + 1) + (xcd - r) * q) + off; }
        const int nig = WGM * nN, gid = wgid / nig, fm = gid * WGM, gsz = (nM - fm) < WGM ? (nM - fm) : WGM;
        u.pm = fm + ((wgid % nig) % gsz); u.pn = (wgid % nig) / gsz; return true;
    }
    DEVFN void a_ready(const Unit&) const {}
    DEVFN void done(const Unit&) const {}
};

struct EpiSwiglu {
    static constexpr bool PERM = true, MIDK = false;
    bf16_t* O; int ldc; const float* ssq; LAS unsigned char* lds;
    DEVFN void pre(const Unit& u, int par, int tid) const { rinv_pre(ssq, lds, u.pm, par, tid); }
    DEVFN void operator()(const f32x4 (&acc)[2][2][4][2], const Unit& u, int wr, int wc, int fr, int fq, int par) const {
        const int row0 = u.pm * BM + wr * 64 + fr, col0 = u.pn * HALF + wc * 32 + 8 * fq;
#pragma unroll
        for (int ai = 0; ai < 2; ++ai)
#pragma unroll
            for (int m = 0; m < 4; ++m) {
                bf16_t* rowp = O + (size_t)(row0 + ai * HALF + m * 16) * ldc + col0;
                const float ri = rinv_get(lds, par, ai * HALF + wr * 64 + m * 16 + fr);
                const float ri2 = ri * ri, nl = ri * -1.4426950408889634f;
                f32x4 a = swiglu4(acc[ai][0][m][0], acc[ai][1][m][0], ri2, nl), b = swiglu4(acc[ai][0][m][1], acc[ai][1][m][1], ri2, nl);
                u32x4 w; w.x = pk2(a[0], a[1]); w.y = pk2(a[2], a[3]); w.z = pk2(b[0], b[1]); w.w = pk2(b[2], b[3]);
                *(u32x4*)rowp = w; EPI_FENCE();
            }
    }
};
struct EpiResAdd {
    static constexpr bool PERM = false, MIDK = false;
    const bf16_t* Hs; bf16_t* Hd; float* ssq; int ldc; int halve; LAS unsigned char* lds;
    DEVFN void pre(const Unit&, int, int) const {}
    DEVFN void operator()(const f32x4 (&acc)[2][2][4][2], const Unit& u, int wr, int wc, int fr, int fq, int) const {
        const int row0 = u.pm * BM + wr * 64 + fr, col0 = u.pn * BM + wc * 32 + 4 * fq;
        int frq = fr; OPAQUE_V(frq);
        const float scale = halve ? 0.5f : 1.0f; const f32x4 sc4 = {scale, scale, scale, scale};
        u32x2 res[2][4][2][2];
#pragma unroll
        for (int ai = 0; ai < 2; ++ai) {
            u32x2 hv[4][2][2];
#pragma unroll
            for (int m = 0; m < 4; ++m) { const unsigned off = (unsigned)(row0 + ai * HALF + m * 16) * (unsigned)ldc + (unsigned)col0;
#pragma unroll
                for (int bj = 0; bj < 2; ++bj)
#pragma unroll
                    for (int n = 0; n < 2; ++n) hv[m][bj][n] = *(const u32x2*)(Hs + (off + bj * HALF + n * 16)); }
            EPI_FENCE();
#pragma unroll
            for (int m = 0; m < 4; ++m) { float part = 0.f;
#pragma unroll
                for (int bj = 0; bj < 2; ++bj)
#pragma unroll
                    for (int n = 0; n < 2; ++n) { const u32x2 hw = hv[m][bj][n]; f32x4 v = acc[ai][bj][m][n] * sc4; v[0] += bflo(hw.x); v[1] += bfhi(hw.x); v[2] += bflo(hw.y); v[3] += bfhi(hw.y);
                        const u32x2 o = pk4(v); res[ai][m][bj][n] = o;
                        const float r0 = bflo(o.x), r1 = bfhi(o.x), r2 = bflo(o.y), r3 = bfhi(o.y); part += (r0 * r0 + r1 * r1) + (r2 * r2 + r3 * r3); }
                part += __shfl_xor(part, 16); part += __shfl_xor(part, 32);
                if (fq == 0) ((LAS float*)(lds + EPI_RED_OFF))[(ai * HALF + wr * 64 + m * 16 + frq) * 4 + wc] = part; }
            EPI_FENCE();
        }
#pragma unroll
        for (int ai = 0; ai < 2; ++ai)
#pragma unroll
            for (int m = 0; m < 4; ++m) { const unsigned off = (unsigned)(row0 + ai * HALF + m * 16) * (unsigned)ldc + (unsigned)col0;
#pragma unroll
                for (int bj = 0; bj < 2; ++bj)
#pragma unroll
                    for (int n = 0; n < 2; ++n) *(u32x2*)(Hd + (off + bj * HALF + n * 16)) = res[ai][m][bj][n]; }
        EPI_BARRIER();
        { int t = wr * 256 + wc * 64 + fq * 16 + fr; OPAQUE_V(t); if (t < 256) { const f32x4 q = *(const LAS f32x4*)(lds + EPI_RED_OFF + t * 16); ssq[(size_t)(u.pm * BM + t) * 4 + u.pn] = (q[0] + q[1]) + (q[2] + q[3]); } }
    }
};
struct EpiGateBf16 {
    static constexpr bool PERM = false, MIDK = false;
    bf16_t* SG; int ldc; const float* ssq; LAS unsigned char* lds;
    DEVFN void pre(const Unit& u, int par, int tid) const { rinv_pre(ssq, lds, u.pm, par, tid); }
    DEVFN void operator()(const f32x4 (&acc)[2][2][4][2], const Unit& u, int wr, int wc, int fr, int fq, int par) const {
        const int row0 = u.pm * BM + wr * 64 + fr, col0 = u.pn * BM + wc * 32 + 4 * fq;
#pragma unroll
        for (int ai = 0; ai < 2; ++ai)
#pragma unroll
            for (int m = 0; m < 4; ++m) { const unsigned off = (unsigned)(row0 + ai * HALF + m * 16) * (unsigned)ldc + (unsigned)col0; const float ri = rinv_get(lds, par, ai * HALF + wr * 64 + m * 16 + fr);
#pragma unroll
                for (int bj = 0; bj < 2; ++bj)
#pragma unroll
                    for (int n = 0; n < 2; ++n) { f32x4 v = acc[ai][bj][m][n];
#pragma unroll
                        for (int j = 0; j < 4; ++j) v[j] = fsigmoid(v[j] * ri);
                        *(u32x2*)(SG + (off + bj * HALF + n * 16)) = pk4(v); }
                EPI_FENCE(); }
    }
};
struct EpiPle {
    static constexpr bool PERM = false, MIDK = false;
    const bf16_t* Hs; const bf16_t* SG; int ldc; bf16_t* Hd; float* ssq_out; LAS unsigned char* lds;
    DEVFN void pre(const Unit&, int, int) const {}
    DEVFN void operator()(const f32x4 (&acc)[2][2][4][2], const Unit& u, int wr, int wc, int fr, int fq, int) const {
        const int row0 = u.pm * BM + wr * 64 + fr, col0 = u.pn * BM + wc * 32 + 4 * fq;
        int frq = fr; OPAQUE_V(frq);
        u32x2 res[2][4][2][2];
#pragma unroll
        for (int ai = 0; ai < 2; ++ai)
#pragma unroll
            for (int mp = 0; mp < 2; ++mp) {
                u32x2 hv[2][2][2], gv[2][2][2];
#pragma unroll
                for (int m2 = 0; m2 < 2; ++m2) { const unsigned ro = (unsigned)(row0 + ai * HALF + (2 * mp + m2) * 16) * (unsigned)ldc + (unsigned)col0;
#pragma unroll
                    for (int bj = 0; bj < 2; ++bj)
#pragma unroll
                        for (int n = 0; n < 2; ++n) { hv[m2][bj][n] = *(const u32x2*)(Hs + (ro + bj * HALF + n * 16)); gv[m2][bj][n] = *(const u32x2*)(SG + (ro + bj * HALF + n * 16)); } }
                EPI_FENCE();
#pragma unroll
                for (int m2 = 0; m2 < 2; ++m2) { const int m = 2 * mp + m2; float part = 0.f;
#pragma unroll
                    for (int bj = 0; bj < 2; ++bj)
#pragma unroll
                        for (int n = 0; n < 2; ++n) { const f32x4 a = acc[ai][bj][m][n]; const u32x2 gw = gv[m2][bj][n], hw = hv[m2][bj][n]; f32x4 v;
                            v[0] = bflo(hw.x) + bflo(gw.x) * a[0]; v[1] = bfhi(hw.x) + bfhi(gw.x) * a[1]; v[2] = bflo(hw.y) + bflo(gw.y) * a[2]; v[3] = bfhi(hw.y) + bfhi(gw.y) * a[3];
                            const u32x2 o = pk4(v); res[ai][m][bj][n] = o;
                            const float r0 = bflo(o.x), r1 = bfhi(o.x), r2 = bflo(o.y), r3 = bfhi(o.y); part += (r0 * r0 + r1 * r1) + (r2 * r2 + r3 * r3); }
                    part += __shfl_xor(part, 16); part += __shfl_xor(part, 32);
                    if (fq == 0) ((LAS float*)(lds + EPI_RED_OFF))[(ai * HALF + wr * 64 + m * 16 + frq) * 4 + wc] = part; }
                EPI_FENCE();
            }
#pragma unroll
        for (int ai = 0; ai < 2; ++ai)
#pragma unroll
            for (int m = 0; m < 4; ++m) { const unsigned ro = (unsigned)(row0 + ai * HALF + m * 16) * (unsigned)ldc + (unsigned)col0;
#pragma unroll
                for (int bj = 0; bj < 2; ++bj)
#pragma unroll
                    for (int n = 0; n < 2; ++n) *(u32x2*)(Hd + (ro + bj * HALF + n * 16)) = res[ai][m][bj][n]; }
        EPI_BARRIER();
        { int t = wr * 256 + wc * 64 + fq * 16 + fr; OPAQUE_V(t); if (t < 256) { const f32x4 q = *(const LAS f32x4*)(lds + EPI_RED_OFF + t * 16); ssq_out[(size_t)(u.pm * BM + t) * 4 + u.pn] = (q[0] + q[1]) + (q[2] + q[3]); } }
    }
};
struct EpiMerge {
    static constexpr bool PERM = true, MIDK = true;
    bf16_t* MH; const bf16_t* G; int ldg;
    DEVFN void pre(const Unit&, int, int) const {}
    DEVFN void gate8(unsigned off, f32x4& g0, f32x4& g1) const { unpack8(*(const u32x4*)(G + off), g0, g1); }
    DEVFN void unpack8(u32x4 w, f32x4& g0, f32x4& g1) const {
        g0[0] = fmaxf(bflo(w.x), 1e-30f); g0[1] = fmaxf(bfhi(w.x), 1e-30f); g0[2] = fmaxf(bflo(w.y), 1e-30f); g0[3] = fmaxf(bfhi(w.y), 1e-30f);
        g1[0] = fmaxf(bflo(w.z), 1e-30f); g1[1] = fmaxf(bfhi(w.z), 1e-30f); g1[2] = fmaxf(bflo(w.w), 1e-30f); g1[3] = fmaxf(bfhi(w.w), 1e-30f); }
    DEVFN void mid(f32x4 (&acc)[2][2][4][2], const Unit& u, int wr, int wc, int fr, int fq, int x) const {
        OPAQUE_V(fr); OPAQUE_V(fq);
        const int row0 = u.pm * BM + wr * 64 + fr; const unsigned col0 = (unsigned)(u.pn * BM + wc * 32 + 8 * fq) + (unsigned)x * (unsigned)(SLAB * D);
#pragma unroll
        for (int ai = 0; ai < 2; ++ai) {
            u32x4 gn[4][2], gd[4][2];
#pragma unroll
            for (int m = 0; m < 4; ++m) { const unsigned off = (unsigned)(row0 + ai * HALF + m * 16) * (unsigned)ldg + col0;
#pragma unroll
                for (int bj = 0; bj < 2; ++bj) { gn[m][bj] = *(const u32x4*)(G + (off + bj * HALF)); gd[m][bj] = *(const u32x4*)(G + (off + (unsigned)(SLAB * D) + bj * HALF)); } }
            EPI_FENCE();
#pragma unroll
            for (int m = 0; m < 4; ++m)
#pragma unroll
                for (int bj = 0; bj < 2; ++bj) { f32x4 n0, n1, d0, d1; unpack8(gn[m][bj], n0, n1); unpack8(gd[m][bj], d0, d1);
#pragma unroll
                    for (int j = 0; j < 4; ++j) { acc[ai][bj][m][0][j] *= n0[j] * frcp(d0[j]); acc[ai][bj][m][1][j] *= n1[j] * frcp(d1[j]); } }
            EPI_FENCE();
        }
    }
    DEVFN void operator()(const f32x4 (&acc)[2][2][4][2], const Unit& u, int wr, int wc, int fr, int fq, int) const {
        OPAQUE_V(fr); OPAQUE_V(fq);
        const int row0 = u.pm * BM + wr * 64 + fr, col0 = u.pn * BM + wc * 32 + 8 * fq;
        u32x4 res[2][4][2];
#pragma unroll
        for (int ai = 0; ai < 2; ++ai) {
            u32x4 gc[4][2];
#pragma unroll
            for (int m = 0; m < 4; ++m)
#pragma unroll
                for (int bj = 0; bj < 2; ++bj) gc[m][bj] = *(const u32x4*)(G + ((unsigned)(row0 + ai * HALF + m * 16) * (unsigned)ldg + 2u * (unsigned)(SLAB * D) + col0 + bj * HALF));
            EPI_FENCE();
#pragma unroll
            for (int m = 0; m < 4; ++m)
#pragma unroll
                for (int bj = 0; bj < 2; ++bj) { f32x4 g0, g1; unpack8(gc[m][bj], g0, g1);
                    const f32x4 v0 = acc[ai][bj][m][0] * g0, v1 = acc[ai][bj][m][1] * g1;
                    u32x4 w; w.x = pk2(v0[0], v0[1]); w.y = pk2(v0[2], v0[3]); w.z = pk2(v1[0], v1[1]); w.w = pk2(v1[2], v1[3]); res[ai][m][bj] = w; }
            EPI_FENCE();
        }
#pragma unroll
        for (int ai = 0; ai < 2; ++ai)
#pragma unroll
            for (int m = 0; m < 4; ++m) { const unsigned row = (unsigned)(row0 + ai * HALF + m * 16);
#pragma unroll
                for (int bj = 0; bj < 2; ++bj) *(u32x4*)(MH + row * (unsigned)D + col0 + bj * HALF) = res[ai][m][bj]; }
    }
};
struct EpiInProj {
    static constexpr bool PERM = true, MIDK = false;
    bf16_t* O; const float* cosT; const float* sinT; const float* lb; int row_base; const float* ssq; LAS unsigned char* lds;
    DEVFN void pre(const Unit& u, int par, int tid) const { rinv_pre(ssq, lds, u.pm, par, tid); }
    DEVFN unsigned zdst(int cb, int cw, int row) const {
        if (cb < OFF_QB) { const int sec = (cb / 768) * 768; return zoff(sec, 64, (cb - sec) / 64 + (cw >> 6), row, cw & 63); }
        if (cb < OFF_MG) { const int sec = OFF_QB + ((cb - OFF_QB) / 512) * 512; return zoff(sec, 128, (cb - sec) / 128, row, cw); }
        const int x = (cb - OFF_MG) / D, c = (cb - OFF_MG) % D; return (unsigned)SLAB * (unsigned)OFF_MG + (unsigned)x * (unsigned)(SLAB * D) + (unsigned)row * (unsigned)D + (unsigned)(c + cw);
    }
    DEVFN void store8(int cb, int cw, int row, f32x4 v0, f32x4 v1) const { u32x4 w; w.x = pk2(v0[0], v0[1]); w.y = pk2(v0[2], v0[3]); w.z = pk2(v1[0], v1[1]); w.w = pk2(v1[2], v1[3]); *(u32x4*)(O + zdst(cb, cw, row)) = w; }
    DEVFN void operator()(const f32x4 (&acc)[2][2][4][2], const Unit& u, int wr, int wc, int fr, int fq, int par) const {
        const int pn = u.pn;
        const int mode = pn < 9 ? 0 : pn < 13 ? 1 : pn < 15 ? 0 : pn < 19 ? 2 : pn < 23 ? 3 : pn < 25 ? 0 : pn < 27 ? 2 : 4;
        int cw = wc * 32 + 8 * fq; OPAQUE_V(cw);
        const int row0 = u.pm * BM + wr * 64 + fr, col0 = pn * BM + cw;
        if (mode == 1) {
#pragma unroll
            for (int ai = 0; ai < 2; ++ai) {
                f32x4 cq[4], sq[4];
#pragma unroll
                for (int m = 0; m < 4; ++m) { const int pos = pos_of(row_base + row0 + ai * HALF + m * 16); cq[m] = *(const f32x4*)(cosT + pos * 64 + 4 * (4 * wc + fq)); sq[m] = *(const f32x4*)(sinT + pos * 64 + 4 * (4 * wc + fq)); }
                EPI_FENCE();
#pragma unroll
                for (int m = 0; m < 4; ++m) { const int row = row0 + ai * HALF + m * 16; const float ri = rinv_get(lds, par, ai * HALF + wr * 64 + m * 16 + fr); const f32x4 c4 = cq[m], s4 = sq[m];
#pragma unroll
                    for (int bj = 0; bj < 2; ++bj) { const f32x4 v0 = acc[ai][bj][m][0] * ri, v1 = acc[ai][bj][m][1] * ri; store8(pn * BM + bj * HALF, cw, row, v0 * c4 - v1 * s4, v0 * s4 + v1 * c4); } }
                EPI_FENCE();
            }
        } else if (mode == 3) {
            f32x4 lbv[2][2];
#pragma unroll
            for (int bj = 0; bj < 2; ++bj) { const int lc = (col0 + bj * HALF - OFF_FCF) & 511; lbv[bj][0] = *(const f32x4*)(lb + lc); lbv[bj][1] = *(const f32x4*)(lb + lc + 4); }
            EPI_FENCE();
#pragma unroll
            for (int ai = 0; ai < 2; ++ai)
#pragma unroll
                for (int m = 0; m < 4; ++m) { const int row = row0 + ai * HALF + m * 16; const float ri = rinv_get(lds, par, ai * HALF + wr * 64 + m * 16 + fr);
#pragma unroll
                    for (int bj = 0; bj < 2; ++bj) { f32x4 v0 = acc[ai][bj][m][0] * ri, v1 = acc[ai][bj][m][1] * ri; const f32x4 l0 = lbv[bj][0], l1 = lbv[bj][1];
#pragma unroll
                        for (int j = 0; j < 4; ++j) { v0[j] = fmaxf(flog(l0[j] + (1.f - l0[j]) * fsigmoid(v0[j])), -30.f); v1[j] = fmaxf(flog(l1[j] + (1.f - l1[j]) * fsigmoid(v1[j])), -30.f); }
                        u32x4 w; w.x = f2h(v0[0]) | (f2h(v0[1]) << 16); w.y = f2h(v0[2]) | (f2h(v0[3]) << 16); w.z = f2h(v1[0]) | (f2h(v1[1]) << 16); w.w = f2h(v1[2]) | (f2h(v1[3]) << 16);
                        *(u32x4*)(O + zdst(pn * BM + bj * HALF, cw, row)) = w; } }
        } else {
#pragma unroll
            for (int ai = 0; ai < 2; ++ai)
#pragma unroll
                for (int m = 0; m < 4; ++m) { const int row = row0 + ai * HALF + m * 16; const float ri = rinv_get(lds, par, ai * HALF + wr * 64 + m * 16 + fr);
#pragma unroll
                    for (int bj = 0; bj < 2; ++bj) { f32x4 v0 = acc[ai][bj][m][0] * ri, v1 = acc[ai][bj][m][1] * ri;
                        if (mode == 2) {
#pragma unroll
                            for (int j = 0; j < 4; ++j) { v0[j] = fsilu(v0[j]); v1[j] = fsilu(v1[j]); } }
                        else if (mode == 4) {
#pragma unroll
                            for (int j = 0; j < 4; ++j) { v0[j] = fsigmoid(v0[j]); v1[j] = fsigmoid(v1[j]); } }
                        store8(pn * BM + bj * HALF, cw, row, v0, v1); } }
        }
    }
};

#ifndef CPU_EMU
#define PG8_LAS __attribute__((address_space(3)))
template <class Epi, class Sched, bool ALIGN_EPI = true, bool SP2 = true>
__device__ __forceinline__ void gemm_phase(int w0, PG8_LAS unsigned char* lds, const Gemm g, const Sched S, const Epi E) {
    const int tid = opaque_tid(w0), wid = __builtin_amdgcn_readfirstlane(tid >> 6), lane = tid & 63, wr = wid >> 2, wc = wid & 3, fr = lane & 15, fq = lane >> 4;
    const int K = g.K, nt = K / BK;
    unsigned voffA[2], voffB[2];
#pragma unroll
    for (int i = 0; i < 2; ++i) { int R, C; stage_rc(tid * 16 + i * 8192, R, C); const int Rb = Epi::PERM ? ((R & ~31) + perm32(R & 31)) : R;
        voffA[i] = (unsigned)(R * g.lda + C) * 2u; voffB[i] = (unsigned)(Rb * g.ldb + C) * 2u; }
    const size_t kstep = (size_t)(BK * 2);
    const size_t hstepA = (size_t)HALF * g.lda * 2, hstepB = (size_t)HALF * g.ldb * 2;
    const size_t tstepA = 2 * hstepA, tstepB = 2 * hstepB;
    const unsigned ldsw = (unsigned)wid * 1024u;
    const int aoff = lds_byte(wr * 64 + fr, fq * 8), boff = lds_byte(wc * 32 + fr, fq * 8);
#define PG8_SA(b, h) (((b) * 2 + (h)) * HTB)
#define PG8_SB(b, h) ((4 + (b) * 2 + (h)) * HTB)
#define PG8_STAGE(bufoff, gbase, voff) do { _Pragma("unroll") for (int _i = 0; _i < 2; ++_i) \
        __builtin_amdgcn_global_load_lds((const unsigned*)((const char*)(gbase) + (voff)[_i]), (PG8_LAS unsigned*)(lds + (bufoff) + ldsw + _i * 8192), 16, 0, 0); } while (0)
#define PG8_LDA(dst, b, h) do { _Pragma("unroll") for (int m = 0; m < 4; ++m) _Pragma("unroll") for (int k = 0; k < 2; ++k) dst[m][k] = *(const PG8_LAS bf16x8*)(lds + PG8_SA(b, h) + aoff + m * 2048 + k * 1024); } while (0)
#define PG8_LDB(dst, b, h) do { _Pragma("unroll") for (int n = 0; n < 2; ++n) _Pragma("unroll") for (int k = 0; k < 2; ++k) dst[n][k] = *(const PG8_LAS bf16x8*)(lds + PG8_SB(b, h) + boff + n * 2048 + k * 1024); } while (0)
#define PG8_MMA(ai, bj, At, Bt) do { __builtin_amdgcn_s_setprio(1); _Pragma("unroll") for (int m = 0; m < 4; ++m) _Pragma("unroll") for (int n = 0; n < 2; ++n) _Pragma("unroll") for (int k = 0; k < 2; ++k) \
        acc[ai][bj][m][n] = __builtin_amdgcn_mfma_f32_16x16x32_bf16(Bt[n][k], At[m][k], acc[ai][bj][m][n], 0, 0, 0); __builtin_amdgcn_s_setprio(0); } while (0)
#define PG8_WAIT_V(n) asm volatile("s_waitcnt vmcnt(" #n ")" ::: "memory")
#define PG8_WAIT_L(n) asm volatile("s_waitcnt lgkmcnt(" #n ")" ::: "memory")
#define PG8_BAR __builtin_amdgcn_s_barrier()
#define PG8_SCHED __builtin_amdgcn_sched_barrier(0)
    Unit cur, nxt; int ui = 0;
    if (!S.next(0, cur)) return;
    f32x4 acc[2][2][4][2];
#pragma unroll
    for (int a = 0; a < 2; ++a)
#pragma unroll
        for (int b = 0; b < 2; ++b)
#pragma unroll
            for (int m = 0; m < 4; ++m)
#pragma unroll
                for (int n = 0; n < 2; ++n) acc[a][b][m][n] = (f32x4){0.f, 0.f, 0.f, 0.f};
    bf16x8 At[4][2], B0[2][2], B1[2][2];
    const char* cA = (const char*)g.A + (size_t)cur.pm * tstepA; const char* cB = (const char*)g.Bt + (size_t)cur.pn * tstepB;
    S.a_ready(cur);
    E.pre(cur, 0, wid * 64 + lane_id_v());
    if constexpr (SP2) {
        PG8_STAGE(PG8_SB(0, 0), cB, voffB); PG8_STAGE(PG8_SB(0, 1), cB + hstepB, voffB); PG8_STAGE(PG8_SA(0, 0), cA, voffA); PG8_STAGE(PG8_SA(0, 1), cA + hstepA, voffA);
        if (wr == 1) PG8_BAR;
        PG8_WAIT_V(2); PG8_BAR;
        PG8_STAGE(PG8_SB(1, 0), cB + kstep, voffB); PG8_STAGE(PG8_SA(1, 0), cA + kstep, voffA); PG8_STAGE(PG8_SB(1, 1), cB + hstepB + kstep, voffB);
        PG8_WAIT_V(6); PG8_BAR;
    } else {
        PG8_STAGE(PG8_SB(0, 0), cB, voffB); PG8_STAGE(PG8_SA(0, 0), cA, voffA); PG8_STAGE(PG8_SB(0, 1), cB + hstepB, voffB); PG8_STAGE(PG8_SA(0, 1), cA + hstepA, voffA);
        if (wr == 1) PG8_BAR;
        PG8_WAIT_V(4); PG8_BAR;
        PG8_STAGE(PG8_SB(1, 0), cB + kstep, voffB); PG8_STAGE(PG8_SA(1, 0), cA + kstep, voffA); PG8_STAGE(PG8_SB(1, 1), cB + hstepB + kstep, voffB);
        PG8_WAIT_V(6); PG8_BAR;
    }
    for (;;) {
        const bool has_next = S.next(ui + 1, nxt);
        const char* nA = has_next ? (const char*)g.A + (size_t)nxt.pm * tstepA : cA; const char* nB = has_next ? (const char*)g.Bt + (size_t)nxt.pn * tstepB : cB;
        constexpr int NSEG = Epi::MIDK ? 3 : 1;
#pragma nounroll
        for (int seg = 0; seg < NSEG; ++seg) {
        const int tb = Epi::MIDK ? (seg == 0 ? 0 : (seg == 1 ? 4 : 12)) : 0, te = Epi::MIDK ? (seg == 0 ? 4 : (seg == 1 ? 12 : nt)) : nt;
#pragma nounroll
        for (int t = tb; t < te; t += 2) {
            const bool last = (t == nt - 2);
            const char* a1 = cA + (size_t)(t + 1) * kstep;
            const char* a2 = last ? nA : cA + (size_t)(t + 2) * kstep; const char* b2 = last ? nB : cB + (size_t)(t + 2) * kstep;
            const char* a3 = a2 + kstep; const char* b3 = b2 + kstep;
            if (last && has_next) S.a_ready(nxt);
            if constexpr (SP2) {
            PG8_LDB(B0, 0, 0); PG8_LDB(B1, 0, 1); PG8_SCHED; PG8_LDA(At, 0, 0); PG8_STAGE(PG8_SA(1, 1), a1 + hstepA, voffA);
            PG8_WAIT_V(8); PG8_WAIT_L(0); PG8_BAR; PG8_MMA(0, 0, At, B0); PG8_MMA(0, 1, At, B1); PG8_BAR; PG8_SCHED;
            PG8_LDA(At, 0, 1); PG8_STAGE(PG8_SB(0, 0), b2, voffB); PG8_STAGE(PG8_SB(0, 1), b2 + hstepB, voffB); PG8_STAGE(PG8_SA(0, 0), a2, voffA);
            PG8_WAIT_V(8); PG8_WAIT_L(0); PG8_BAR; PG8_MMA(1, 0, At, B0); PG8_MMA(1, 1, At, B1); PG8_BAR; PG8_SCHED;
            PG8_LDB(B0, 1, 0); PG8_LDB(B1, 1, 1); PG8_SCHED; PG8_LDA(At, 1, 0); PG8_STAGE(PG8_SA(0, 1), a2 + hstepA, voffA);
            PG8_WAIT_V(8); PG8_WAIT_L(0); PG8_BAR; PG8_MMA(0, 0, At, B0); PG8_MMA(0, 1, At, B1); PG8_BAR; PG8_SCHED;
            PG8_LDA(At, 1, 1); PG8_STAGE(PG8_SB(1, 0), b3, voffB); PG8_STAGE(PG8_SB(1, 1), b3 + hstepB, voffB); PG8_STAGE(PG8_SA(1, 0), a3, voffA);
            PG8_WAIT_V(8); PG8_WAIT_L(0); PG8_BAR; PG8_MMA(1, 0, At, B0); PG8_MMA(1, 1, At, B1); PG8_BAR; PG8_SCHED;
            } else {
            PG8_LDB(B0, 0, 0); PG8_SCHED; PG8_LDA(At, 0, 0); PG8_STAGE(PG8_SA(1, 1), a1 + hstepA, voffA);
            PG8_WAIT_L(8); PG8_BAR; PG8_WAIT_L(0); PG8_MMA(0, 0, At, B0); PG8_BAR; PG8_SCHED;
            PG8_LDB(B1, 0, 1); PG8_STAGE(PG8_SB(0, 0), b2, voffB);
            PG8_BAR; PG8_WAIT_L(0); PG8_MMA(0, 1, At, B1); PG8_BAR;
            PG8_LDA(At, 0, 1); PG8_STAGE(PG8_SA(0, 0), a2, voffA);
            PG8_BAR; PG8_WAIT_L(0); PG8_MMA(1, 0, At, B0); PG8_BAR; PG8_SCHED;
            PG8_STAGE(PG8_SB(0, 1), b2 + hstepB, voffB);
            PG8_WAIT_V(6); PG8_BAR; PG8_MMA(1, 1, At, B1); PG8_BAR;
            PG8_LDB(B0, 1, 0); PG8_SCHED; PG8_LDA(At, 1, 0); PG8_STAGE(PG8_SA(0, 1), a2 + hstepA, voffA);
            PG8_WAIT_L(8); PG8_BAR; PG8_WAIT_L(0); PG8_MMA(0, 0, At, B0); PG8_BAR; PG8_SCHED;
            PG8_LDB(B1, 1, 1); PG8_STAGE(PG8_SB(1, 0), b3, voffB);
            PG8_BAR; PG8_WAIT_L(0); PG8_MMA(0, 1, At, B1); PG8_BAR;
            PG8_LDA(At, 1, 1); PG8_STAGE(PG8_SA(1, 0), a3, voffA);
            PG8_BAR; PG8_WAIT_L(0); PG8_MMA(1, 0, At, B0); PG8_BAR; PG8_SCHED;
            PG8_STAGE(PG8_SB(1, 1), b3 + hstepB, voffB);
            PG8_WAIT_V(6); PG8_BAR; PG8_MMA(1, 1, At, B1); PG8_BAR;
            }
        }
        if constexpr (Epi::MIDK) { if (seg < 2) E.mid(acc, cur, wr, wc, fr, fq, seg); }
        }
        if constexpr (ALIGN_EPI) { if (wr == 0) PG8_BAR; }
        E(acc, cur, wr, wc, fr, fq, ui & 1); S.done(cur);
        if (!has_next) break;
        E.pre(nxt, (ui + 1) & 1, wid * 64 + lane_id_v());
#pragma unroll
        for (int a = 0; a < 2; ++a)
#pragma unroll
            for (int b = 0; b < 2; ++b)
#pragma unroll
                for (int m = 0; m < 4; ++m)
#pragma unroll
                    for (int n = 0; n < 2; ++n) acc[a][b][m][n] = (f32x4){0.f, 0.f, 0.f, 0.f};
        cur = nxt; cA = nA; cB = nB; ++ui;
        if constexpr (ALIGN_EPI) { if (wr == 1) PG8_BAR; }
    }
    PG8_WAIT_V(0);
    if constexpr (!ALIGN_EPI) { if (wr == 0) PG8_BAR; }
    PG8_BAR;
#undef PG8_SA
#undef PG8_SB
#undef PG8_STAGE
#undef PG8_LDA
#undef PG8_LDB
#undef PG8_MMA
#undef PG8_WAIT_V
#undef PG8_WAIT_L
#undef PG8_BAR
#undef PG8_SCHED
}
#else
template <class Epi, class Sched, bool ALIGN_EPI = true, bool SP2 = true>
void gemm_phase(int w0, unsigned char* lds, const Gemm g, const Sched& S, const Epi& E) {
    (void)lds; const int tid = opaque_tid(w0), wid = tid >> 6, lane = tid & 63, wr = wid >> 2, wc = wid & 3, fr = lane & 15, fq = lane >> 4;
    Unit cur;
    for (int ui = 0; S.next(ui, cur); ++ui) {
        E.pre(cur, ui & 1, tid); __syncthreads();
        f32x4 acc[2][2][4][2];
        for (int ai = 0; ai < 2; ++ai) for (int bj = 0; bj < 2; ++bj) for (int m = 0; m < 4; ++m) for (int n = 0; n < 2; ++n) for (int j = 0; j < 4; ++j) {
            const int row = 256 * cur.pm + 128 * ai + 64 * wr + 16 * m + fr;
            const int col = Epi::PERM ? 256 * cur.pn + 128 * bj + 32 * wc + 8 * fq + 4 * n + j : 256 * cur.pn + 128 * bj + 32 * wc + 16 * n + 4 * fq + j;
            acc[ai][bj][m][n][j] = 0.f; }
        const int nseg = Epi::MIDK ? 3 : 1; const int kb[4] = {0, Epi::MIDK ? 256 : g.K, 768, g.K};
        for (int sg = 0; sg < nseg; ++sg) {
            for (int ai = 0; ai < 2; ++ai) for (int bj = 0; bj < 2; ++bj) for (int m = 0; m < 4; ++m) for (int n = 0; n < 2; ++n) for (int j = 0; j < 4; ++j) {
                const int row = 256 * cur.pm + 128 * ai + 64 * wr + 16 * m + fr;
                const int col = Epi::PERM ? 256 * cur.pn + 128 * bj + 32 * wc + 8 * fq + 4 * n + j : 256 * cur.pn + 128 * bj + 32 * wc + 16 * n + 4 * fq + j;
                const bf16_t* a = g.A + (size_t)row * g.lda; const bf16_t* b = g.Bt + (size_t)col * g.ldb; float s = 0.f;
                for (int k = kb[sg]; k < kb[sg + 1]; ++k) s += bf2f(a[k]) * bf2f(b[k]);
                acc[ai][bj][m][n][j] += s; }
            if constexpr (Epi::MIDK) { if (sg < 2) E.mid(acc, cur, wr, wc, fr, fq, sg); }
        }
        E(acc, cur, wr, wc, fr, fq, ui & 1);
    }
}
#endif
}

#ifndef CPU_EMU
#define XB_TMO      128
#define XB_XCNT(j)  (256  + 64 * (j))
#define XB_XSUB(j)  (1280 + 64 * (j))
#define XB_XGEN(j)  (2304 + 64 * (j))
#define XB_TOP      3328
#define XB_TOPGEN   3392
#define XCD_BAR_WORDS 3456
#define XB_SPIN_CAP (1u << 22)
__device__ __forceinline__ unsigned xb_ld(unsigned* p)              { return __hip_atomic_load(p, __ATOMIC_RELAXED, __HIP_MEMORY_SCOPE_AGENT); }
__device__ __forceinline__ unsigned xb_add(unsigned* p, unsigned v) { return __hip_atomic_fetch_add(p, v, __ATOMIC_RELAXED, __HIP_MEMORY_SCOPE_AGENT); }
__device__ __forceinline__ unsigned xb_xcc_id() { return (unsigned)__builtin_amdgcn_s_getreg((3 << 11) | 20) & 0xFu; }
#define XB_SPIN(cond, bar) do { unsigned _sp = 0; while (cond) { __builtin_amdgcn_s_sleep(1); \
    if ((++_sp & 255u) == 0u) { if (xb_ld(&(bar)[XB_TMO])) break; if (_sp > XB_SPIN_CAP) { atomicAdd(&(bar)[XB_TMO], 1u); break; } } } } while (0)
struct XcdBarrier { unsigned* bar; unsigned x; volatile LAS unsigned* st; };
__device__ __forceinline__ XcdBarrier xcd_barrier_post(unsigned* bar, volatile LAS unsigned* st) {
    XcdBarrier b; b.bar = bar; b.x = xb_xcc_id(); b.st = st;
    if (threadIdx.x == 0) (void)xb_add(&bar[XB_XCNT(b.x)], 1u);
    return b;
}
__device__ __forceinline__ void xcd_barrier_complete(unsigned* bar, unsigned x, unsigned& nloc, unsigned& nx) {
    const unsigned G = gridDim.x * gridDim.y * gridDim.z;
    unsigned sum, cnt, mine, sp = 0u;
    for (;;) {
        sum = 0u; cnt = 0u; mine = 0u;
#pragma unroll
        for (unsigned j = 0; j < 16; ++j) { const unsigned c = xb_ld(&bar[XB_XCNT(j)]); sum += c; cnt += (c > 0u) ? 1u : 0u; mine = (j == x) ? c : mine; }
        if (sum == G) break;
        __builtin_amdgcn_s_sleep(1);
        if ((++sp & 255u) == 0u) { if (xb_ld(&bar[XB_TMO])) break; if (sp > XB_SPIN_CAP) { atomicAdd(&bar[XB_TMO], 1u); break; } }
    }
    nloc = mine > 0u ? mine : 1u; nx = cnt > 0u ? cnt : 1u;
}
__device__ __forceinline__ void xcd_barrier(const XcdBarrier& b, int w0) {
    asm volatile("s_waitcnt vmcnt(0)" ::: "memory");
    __syncthreads();
    if (w0 == 0 && lane_id_v() == 0) {
        unsigned* bar = b.bar;
        __builtin_amdgcn_s_waitcnt(0);
        unsigned nloc = b.st[0], nx = b.st[1];
        if (nloc == 0u) { xcd_barrier_complete(bar, b.x, nloc, nx); b.st[0] = nloc; b.st[1] = nx; }
        const unsigned old = xb_add(&bar[XB_XSUB(b.x)], 1u);
        const unsigned gen = old / nloc;
        if (old + 1u == (gen + 1u) * nloc) {
            __builtin_amdgcn_fence(__ATOMIC_RELEASE, "agent");
            asm volatile("s_waitcnt vmcnt(0)" ::: "memory");
            const unsigned og = xb_add(&bar[XB_TOP], 1u);
            const unsigned tg = og / nx;
            if (og + 1u == (tg + 1u) * nx) xb_add(&bar[XB_TOPGEN], 1u);
            else XB_SPIN(xb_ld(&bar[XB_TOPGEN]) == tg, bar);
            __builtin_amdgcn_fence(__ATOMIC_ACQUIRE, "agent");
            xb_add(&bar[XB_XGEN(b.x)], 1u);
            asm volatile("s_waitcnt vmcnt(0)" ::: "memory");
        } else {
            XB_SPIN(xb_ld(&bar[XB_XGEN(b.x)]) == gen, bar);
            __builtin_amdgcn_fence(__ATOMIC_ACQUIRE, "agent");
            asm volatile("s_waitcnt vmcnt(0)" ::: "memory");
        }
    }
    __syncthreads();
}
#endif

enum { I_XP = 0, I_XS, I_PP, I_PS, I_F1N, I_F1G, I_F1U, I_F1D, I_MIXN, I_WIN, I_RELB, I_RETN, I_HLB, I_HGN, I_WBA, I_WBB, I_WBC, I_WMG, I_WOUT, I_F2N, I_F2G, I_F2U, I_F2D, I_PLEN, I_WPG, I_WPP, I_FINN, N_INPUTS };
struct Args { const float* in[N_INPUTS]; float* out; unsigned char* ws; int lo, hi; };

DEVFN float wave_sum(float v) {
#pragma unroll
    for (int o = 1; o < 64; o <<= 1) v += __shfl_xor(v, o);
    return v;
}
DEVFN void init_rows(const Args& a, bf16_t* H, float* ssq0, int gw, int ngw, int lane) {
    constexpr int NC = D / 256;
    for (int row = gw; row < T; row += ngw) {
        const float* src = row < NP ? a.in[I_XP] + (size_t)row * D : a.in[I_XS] + (size_t)(row - NP) * D;
        float s = 0.f;
#pragma unroll
        for (int j = 0; j < NC; ++j) { const int c = 4 * (lane + 64 * j); const u32x2 o = pk4(*(const f32x4*)(src + c)); *(u32x2*)(H + (size_t)row * D + c) = o;
            const float r0 = bflo(o.x), r1 = bfhi(o.x), r2 = bflo(o.y), r3 = bfhi(o.y); s += (r0 * r0 + r1 * r1) + (r2 * r2 + r3 * r3); }
        s = wave_sum(s);
        if (lane == 0) *(f32x4*)(ssq0 + 4 * (size_t)row) = (f32x4){s, 0.f, 0.f, 0.f};
    }
}
DEVFN void final_norm_rows(const bf16_t* H, float* out, const float* gfin, int gw, int ngw, int lane, float oscale) {
    constexpr int NC = D / 256;
    for (int row = gw; row < T; row += ngw) {
        f32x4 v[NC]; float s = 0.f;
#pragma unroll
        for (int j = 0; j < NC; ++j) { const u32x2 w = *(const u32x2*)(H + (size_t)row * D + 4 * (lane + 64 * j)); v[j] = (f32x4){bflo(w.x), bfhi(w.x), bflo(w.y), bfhi(w.y)}; s += (v[j][0] * v[j][0] + v[j][1] * v[j][1]) + (v[j][2] * v[j][2] + v[j][3] * v[j][3]); }
        const float rinv = rms_rinv(wave_sum(s)) * oscale;
#pragma unroll
        for (int j = 0; j < NC; ++j) { const int c = 4 * (lane + 64 * j); const f32x4 gq = *(const f32x4*)(gfin + c); *(f32x4*)(out + (size_t)row * D + c) = v[j] * rinv * gq; }
    }
}
DEVFN void cvt_ple(const Args& a, int l, bf16_t* PB, int gtid, int nthr) {
    for (size_t it = gtid; it < (size_t)T * D_PLE / 8; it += nthr) {
        const size_t e = it * 8; const int row = (int)(e / D_PLE), c = (int)(e % D_PLE);
        const float* src = row < NP ? a.in[I_PP] + ((size_t)l * NP + row) * D_PLE + c : a.in[I_PS] + ((size_t)l * NS + (row - NP)) * D_PLE + c;
        const f32x4 x = *(const f32x4*)src, y = *(const f32x4*)(src + 4);
        u32x4 w; w.x = pk2(x[0], x[1]); w.y = pk2(x[2], x[3]); w.z = pk2(y[0], y[1]); w.w = pk2(y[2], y[3]);
        *(u32x4*)(PB + e) = w;
    }
}
DEVFN int t5_bucket(int rel) {
    const int ret = rel > 0 ? 16 : 0; const int n = rel < 0 ? -rel : rel;
    if (n < 8) return ret + n;
    int large = 8 + (int)(logf((float)n / 8.0f) / logf(128.0f) * 8.0f);
    large = large < 15 ? large : 15;
    return ret + large;
}
DEVFN void prologue_tables(const Args& a, float* rope, float* biasT, float* lbs, int gtid, int nthr) {
    for (int it = gtid; it < 4096 * 64; it += nthr) { const int pos = it >> 6, i = it & 63;
        const float inv = powf(10000.0f, -(float)i / 64.0f); const float ang = (float)pos * inv;
        rope[it] = cosf(ang); rope[4096 * 64 + it] = sinf(ang); }
    for (int it = gtid; it < 3 * 4 * 160; it += nthr) { const int idx = it % 160, gh = it / 160, g = gh >> 2, hh = gh & 3; const int o = idx - 16; const int dil = g == 0 ? 1 : (g == 1 ? 4 : 16);
        biasT[it] = (o >= 0 && o <= 128) ? a.in[I_RELB][t5_bucket((o - 64) * dil) * 12 + 4 * g + hh] : -1e30f; }
    for (int c = gtid; c < 512; c += nthr) {
        float mx = -3.0e38f; for (int l = 0; l < DEPTH; ++l) mx = fmaxf(mx, a.in[I_HLB][l * 512 + c]);
        float den = 0.f; for (int l = 0; l < DEPTH; ++l) den += expf(a.in[I_HLB][l * 512 + c] - mx);
        float cum = 0.f, first = 0.f;
        for (int l = 0; l < DEPTH; ++l) { cum += expf(a.in[I_HLB][l * 512 + c] - mx) / den; if (l == 0) first = cum; lbs[l * 512 + c] = cum - first; }
    }
}
DEVFN int rowmap(int mode, int nl) {
    if (mode == 1) return (nl >> 7) * 256 + (nl & 127);
    if (mode == 2) return (nl >> 7) * 256 + 128 + (nl & 127);
    if (mode == 3) { const int dl = nl & 127, nn = dl >> 6, rem = dl & 63; return (nl & ~127) + 8 * (rem >> 2) + 4 * nn + (rem & 3); }
    return nl;
}
struct CvtDesc { const float* W; int K, ldw, col0, ncols; bf16_t* dst; int ldd, koff, mode, row_off; const float* gain; float cscale; };
DEVFN void cvt_item(const CvtDesc& d, int item, LAS float* scr, int lane) {
    const int nblk = d.ncols / 32, kb = item / nblk, nb = item % nblk, k0 = 64 * kb, n0 = 32 * nb;
#pragma unroll
    for (int i = 0; i < 8; ++i) { const int kk = 8 * i + (lane >> 3), n4 = 4 * (lane & 7); const float gsc = (d.gain ? d.gain[k0 + kk] : 1.0f) * d.cscale;
        const f32x4 w = *(const f32x4*)(d.W + (size_t)(k0 + kk) * d.ldw + d.col0 + n0 + n4) * gsc;
        LAS float* p = scr + kk * 33 + n4; p[0] = w[0]; p[1] = w[1]; p[2] = w[2]; p[3] = w[3]; }
    __builtin_amdgcn_wave_barrier();
    const int c = lane & 7;
#pragma unroll
    for (int j = 0; j < 4; ++j) { const int n = (lane >> 3) + 8 * j; const LAS float* s = scr + (8 * c) * 33 + n;
        u32x4 o; o.x = pk2(s[0 * 33], s[1 * 33]); o.y = pk2(s[2 * 33], s[3 * 33]); o.z = pk2(s[4 * 33], s[5 * 33]); o.w = pk2(s[6 * 33], s[7 * 33]);
        *(u32x4*)(d.dst + (size_t)(d.row_off + rowmap(d.mode, n0 + n)) * d.ldd + d.koff + k0 + 8 * c) = o; }
    __builtin_amdgcn_wave_barrier();
}
constexpr int N_CVT = 18;
DEVFN CvtDesc cvt_desc(const Args& a, int l, bf16_t* WB, int i) {
    CvtDesc d; d.col0 = 0; d.koff = 0; d.mode = 0; d.row_off = 0; d.gain = nullptr; d.cscale = 1.0f;
    const float* win = a.in[I_WIN] + (size_t)l * D * N_IN;
    switch (i) {
    case 0: d.W = a.in[I_F1G] + (size_t)l * D * FF; d.K = D; d.ldw = FF; d.ncols = FF; d.dst = WB + WE_GU1; d.ldd = D; d.mode = 1; d.gain = a.in[I_F1N] + l * D; break;
    case 1: d.W = a.in[I_F1U] + (size_t)l * D * FF; d.K = D; d.ldw = FF; d.ncols = FF; d.dst = WB + WE_GU1; d.ldd = D; d.mode = 2; d.gain = a.in[I_F1N] + l * D; break;
    case 2: d.W = a.in[I_F1D] + (size_t)l * FF * D; d.K = FF; d.ldw = D; d.ncols = D; d.dst = WB + WE_D1; d.ldd = FF; break;
    case 3: d.W = win; d.K = D; d.ldw = N_IN; d.col0 = 0; d.ncols = 768; d.dst = WB + WE_IN; d.ldd = D; d.gain = a.in[I_MIXN] + l * D; d.cscale = 0.125f; break;
    case 4: d.W = win; d.K = D; d.ldw = N_IN; d.col0 = 768; d.ncols = 1536; d.dst = WB + WE_IN; d.ldd = D; d.row_off = 768; d.gain = a.in[I_MIXN] + l * D; break;
    case 5: d.W = win; d.K = D; d.ldw = N_IN; d.col0 = OFF_QB; d.ncols = 512; d.dst = WB + WE_IN; d.ldd = D; d.row_off = OFF_QB; d.mode = 3; d.gain = a.in[I_MIXN] + l * D; break;
    case 6: d.W = win; d.K = D; d.ldw = N_IN; d.col0 = OFF_KB; d.ncols = 512; d.dst = WB + WE_IN; d.ldd = D; d.row_off = OFF_KB; d.mode = 3; d.gain = a.in[I_MIXN] + l * D; d.cscale = 0.08838834764831845f; break;
    case 7: d.W = win; d.K = D; d.ldw = N_IN; d.col0 = OFF_VB; d.ncols = N_IN - OFF_VB; d.dst = WB + WE_IN; d.ldd = D; d.row_off = OFF_VB; d.gain = a.in[I_MIXN] + l * D; break;
    case 8: d.W = a.in[I_WMG] + (size_t)l * D * 3 * D; d.K = D; d.ldw = 3 * D; d.ncols = 3 * D; d.dst = WB + WE_IN; d.ldd = D; d.row_off = OFF_MG; d.gain = a.in[I_MIXN] + l * D; break;
    case 9: d.W = a.in[I_WBA] + (size_t)l * 256 * D; d.K = 256; d.ldw = D; d.ncols = D; d.dst = WB + WE_BR; d.ldd = MIXW; d.koff = 0; break;
    case 10: d.W = a.in[I_WBB] + (size_t)l * 512 * D; d.K = 512; d.ldw = D; d.ncols = D; d.dst = WB + WE_BR; d.ldd = MIXW; d.koff = 256; break;
    case 11: d.W = a.in[I_WBC] + (size_t)l * 512 * D; d.K = 512; d.ldw = D; d.ncols = D; d.dst = WB + WE_BR; d.ldd = MIXW; d.koff = 768; break;
    case 12: d.W = a.in[I_WOUT] + (size_t)l * D * D; d.K = D; d.ldw = D; d.ncols = D; d.dst = WB + WE_OUT; d.ldd = D; break;
    case 13: d.W = a.in[I_F2G] + (size_t)l * D * FF; d.K = D; d.ldw = FF; d.ncols = FF; d.dst = WB + WE_GU2; d.ldd = D; d.mode = 1; d.gain = a.in[I_F2N] + l * D; break;
    case 14: d.W = a.in[I_F2U] + (size_t)l * D * FF; d.K = D; d.ldw = FF; d.ncols = FF; d.dst = WB + WE_GU2; d.ldd = D; d.mode = 2; d.gain = a.in[I_F2N] + l * D; break;
    case 15: d.W = a.in[I_F2D] + (size_t)l * FF * D; d.K = FF; d.ldw = D; d.ncols = D; d.dst = WB + WE_D2; d.ldd = FF; break;
    case 16: d.W = a.in[I_WPG] + (size_t)l * D * D; d.K = D; d.ldw = D; d.ncols = D; d.dst = WB + WE_PG; d.ldd = D; d.gain = a.in[I_PLEN] + l * D; break;
    default: d.W = a.in[I_WPP] + (size_t)l * D_PLE * D; d.K = D_PLE; d.ldw = D; d.ncols = D; d.dst = WB + WE_PP; d.ldd = D_PLE; break;
    }
    return d;
}
DEVFN void convert_weights(const Args& a, int l, bf16_t* WB, LAS unsigned char* lds, int gw, int ngw, int wave, int lane) {
    LAS float* scr = (LAS float*)(lds + wave * 8704);
    for (int i = 0; i < N_CVT; ++i) {
        const CvtDesc d = cvt_desc(a, l, WB, i);
        const int nitems = (d.K / 64) * (d.ncols / 32);
        for (int it = gw; it < nitems; it += ngw) cvt_item(d, it, scr, lane);
    }
}

#ifndef CPU_EMU
DEVFN s16x4 lds_tr(const LAS bf16_t* p) { return __builtin_amdgcn_ds_read_tr16_b64_v4i16((LAS s16x4*)p); }
#else
s16x4 lds_tr(const bf16_t* p);
#endif
DEVFN bf16x8 tr8(const LAS bf16_t* X, int stride, int r0, int col0, int c16, int g4) {
    const LAS bf16_t* p = X + (r0 + 8 * g4 + (c16 >> 2)) * stride + col0 + 4 * (c16 & 3);
    return cat8(lds_tr(p), lds_tr(p + 4 * stride));
}
DEVFN bf16x8 tr8p(const LAS bf16_t* X, int stride, int r0, int col0, int c16, int g4) {
    const LAS bf16_t* p = X + (r0 + 4 * g4 + (c16 >> 2)) * stride + col0 + 4 * (c16 & 3);
    return cat8(lds_tr(p), lds_tr(p + 16 * stride));
}
DEVFN u32x4 scale8(u32x4 v, float s) {
    u32x4 o; o.x = pk2(bflo(v.x) * s, bfhi(v.x) * s); o.y = pk2(bflo(v.y) * s, bfhi(v.y) * s); o.z = pk2(bflo(v.z) * s, bfhi(v.z) * s); o.w = pk2(bflo(v.w) * s, bfhi(v.w) * s); return o;
}
template <class U> DEVFN void run_units(LAS unsigned char* lds, const U& ctx, int u0, int u1) {
    if (u0 >= u1) return;
    typename U::Regs L = ctx.load(u0);
    for (int u = u0; u < u1; ++u) {
        __syncthreads();
        ctx.stage(lds, L);
        const typename U::Regs N = ctx.load(u + 1 < u1 ? u + 1 : u);
        __syncthreads();
        ctx.compute(lds, L, u);
        L = N;
    }
}

template <class U, class F> DEVFN void run_units_k(LAS unsigned char* lds, const U& ctx, int u0, int u1, typename U::Regs L, F tail) {
    if (u0 >= u1) { tail(); return; }
    for (int u = u0; u + 1 < u1; ++u) {
        __syncthreads();
        ctx.stage(lds, L);
        const typename U::Regs N = ctx.load(u + 1);
        __syncthreads();
        ctx.compute(lds, L, u);
        L = N;
    }
    __syncthreads();
    ctx.stage(lds, L);
    tail();
    __syncthreads();
    int ul = u1 - 1; OPAQUE_SI(ul);
    ctx.compute(lds, L, ul);
}
template <class U> DEVFN void run_units2(LAS unsigned char* lds, const U& ctx, int u0, int u1) {
    if (u0 >= u1) return;
    typename U::Regs L; ctx.load1(L, u0); ctx.load2(L, u0);
    for (int u = u0; u < u1; ++u) {
        __syncthreads();
        ctx.stage(lds, L);
        typename U::Regs N; const int nu = u + 1 < u1 ? u + 1 : u;
        ctx.load1(N, nu);
        __syncthreads();
        ctx.compute(lds, L, u, N, nu);
        L = N;
    }
}
template <class U> DEVFN void run_units2_k(LAS unsigned char* lds, const U& ctx, int u0, int u1, typename U::Regs L) {
    if (u0 >= u1) return;
    ctx.load2(L, u0);
    for (int u = u0; u < u1; ++u) {
        __syncthreads();
        ctx.stage(lds, L);
        typename U::Regs N; const int nu = u + 1 < u1 ? u + 1 : u;
        ctx.load1(N, nu);
        __syncthreads();
        ctx.compute(lds, L, u, N, nu);
        L = N;
    }
}
struct AUnit {
    const bf16_t* Z; bf16_t* AO; float* LSE; const float* biasT; int S; int w0;
    struct Regs { u32x4 kv[4], vv[4]; bf16x8 bq[2]; f32x4 b; };
    struct Idx { int hh, g, dil, L, cb, head, rowbase, k0; };
    DEVFN Idx decode(int unit) const {
        Idx x; const int upb = S / 128; const int ub = unit % upb; int t = unit / upb; x.hh = t & 3; t >>= 2; x.g = t % 3; const int seq = t / 3;
        x.dil = x.g == 0 ? 1 : (x.g == 1 ? 4 : 16); x.L = S / x.dil; const int bpr = x.L / 128; const int r = ub / bpr; x.cb = ub % bpr;
        x.head = 4 * x.g + x.hh; x.rowbase = seq * S + r; x.k0 = 128 * x.cb - 64; return x;
    }
    DEVFN Regs load(int unit) const {
        const int tid = opaque_tid(w0), lane = tid & 63, w = tid >> 6, c16 = lane & 15, g4 = lane >> 4; const Idx x = decode(unit); Regs R;
#pragma unroll
        for (int i = 0; i < 4; ++i) {
            const int id = tid + 512 * i, key = id >> 3, ch = id & 7, ik = x.k0 + key;
            const int ikc = ik < 0 ? 0 : (ik < x.L ? ik : x.L - 1); const int zr = x.rowbase + ikc * x.dil;
            R.kv[i] = *(const u32x4*)(Z + zoff(OFF_KA, 64, x.head, zr, 8 * ch)); R.vv[i] = *(const u32x4*)(Z + zoff(OFF_VA, 64, x.head, zr, 8 * ch));
        }
        R.b = (f32x4){tid < 160 ? biasT[(x.g * 4 + x.hh) * 160 + tid] : 0.f, 0.f, 0.f, 0.f};
        const size_t qrow = (size_t)(x.rowbase + (128 * x.cb + 16 * w + c16) * x.dil);
#pragma unroll
        for (int ks = 0; ks < 2; ++ks) R.bq[ks] = *(const bf16x8*)(Z + zoff(OFF_QA, 64, x.head, (int)qrow, 32 * ks + 8 * g4));
        return R;
    }
    DEVFN void stage(LAS unsigned char* lds, const Regs& R) const {
        const int tid = opaque_tid(w0);
        LAS bf16_t* Ks = (LAS bf16_t*)lds; LAS bf16_t* Vs = (LAS bf16_t*)(lds + 256 * 72 * 2); LAS float* bs = (LAS float*)(lds + 2 * 256 * 72 * 2);
#pragma unroll
        for (int i = 0; i < 4; ++i) { const int id = tid + 512 * i, key = id >> 3, ch = id & 7; *(LAS u32x4*)(Ks + key * 72 + 8 * ch) = R.kv[i]; *(LAS u32x4*)(Vs + key * 72 + 8 * ch) = R.vv[i]; }
        if (tid < 160) bs[tid] = R.b[0];
    }
    DEVFN void compute(LAS unsigned char* lds, const Regs& R, int unit) const {
        const int tid = opaque_tid(w0), lane = tid & 63, w = tid >> 6, c16 = lane & 15, g4 = lane >> 4; const Idx x = decode(unit);
        const LAS bf16_t* Ks = (const LAS bf16_t*)lds; const LAS bf16_t* Vs = (const LAS bf16_t*)(lds + 256 * 72 * 2); const LAS float* bs = (const LAS float*)(lds + 2 * 256 * 72 * 2);
        const size_t qrow = (size_t)(x.rowbase + (128 * x.cb + 16 * w + c16) * x.dil);
        f32x4 sc[9]; float mx = -3.0e38f;
        f32x4 bv[9];
#pragma unroll
        for (int kt = 0; kt < 9; ++kt)
#pragma unroll
            for (int rr = 0; rr < 4; ++rr) bv[kt][rr] = bs[16 * kt + 4 * g4 + rr - c16 + 16];
        OPAQUE_V9(bv);
#pragma unroll
        for (int kt = 0; kt < 9; ++kt) {
            f32x4 acc = {0.f, 0.f, 0.f, 0.f};
#pragma unroll
            for (int ks = 0; ks < 2; ++ks) acc = mfma16(*(const LAS bf16x8*)(Ks + (16 * (w + kt) + c16) * 72 + 32 * ks + 8 * g4), R.bq[ks], acc);
#pragma unroll
            for (int rr = 0; rr < 4; ++rr) {
                const int ik = x.k0 + 16 * (w + kt) + 4 * g4 + rr;
                const float s = (unsigned)ik < (unsigned)x.L ? acc[rr] + bv[kt][rr] : -1e30f;
                acc[rr] = s; mx = fmaxf(mx, s);
            }
            sc[kt] = acc;
        }
        mx = fmaxf(mx, __shfl_xor(mx, 16)); mx = fmaxf(mx, __shfl_xor(mx, 32));
        float sum = 0.f;
#pragma unroll
        for (int kt = 0; kt < 9; ++kt)
#pragma unroll
            for (int rr = 0; rr < 4; ++rr) { const float p = fexp(sc[kt][rr] - mx); sc[kt][rr] = p; sum += p; }
        sum += __shfl_xor(sum, 16); sum += __shfl_xor(sum, 32);
        bf16x8 bp[5];
        const f32x4 zero4 = {0.f, 0.f, 0.f, 0.f};
#pragma unroll
        for (int pp = 0; pp < 5; ++pp) bp[pp] = pack8(sc[2 * pp], pp < 4 ? sc[2 * pp + 1] : zero4);
        const float inv = 1.0f / sum;
#pragma unroll
        for (int dt = 0; dt < 4; ++dt) {
            f32x4 acc = {0.f, 0.f, 0.f, 0.f};
#pragma unroll
            for (int pp = 0; pp < 5; ++pp) {
                const LAS bf16_t* p = Vs + (16 * (w + 2 * pp) + 4 * g4 + (c16 >> 2)) * 72 + 16 * dt + 4 * (c16 & 3);
                acc = mfma16(cat8(lds_tr(p), lds_tr(p + (pp < 4 ? 16 * 72 : 0))), bp[pp], acc);
            }
            *(u32x2*)(AO + qrow * AOW + x.head * 64 + 16 * dt + 4 * g4) = pk4(acc * inv);
        }
        if (g4 == 0) LSE[qrow * 12 + x.head] = mx + logf(sum);
    }
};
DEVFN void mixer_a_merge(const bf16_t* AO, const float* LSE, bf16_t* MIX, int gtid, int nthr) {
    for (int it = gtid; it < SLAB * 32; it += nthr) {
        const int row = it >> 5, hh = (it >> 3) & 3, c = it & 7;
        const float l0 = LSE[(size_t)row * 12 + hh], l1 = LSE[(size_t)row * 12 + 4 + hh], l2 = LSE[(size_t)row * 12 + 8 + hh];
        const float m = fmaxf(l0, fmaxf(l1, l2)); float w0 = fexp(l0 - m), w1 = fexp(l1 - m), w2 = fexp(l2 - m); const float inv = 1.0f / (w0 + w1 + w2); w0 *= inv; w1 *= inv; w2 *= inv;
        const u32x4 a0 = *(const u32x4*)(AO + (size_t)row * AOW + hh * 64 + 8 * c), a1 = *(const u32x4*)(AO + (size_t)row * AOW + (4 + hh) * 64 + 8 * c), a2 = *(const u32x4*)(AO + (size_t)row * AOW + (8 + hh) * 64 + 8 * c);
        u32x4 o;
        o.x = pk2(w0 * bflo(a0.x) + w1 * bflo(a1.x) + w2 * bflo(a2.x), w0 * bfhi(a0.x) + w1 * bfhi(a1.x) + w2 * bfhi(a2.x));
        o.y = pk2(w0 * bflo(a0.y) + w1 * bflo(a1.y) + w2 * bflo(a2.y), w0 * bfhi(a0.y) + w1 * bfhi(a1.y) + w2 * bfhi(a2.y));
        o.z = pk2(w0 * bflo(a0.z) + w1 * bflo(a1.z) + w2 * bflo(a2.z), w0 * bfhi(a0.z) + w1 * bfhi(a1.z) + w2 * bfhi(a2.z));
        o.w = pk2(w0 * bflo(a0.w) + w1 * bflo(a1.w) + w2 * bflo(a2.w), w0 * bfhi(a0.w) + w1 * bfhi(a1.w) + w2 * bfhi(a2.w));
        *(u32x4*)(MIX + (size_t)row * MIXW + hh * 64 + 8 * c) = o;
    }
}

struct BKvUnit {
    const bf16_t* Z; bf16_t* SB; int w0;
    struct Regs { u32x4 kv[4], vv[4]; };
    DEVFN Regs load(int unit) const {
        const int tid = opaque_tid(w0); const int h = unit & 3, row0 = (unit >> 2) * 128; Regs R;
#pragma unroll
        for (int i = 0; i < 4; ++i) { const int id = tid + 512 * i, j = id >> 4, ch = id & 15; R.kv[i] = *(const u32x4*)(Z + zoff(OFF_KB, 128, h, row0 + j, 8 * ch)); R.vv[i] = *(const u32x4*)(Z + zoff(OFF_VB, 128, h, row0 + j, 8 * ch)); }
        return R;
    }
    DEVFN void stage(LAS unsigned char* lds, const Regs& R) const { (void)lds; (void)R; }
    DEVFN void compute(LAS unsigned char* lds, const Regs& R, int unit) const {
        const int tid = opaque_tid(w0), lane = tid & 63, w = tid >> 6, c16 = lane & 15, g4 = lane >> 4;
        const int h = unit & 3;
        LAS bf16_t* Ks = (LAS bf16_t*)lds;
        LAS bf16_t* Vf = (LAS bf16_t*)(lds + 128 * 136 * 2);
        LAS bf16_t* Vb = (LAS bf16_t*)(lds + 2 * 128 * 136 * 2);
        const float l2f = ret_l2(0, h), l2b = ret_l2(1, h);
#pragma unroll
        for (int i = 0; i < 4; ++i) {
            const int id = tid + 512 * i, j = id >> 4, ch = id & 15;
            *(LAS u32x4*)(Ks + j * 136 + 8 * ch) = R.kv[i];
            *(LAS u32x4*)(Vf + j * 136 + 8 * ch) = scale8(R.vv[i], exp2f((float)(127 - j) * l2f));
            *(LAS u32x4*)(Vb + j * 136 + 8 * ch) = scale8(R.vv[i], exp2f((float)j * l2b));
        }
        __syncthreads();
        bf16x8 af[4];
#pragma unroll
        for (int ks = 0; ks < 4; ++ks) af[ks] = tr8(Ks, 136, 32 * ks, 16 * w, c16, g4);
#pragma unroll
        for (int dir = 0; dir < 2; ++dir) {
            const LAS bf16_t* V = dir ? Vb : Vf;
            bf16_t* dst = SB + ((size_t)unit * 2 + dir) * 16384;
#pragma unroll
            for (int b = 0; b < 8; ++b) {
                f32x4 acc = {0.f, 0.f, 0.f, 0.f};
#pragma unroll
                for (int ks = 0; ks < 4; ++ks) acc = mfma16(af[ks], tr8(V, 136, 32 * ks, 16 * b, c16, g4), acc);
                *(u32x2*)(dst + (16 * b + c16) * 128 + 16 * w + 4 * g4) = pk4(acc);
            }
        }
    }
};
DEVFN void mixer_scan(bf16_t* SB, bf16_t* SC, const float* GC, int nseq, int S, int gtid, int nthr) {
    const int nb = S / 128, nc = S / 64;
    for (int it = gtid; it < nseq * 8 * 2048; it += nthr) {
        const int e8 = it & 2047; int t = it >> 11; const int dir = t & 1, h = (t >> 1) & 3, seq = t >> 3;
        const float G = exp2f(128.0f * ret_l2(dir, h));
        float carry[8];
#pragma unroll
        for (int j = 0; j < 8; ++j) carry[j] = 0.f;
        for (int cc = 0; cc < nb; ++cc) {
            const int c = dir ? nb - 1 - cc : cc;
            bf16_t* p = SB + ((size_t)((seq * nb + c) * 4 + h) * 2 + dir) * 16384 + e8 * 8;
            const u32x4 v = *(const u32x4*)p;
            u32x4 o; o.x = pk2(carry[0], carry[1]); o.y = pk2(carry[2], carry[3]); o.z = pk2(carry[4], carry[5]); o.w = pk2(carry[6], carry[7]);
            *(u32x4*)p = o;
            carry[0] = carry[0] * G + bflo(v.x); carry[1] = carry[1] * G + bfhi(v.x); carry[2] = carry[2] * G + bflo(v.y); carry[3] = carry[3] * G + bfhi(v.y);
            carry[4] = carry[4] * G + bflo(v.z); carry[5] = carry[5] * G + bfhi(v.z); carry[6] = carry[6] * G + bflo(v.w); carry[7] = carry[7] * G + bfhi(v.w);
        }
    }
    for (int it = gtid; it < nseq * 8 * 2048; it += nthr) {
        const int e8 = it & 2047; int t = it >> 11; const int dir = t & 1, h = (t >> 1) & 3, seq = t >> 3;
        const int dk0 = (e8 & 15) * 8;
        float carry[8];
#pragma unroll
        for (int j = 0; j < 8; ++j) carry[j] = 0.f;
        for (int cc = 0; cc < nc; ++cc) {
            const int c = dir ? nc - 1 - cc : cc;
            const size_t ui = (size_t)((seq * nc + c) * 4 + h) * 2 + dir;
            bf16_t* p = SC + ui * 16384 + e8 * 8;
            const f32x4 g0 = *(const f32x4*)(GC + ui * 128 + dk0), g1 = *(const f32x4*)(GC + ui * 128 + dk0 + 4);
            const u32x4 v = *(const u32x4*)p;
            u32x4 o; o.x = pk2(carry[0], carry[1]); o.y = pk2(carry[2], carry[3]); o.z = pk2(carry[4], carry[5]); o.w = pk2(carry[6], carry[7]);
            *(u32x4*)p = o;
            carry[0] = carry[0] * g0[0] + bflo(v.x); carry[1] = carry[1] * g0[1] + bfhi(v.x); carry[2] = carry[2] * g0[2] + bflo(v.y); carry[3] = carry[3] * g0[3] + bfhi(v.y);
            carry[4] = carry[4] * g1[0] + bflo(v.z); carry[5] = carry[5] * g1[1] + bfhi(v.z); carry[6] = carry[6] * g1[2] + bflo(v.w); carry[7] = carry[7] * g1[3] + bfhi(v.w);
        }
    }
}
struct BOutUnit {
    const bf16_t* Z; const bf16_t* SB; bf16_t* MIX; const float* gain; int w0;
    struct Regs { u32x4 kv[4], vv[4], sf[4], sb[4]; bf16x8 bq[4]; f32x4 gn; };
    DEVFN Regs load(int unit) const {
        const int tid = opaque_tid(w0), lane = tid & 63, w = tid >> 6, c16 = lane & 15, g4 = lane >> 4; const int h = unit & 3, row0 = (unit >> 2) * 128; Regs R;
        const bf16_t* gSf = SB + ((size_t)unit * 2 + 0) * 16384; const bf16_t* gSb = SB + ((size_t)unit * 2 + 1) * 16384;
#pragma unroll
        for (int i = 0; i < 4; ++i) {
            const int id = tid + 512 * i, j = id >> 4, ch = id & 15;
            R.kv[i] = *(const u32x4*)(Z + zoff(OFF_KB, 128, h, row0 + j, 8 * ch)); R.vv[i] = *(const u32x4*)(Z + zoff(OFF_VB, 128, h, row0 + j, 8 * ch)); R.sf[i] = *(const u32x4*)(gSf + j * 128 + 8 * ch); R.sb[i] = *(const u32x4*)(gSb + j * 128 + 8 * ch);
        }
        const size_t row = (size_t)(row0 + 16 * w + c16);
#pragma unroll
        for (int ks = 0; ks < 4; ++ks) R.bq[ks] = *(const bf16x8*)(Z + zoff(OFF_QB, 128, h, (int)row, 32 * ks + 8 * g4));
        R.gn = (f32x4){gain[h * 128 + (tid & 127)], 0.f, 0.f, 0.f};
        return R;
    }
    DEVFN void stage(LAS unsigned char* lds, const Regs& R) const {
        const int tid = opaque_tid(w0);
        LAS bf16_t* Ks = (LAS bf16_t*)lds; LAS bf16_t* Vs = (LAS bf16_t*)(lds + 128 * 136 * 2); LAS bf16_t* Sf = (LAS bf16_t*)(lds + 2 * 128 * 136 * 2); LAS bf16_t* Sb = (LAS bf16_t*)(lds + 3 * 128 * 136 * 2);
#pragma unroll
        for (int i = 0; i < 4; ++i) { const int id = tid + 512 * i, j = id >> 4, ch = id & 15; const int o = j * 136 + 8 * ch;
            *(LAS u32x4*)(Ks + o) = R.kv[i]; *(LAS u32x4*)(Vs + o) = R.vv[i]; *(LAS u32x4*)(Sf + o) = R.sf[i]; *(LAS u32x4*)(Sb + o) = R.sb[i]; }
        if (tid < 128) ((LAS float*)(lds + 4 * 128 * 136 * 2))[tid] = R.gn[0];
    }
    DEVFN void compute(LAS unsigned char* lds, const Regs& R, int unit) const {
        const int tid = opaque_tid(w0), lane = tid & 63, w = tid >> 6, c16 = lane & 15, g4 = lane >> 4;
        const int h = unit & 3, row0 = (unit >> 2) * 128;
        const LAS bf16_t* Ks = (const LAS bf16_t*)lds;
        const LAS bf16_t* Vs = (const LAS bf16_t*)(lds + 128 * 136 * 2);
        const LAS bf16_t* Sf = (const LAS bf16_t*)(lds + 2 * 128 * 136 * 2);
        const LAS bf16_t* Sb = (const LAS bf16_t*)(lds + 3 * 128 * 136 * 2);
        const LAS float* gtab = (const LAS float*)(lds + 4 * 128 * 136 * 2);
        const float l2f = ret_l2(0, h), l2b = ret_l2(1, h);
        const int i = 16 * w + c16; const size_t row = (size_t)(row0 + i);
        u32x2 gwv[8];
#pragma unroll
        for (int dvt = 0; dvt < 8; ++dvt) gwv[dvt] = *(const u32x2*)(Z + zoff(OFF_GB, 128, h, (int)row, 16 * dvt + 4 * g4));
        f32x4 P[8];
#pragma unroll
        for (int jt = 0; jt < 8; ++jt) {
            f32x4 acc = {0.f, 0.f, 0.f, 0.f};
#pragma unroll
            for (int ks = 0; ks < 4; ++ks) acc = mfma16(*(const LAS bf16x8*)(Ks + (16 * jt + c16) * 136 + 32 * ks + 8 * g4), R.bq[ks], acc);
#pragma unroll
            for (int rr = 0; rr < 4; ++rr) { const int d = i - (16 * jt + 4 * g4 + rr); const float wgt = d > 0 ? exp2f((float)d * l2f) : (d < 0 ? exp2f((float)(-d) * l2b) : 2.0f); acc[rr] *= wgt; }
            P[jt] = acc;
        }
        bf16x8 bp[4];
#pragma unroll
        for (int k2 = 0; k2 < 4; ++k2) bp[k2] = pack8(P[2 * k2], P[2 * k2 + 1]);
        const float cf = exp2f((float)(i + 1) * l2f), cb = exp2f((float)(128 - i) * l2b);
        f32x4 o[8]; float s1 = 0.f;
#pragma unroll
        for (int dvt = 0; dvt < 8; ++dvt) {
            f32x4 aO = {0.f, 0.f, 0.f, 0.f}, aF = {0.f, 0.f, 0.f, 0.f}, aB = {0.f, 0.f, 0.f, 0.f};
#pragma unroll
            for (int k2 = 0; k2 < 4; ++k2) aO = mfma16(tr8p(Vs, 136, 32 * k2, 16 * dvt, c16, g4), bp[k2], aO);
#pragma unroll
            for (int ks = 0; ks < 4; ++ks) {
                aF = mfma16(*(const LAS bf16x8*)(Sf + (16 * dvt + c16) * 136 + 32 * ks + 8 * g4), R.bq[ks], aF);
                aB = mfma16(*(const LAS bf16x8*)(Sb + (16 * dvt + c16) * 136 + 32 * ks + 8 * g4), R.bq[ks], aB);
            }
            o[dvt] = aO + aF * cf + aB * cb;
            s1 += (o[dvt][0] + o[dvt][1]) + (o[dvt][2] + o[dvt][3]);
            EPI_FENCE();
        }
        s1 += __shfl_xor(s1, 16); s1 += __shfl_xor(s1, 32);
        const float mu = s1 * (1.0f / 128.0f); float s2 = 0.f;
#pragma unroll
        for (int dvt = 0; dvt < 8; ++dvt) { o[dvt] = o[dvt] - mu; s2 += (o[dvt][0] * o[dvt][0] + o[dvt][1] * o[dvt][1]) + (o[dvt][2] * o[dvt][2] + o[dvt][3] * o[dvt][3]); }
        s2 += __shfl_xor(s2, 16); s2 += __shfl_xor(s2, 32);
        const float rstd = 1.0f / sqrtf(s2 * (1.0f / 128.0f) + EPS);
#pragma unroll
        for (int dvt = 0; dvt < 8; ++dvt) {
            const int col = h * 128 + 16 * dvt + 4 * g4;
            const f32x4 gn = *(const LAS f32x4*)(gtab + 16 * dvt + 4 * g4); const u32x2 gw = gwv[dvt];
            f32x4 v = o[dvt] * rstd * gn; v[0] *= bflo(gw.x); v[1] *= bfhi(gw.x); v[2] *= bflo(gw.y); v[3] *= bfhi(gw.y);
            *(u32x2*)(MIX + row * MIXW + 256 + col) = pk4(v);
        }
    }
};

struct CRegs { u32x4 lf[4], v[2]; };
DEVFN CRegs c_load_common(const bf16_t* Z, int row0, int h, int tid) {
    CRegs R;
#pragma unroll
    for (int i = 0; i < 4; ++i) { const int id = tid + 512 * i, dir = id >> 10, j = (id >> 4) & 63, ch = id & 15; R.lf[i] = *(const u32x4*)(Z + zoff(OFF_FCF + dir * 512, 128, h, row0 + j, 8 * ch)); }
#pragma unroll
    for (int i = 0; i < 2; ++i) { const int id = tid + 512 * i, j = id >> 4, ch = id & 15; R.v[i] = *(const u32x4*)(Z + zoff(OFF_IC, 128, h, row0 + j, 8 * ch)); }
    return R;
}
DEVFN void c_stage_common(LAS float* LF, LAS bf16_t* Vs, const CRegs& R, int tid) {
#pragma unroll
    for (int i = 0; i < 4; ++i) {
        const int id = tid + 512 * i, dir = id >> 10, j = (id >> 4) & 63, ch = id & 15; const u32x4 v = R.lf[i];
        LAS float* d = LF + (dir * 64 + j) * 128 + 8 * ch;
        f32x4 a, b; a[0] = h2f(v.x & 0xffffu); a[1] = h2f(v.x >> 16); a[2] = h2f(v.y & 0xffffu); a[3] = h2f(v.y >> 16); b[0] = h2f(v.z & 0xffffu); b[1] = h2f(v.z >> 16); b[2] = h2f(v.w & 0xffffu); b[3] = h2f(v.w >> 16);
        *(LAS f32x4*)d = a; *(LAS f32x4*)(d + 4) = b;
    }
#pragma unroll
    for (int i = 0; i < 2; ++i) { const int id = tid + 512 * i, j = id >> 4, ch = id & 15; *(LAS u32x4*)(Vs + j * 136 + 8 * ch) = R.v[i]; }
}
struct CKvUnit {
    const bf16_t* Z; bf16_t* SC; float* GC; int w0;
    struct Regs { CRegs c; };
    DEVFN Regs load(int unit) const { Regs R; R.c = c_load_common(Z, (unit >> 2) * 64, unit & 3, opaque_tid(w0)); return R; }
    DEVFN void stage(LAS unsigned char* lds, const Regs& R) const { c_stage_common((LAS float*)lds, (LAS bf16_t*)(lds + 65536 + 2 * 64 * 136 * 2), R.c, opaque_tid(w0)); }
    DEVFN void compute(LAS unsigned char* lds, const Regs& R, int unit) const {
        (void)R; const int tid = opaque_tid(w0), lane = tid & 63, w = tid >> 6, c16 = lane & 15, g4 = lane >> 4;
        LAS float* LF = (LAS float*)lds;
        LAS bf16_t* Kx = (LAS bf16_t*)(lds + 65536);
        LAS bf16_t* Vs = (LAS bf16_t*)(lds + 65536 + 2 * 64 * 136 * 2);
        LAS float* tot = (LAS float*)(lds + 65536 + 3 * 64 * 136 * 2);
        {
            const int dir = tid >> 8, half = (tid >> 7) & 1, dk = tid & 127;
            LAS float* lf = LF + (dir * 64 + half * 32) * 128 + dk;
            float run = 0.f;
            if (dir == 0) { for (int j = 31; j >= 0; --j) { const float x = lf[j * 128]; lf[j * 128] = (1.0f - fexp(x)) * fexp(run); run += x; } }
            else { for (int j = 0; j < 32; ++j) { const float x = lf[j * 128]; lf[j * 128] = (1.0f - fexp(x)) * fexp(run); run += x; } }
            tot[(dir * 2 + half) * 128 + dk] = run;
        }
        __syncthreads();
#pragma unroll
        for (int i = 0; i < 4; ++i) {
            const int id = tid + 512 * i, dir = id >> 10, j = (id >> 4) & 63, ch = id & 15, half = j >> 5;
            const LAS float* s = LF + (dir * 64 + j) * 128 + 8 * ch; f32x4 a = *(const LAS f32x4*)s, b = *(const LAS f32x4*)(s + 4);
            if (half == dir) {
                const LAS float* tp = tot + (dir * 2 + (1 - half)) * 128 + 8 * ch; const f32x4 t0 = *(const LAS f32x4*)tp, t1 = *(const LAS f32x4*)(tp + 4);
#pragma unroll
                for (int e = 0; e < 4; ++e) { a[e] *= fexp(t0[e]); b[e] *= fexp(t1[e]); }
            }
            *(LAS bf16x8*)(Kx + (dir * 64 + j) * 136 + 8 * ch) = pack8(a, b);
        }
        if (tid < 256) { const int dir = tid >> 7, dk = tid & 127; GC[((size_t)unit * 2 + dir) * 128 + dk] = fexp(tot[(dir * 2) * 128 + dk] + tot[(dir * 2 + 1) * 128 + dk]); }
        __syncthreads();
#pragma unroll
        for (int dir = 0; dir < 2; ++dir) {
            bf16x8 af[2];
#pragma unroll
            for (int ks = 0; ks < 2; ++ks) af[ks] = tr8(Kx + dir * 64 * 136, 136, 32 * ks, 16 * w, c16, g4);
            bf16_t* dst = SC + ((size_t)unit * 2 + dir) * 16384;
#pragma unroll
            for (int b = 0; b < 8; ++b) {
                f32x4 acc = {0.f, 0.f, 0.f, 0.f};
#pragma unroll
                for (int ks = 0; ks < 2; ++ks) acc = mfma16(af[ks], tr8(Vs, 136, 32 * ks, 16 * b, c16, g4), acc);
                *(u32x2*)(dst + (16 * b + c16) * 128 + 16 * w + 4 * g4) = pk4(acc);
            }
        }
    }
};
struct COutUnit {
    const bf16_t* Z; const bf16_t* SC; bf16_t* MIX; const float* gain; int w0;
    struct Regs { CRegs c; u32x4 qv[4], sf[4], sb[4]; u32x2 gw[4]; f32x4 gn; };
    DEVFN void load1(Regs& R, int unit) const {
        const int tid = opaque_tid(w0), lane = tid & 63, w = tid >> 6, c16 = lane & 15, g4 = lane >> 4; const int h = unit & 3, row0 = (unit >> 2) * 64; R.c = c_load_common(Z, row0, h, tid);
        const size_t row = (size_t)(row0 + 16 * (w & 3) + c16);
#pragma unroll
        for (int ks = 0; ks < 4; ++ks) R.qv[ks] = *(const u32x4*)(Z + zoff(OFF_QC, 128, h, (int)row, 32 * ks + 8 * g4));
    }
    DEVFN void load2(Regs& R, int unit) const {
        const int tid = opaque_tid(w0), lane = tid & 63, w = tid >> 6, c16 = lane & 15, g4 = lane >> 4; const int h = unit & 3, row0 = (unit >> 2) * 64;
        const size_t row = (size_t)(row0 + 16 * (w & 3) + c16);
        const bf16_t* gSf = SC + ((size_t)unit * 2 + 0) * 16384; const bf16_t* gSb = SC + ((size_t)unit * 2 + 1) * 16384;
#pragma unroll
        for (int i = 0; i < 4; ++i) { const int id = tid + 512 * i; R.sf[i] = *(const u32x4*)(gSf + id * 8); R.sb[i] = *(const u32x4*)(gSb + id * 8); }
#pragma unroll
        for (int dd = 0; dd < 4; ++dd) R.gw[dd] = *(const u32x2*)(Z + zoff(OFF_GC, 128, h, (int)row, 16 * (4 * (w >> 2) + dd) + 4 * g4));
        R.gn = (f32x4){gain[h * 128 + (tid & 127)], 0.f, 0.f, 0.f};
    }
    DEVFN void stage(LAS unsigned char* lds, const Regs& R) const { const int tid = opaque_tid(w0); c_stage_common((LAS float*)lds, (LAS bf16_t*)(lds + 65536 + 2 * 64 * 136 * 2), R.c, tid);
        }
    DEVFN void compute(LAS unsigned char* lds, const Regs& R, int unit, Regs& N, int next) const {
        const int tid = opaque_tid(w0), lane = tid & 63, w = tid >> 6, c16 = lane & 15, g4 = lane >> 4;
        const int h = unit & 3, row0 = (unit >> 2) * 64;
        const LAS float* gtab = (const LAS float*)(lds + 65536 + 3 * 64 * 136 * 2 + 2048);
        LAS float* LF = (LAS float*)lds;
        LAS bf16_t* Kx = (LAS bf16_t*)(lds + 65536);
        LAS bf16_t* Vs = (LAS bf16_t*)(lds + 65536 + 2 * 64 * 136 * 2);
        LAS float* bref = (LAS float*)(lds + 65536 + 3 * 64 * 136 * 2);
        LAS float* ssq = bref + 256;
        {
            const int dir = tid >> 8, half = (tid >> 7) & 1, dk = tid & 127;
            LAS float* lf = LF + dir * 64 * 128 + dk; LAS bf16_t* kx = Kx + dir * 64 * 136 + dk;
            float run = 0.f;
            if (dir == 0) {
                if (half == 1) { for (int i = 32; i < 64; ++i) { const float x = lf[i * 128]; run += x; lf[i * 128] = run; kx[i * 136] = (bf16_t)f2bf((1.0f - fexp(x)) * fexp(-run)); } }
                else { for (int i = 31; i >= 0; --i) { const float x = lf[i * 128]; lf[i * 128] = run; kx[i * 136] = (bf16_t)f2bf((1.0f - fexp(x)) * fexp(-run)); run -= x; } bref[dk] = -run; }
            } else {
                if (half == 0) { for (int i = 31; i >= 0; --i) { const float x = lf[i * 128]; run += x; lf[i * 128] = run; kx[i * 136] = (bf16_t)f2bf((1.0f - fexp(x)) * fexp(-run)); } }
                else { for (int i = 32; i < 64; ++i) { const float x = lf[i * 128]; lf[i * 128] = run; kx[i * 136] = (bf16_t)f2bf((1.0f - fexp(x)) * fexp(-run)); run -= x; } bref[128 + dk] = -run; }
            }
        }
        const int it = w & 3, dvh = w >> 2, i = 16 * it + c16; const size_t row = (size_t)(row0 + i);
        __syncthreads();
        bf16x8 Qpf[4], Qpb[4];
#pragma unroll
        for (int ks = 0; ks < 4; ++ks) {
            const int dk0 = 32 * ks + 8 * g4; const u32x4 qv = R.qv[ks];
            f32x4 q0, q1; q0[0] = bflo(qv.x); q0[1] = bfhi(qv.x); q0[2] = bflo(qv.y); q0[3] = bfhi(qv.y); q1[0] = bflo(qv.z); q1[1] = bfhi(qv.z); q1[2] = bflo(qv.w); q1[3] = bfhi(qv.w);
            const f32x4 df0 = *(const LAS f32x4*)(LF + i * 128 + dk0), df1 = *(const LAS f32x4*)(LF + i * 128 + dk0 + 4);
            const f32x4 db0 = *(const LAS f32x4*)(LF + (64 + i) * 128 + dk0), db1 = *(const LAS f32x4*)(LF + (64 + i) * 128 + dk0 + 4);
            f32x4 a0, a1, e0, e1;
#pragma unroll
            for (int j = 0; j < 4; ++j) { a0[j] = q0[j] * fexp(df0[j]); a1[j] = q1[j] * fexp(df1[j]); e0[j] = q0[j] * fexp(db0[j]); e1[j] = q1[j] * fexp(db1[j]); }
            Qpf[ks] = pack8(a0, a1); Qpb[ks] = pack8(e0, e1);
            EPI_FENCE();
        }
        f32x4 P[4];
#pragma unroll
        for (int jt = 0; jt < 4; ++jt) {
            f32x4 af = {0.f, 0.f, 0.f, 0.f}, ab = {0.f, 0.f, 0.f, 0.f};
#pragma unroll
            for (int ks = 0; ks < 4; ++ks) {
                af = mfma16(*(const LAS bf16x8*)(Kx + (16 * jt + c16) * 136 + 32 * ks + 8 * g4), Qpf[ks], af);
                ab = mfma16(*(const LAS bf16x8*)(Kx + (64 + 16 * jt + c16) * 136 + 32 * ks + 8 * g4), Qpb[ks], ab);
            }
#pragma unroll
            for (int rr = 0; rr < 4; ++rr) { const int j = 16 * jt + 4 * g4 + rr; P[jt][rr] = (j <= i ? af[rr] : 0.f) + (j >= i ? ab[rr] : 0.f); }
        }
        bf16x8 bp[2];
#pragma unroll
        for (int k2 = 0; k2 < 2; ++k2) bp[k2] = pack8(P[2 * k2], P[2 * k2 + 1]);
        LAS bf16_t* Sl = (LAS bf16_t*)lds;
        __syncthreads();
#pragma unroll
        for (int q = 0; q < 4; ++q) { const int id = tid + 512 * q, r = id >> 4, ch = id & 15; const int o = r * 128 + ((ch ^ (r & 15)) * 8);
            *(LAS u32x4*)(Sl + o) = R.sf[q]; *(LAS u32x4*)(Sl + 16384 + o) = R.sb[q]; }
        if (tid < 128) ((LAS float*)(lds + 65536 + 3 * 64 * 136 * 2 + 2048))[tid] = R.gn[0];
        const u32x2 gw0 = R.gw[0], gw1 = R.gw[1], gw2 = R.gw[2], gw3 = R.gw[3];
        load2(N, next);
        __syncthreads();
        bf16x8 Qqf[4], Qqb[4];
#pragma unroll
        for (int ks = 0; ks < 4; ++ks) {
            const int dk0 = 32 * ks + 8 * g4;
            const f32x4 rf0 = *(const LAS f32x4*)(bref + dk0), rf1 = *(const LAS f32x4*)(bref + dk0 + 4), rb0 = *(const LAS f32x4*)(bref + 128 + dk0), rb1 = *(const LAS f32x4*)(bref + 128 + dk0 + 4);
            const u32x4 pf = __builtin_bit_cast(u32x4, Qpf[ks]), pb = __builtin_bit_cast(u32x4, Qpb[ks]);
            f32x4 c0, c1, f0, f1;
            c0[0] = bflo(pf.x) * fexp(rf0[0]); c0[1] = bfhi(pf.x) * fexp(rf0[1]); c0[2] = bflo(pf.y) * fexp(rf0[2]); c0[3] = bfhi(pf.y) * fexp(rf0[3]);
            c1[0] = bflo(pf.z) * fexp(rf1[0]); c1[1] = bfhi(pf.z) * fexp(rf1[1]); c1[2] = bflo(pf.w) * fexp(rf1[2]); c1[3] = bfhi(pf.w) * fexp(rf1[3]);
            f0[0] = bflo(pb.x) * fexp(rb0[0]); f0[1] = bfhi(pb.x) * fexp(rb0[1]); f0[2] = bflo(pb.y) * fexp(rb0[2]); f0[3] = bfhi(pb.y) * fexp(rb0[3]);
            f1[0] = bflo(pb.z) * fexp(rb1[0]); f1[1] = bfhi(pb.z) * fexp(rb1[1]); f1[2] = bflo(pb.w) * fexp(rb1[2]); f1[3] = bfhi(pb.w) * fexp(rb1[3]);
            Qqf[ks] = pack8(c0, c1); Qqb[ks] = pack8(f0, f1);
        }
        f32x4 o[4]; float s2 = 0.f;
#pragma unroll
        for (int dd = 0; dd < 4; ++dd) {
            const int dvt = 4 * dvh + dd;
            f32x4 acc = {0.f, 0.f, 0.f, 0.f};
#pragma unroll
            for (int k2 = 0; k2 < 2; ++k2) acc = mfma16(tr8p(Vs, 136, 32 * k2, 16 * dvt, c16, g4), bp[k2], acc);
#pragma unroll
            for (int ks = 0; ks < 4; ++ks) {
                const int so = (16 * dvt + c16) * 128 + (((4 * ks + g4) ^ c16) * 8);
                acc = mfma16(*(const LAS bf16x8*)(Sl + so), Qqf[ks], acc);
                acc = mfma16(*(const LAS bf16x8*)(Sl + 16384 + so), Qqb[ks], acc);
            }
            o[dd] = acc; s2 += (acc[0] * acc[0] + acc[1] * acc[1]) + (acc[2] * acc[2] + acc[3] * acc[3]);
            EPI_FENCE();
        }
        s2 += __shfl_xor(s2, 16); s2 += __shfl_xor(s2, 32);
        if (g4 == 0) ssq[w * 16 + c16] = s2;
        __syncthreads();
        const float rinv = 1.0f / sqrtf((ssq[w * 16 + c16] + ssq[(w ^ 4) * 16 + c16]) * (1.0f / 128.0f) + EPS);
#pragma unroll
        for (int dd = 0; dd < 4; ++dd) {
            const int col = h * 128 + 16 * (4 * dvh + dd) + 4 * g4;
            const f32x4 gn = *(const LAS f32x4*)(gtab + 16 * (4 * dvh + dd) + 4 * g4); const u32x2 gw = dd == 0 ? gw0 : (dd == 1 ? gw1 : (dd == 2 ? gw2 : gw3));
            f32x4 v = o[dd] * rinv * gn; v[0] *= bflo(gw.x); v[1] *= bfhi(gw.x); v[2] *= bflo(gw.y); v[3] *= bfhi(gw.y);
            *(u32x2*)(MIX + row * MIXW + 768 + col) = pk4(v);
        }
    }
};

#ifndef CPU_EMU
#define KERNEL_LDS extern __shared__ __attribute__((aligned(16))) unsigned char lds_raw[]; LAS unsigned char* lds = (LAS unsigned char*)lds_raw;
#ifdef VGPR_LIMIT
__attribute__((amdgpu_num_vgpr(VGPR_LIMIT)))
#endif
__global__ void __launch_bounds__(512, 2) fwd_kernel(Args args)
#else
#define KERNEL_LDS unsigned char* lds = emu_lds();
void fwd_kernel(Args args)
#endif
{
    KERNEL_LDS
    const int G = gridDim.x, bx = blockIdx.x;
#ifndef CPU_EMU
    const int w0 = __builtin_amdgcn_readfirstlane((int)threadIdx.x >> 6);
#else
    const int w0 = 0;
#endif
#ifndef CPU_EMU
#define PH_IDS const int tid = opaque_tid(w0), lane = tid & 63, wave = __builtin_amdgcn_readfirstlane(tid >> 6), gw = bx * 8 + wave, gtid = bx * 512 + tid; int Gs_ = G; asm volatile("" : "+s"(Gs_)); const int ngw = Gs_ * 8, nthr = Gs_ * 512; (void)lane; (void)gw; (void)gtid; (void)ngw; (void)nthr;
#else
#define PH_IDS const int tid = opaque_tid(w0), lane = tid & 63, wave = tid >> 6, gw = bx * 8 + wave, gtid = bx * 512 + tid; const int ngw = G * 8, nthr = G * 512; (void)lane; (void)gw; (void)gtid; (void)ngw; (void)nthr;
#endif
#ifndef CPU_EMU
#define OPAQUE_S(p) asm volatile("" : "+s"(p))
#else
#define OPAQUE_S(p)
#endif
#define GAS_ __attribute__((address_space(1)))
#ifndef CPU_EMU
#define PH_PTRS GAS_ unsigned char* ws_g = (GAS_ unsigned char*)args.ws; OPAQUE_S(ws_g); unsigned char* ws = (unsigned char*)ws_g; GAS_ float* h_g = (GAS_ float*)args.out; OPAQUE_S(h_g); float* h = (float*)h_g; PH_PTRS2
#else
#define PH_PTRS unsigned char* ws = args.ws; float* h = args.out; PH_PTRS2
#endif
#define PH_PTRS2 \
    float* rope = (float*)(ws + WS_ROPE); float* biasT = (float*)(ws + WS_BIAS); float* lbs = (float*)(ws + WS_LBS); \
    bf16_t* WB = (bf16_t*)(ws + WS_WB); bf16_t* XN = (bf16_t*)(ws + WS_XN); unsigned char* R = ws + WS_R; bf16_t* ACT = (bf16_t*)(R + R_ACT); \
    bf16_t* Zs = (bf16_t*)(R + R_Z); bf16_t* AO = (bf16_t*)(R + R_AO); float* LSE = (float*)(R + R_LSE); bf16_t* MIX = (bf16_t*)(R + R_MIX); \
    bf16_t* MH = (bf16_t*)(R + R_MH); bf16_t* SB = (bf16_t*)(R + R_SB); bf16_t* SC = (bf16_t*)(R + R_SC); float* GC = (float*)(R + R_GC); \
    bf16_t* PB = (bf16_t*)(ws + WS_PB); bf16_t* SG = (bf16_t*)(R + R_SG); bf16_t* XN2 = (bf16_t*)(ws + WS_XN2); float* SSQ = (float*)(ws + WS_SSQ); \
    (void)h; (void)rope; (void)biasT; (void)lbs; (void)WB; (void)XN; (void)ACT; (void)Zs; (void)AO; (void)LSE; (void)MIX; (void)MH; (void)SB; (void)SC; (void)GC; (void)PB; (void)SG; (void)XN2; (void)SSQ;
    const int lo = args.lo, hi = args.hi;
#ifndef CPU_EMU
    LAS unsigned* misc = (LAS unsigned*)(lds + LDS_BYTES - 64);
    if (threadIdx.x < 4) misc[threadIdx.x] = 0u;
    __syncthreads();
    XcdBarrier bar = xcd_barrier_post((unsigned*)(args.ws + WS_CTL) + 1024, (volatile LAS unsigned*)misc);
#define GRID_BAR() xcd_barrier(bar, w0)
#else
#define GRID_BAR() emu_grid_barrier()
#endif
    int ph = 0;
#ifdef PROBE_PROF
    int cls_ = 0;
    if (bx == 0 && threadIdx.x == 0) { unsigned long long* P = (unsigned long long*)(args.ws + WS_CTL + 65536); P[0] = __builtin_amdgcn_s_memrealtime(); }
#define PH_CLS(k) cls_ = (k);
#define PROF_END() if (bx == 0 && w0 == 0 && lane_id_v() == 0) { unsigned long long* P = (unsigned long long*)(args.ws + WS_CTL + 65536); const unsigned long long now = __builtin_amdgcn_s_memrealtime(); P[2 + cls_] += now - P[0]; P[0] = now; }
#else
#define PH_CLS(k)
#define PROF_END()
#endif
#define PH_OPEN if (ph >= lo && ph < hi) { PH_IDS PH_PTRS
#define PH_CLOSE PROF_END() if (ph + 1 < hi) GRID_BAR(); } ++ph;

    PH_CLS(0)
    PH_OPEN
        prologue_tables(args, rope, biasT, lbs, gtid, nthr);
    PH_CLOSE

    for (int l = 0; l < DEPTH; ++l) {
        PH_CLS(0)
        PH_OPEN
            convert_weights(args, l, WB, lds, gw, ngw, wave, lane);
            cvt_ple(args, l, PB, gtid, nthr);
            if (l == 0) init_rows(args, XN2, SSQ, gw, ngw, lane);
        PH_CLOSE
        for (int half = 0; half < 2; ++half) {
            const int nA = 4 * l + 2 * half;
            for (int q = 0; q <= NFP; ++q) {
            PH_CLS(q == 0 ? 1 : (q == NFP ? 3 : 2))
            PH_OPEN
                for (int step = 0; step < 2; ++step) {
                    if ((step ^ (bx & 1)) == 0) {
                        if (q > 0) {
                            const size_t r0 = (size_t)(q - 1) * TP;
                            pg8::Gemm g{ACT + r0 * FF, WB + (half ? WE_D2 : WE_D1), TP, D, FF, FF, FF}; pg8::StaticOrder S; S.init(TP, D, G, bx);
                            pg8::EpiResAdd E{(half ? XN : XN2) + r0 * D, XN + r0 * D, SSQ + ((size_t)((nA + 1) % 3) * T + r0) * 4, D, 1, lds};
                            pg8::gemm_phase<pg8::EpiResAdd, pg8::StaticOrder>(w0, lds, g, S, E);
                        }
                    } else if (q < NFP) {
                        const size_t r0 = (size_t)q * TP;
                        pg8::Gemm g{(half ? XN : XN2) + r0 * D, WB + (half ? WE_GU2 : WE_GU1), TP, 2 * FF, D, D, D}; pg8::StaticOrder S; S.init(TP, 2 * FF, G, bx);
                        pg8::EpiSwiglu E{ACT + r0 * FF, FF, SSQ + ((size_t)(nA % 3) * T + r0) * 4, lds};
                        pg8::gemm_phase<pg8::EpiSwiglu, pg8::StaticOrder>(w0, lds, g, S, E);
                    }
                }
            PH_CLOSE
            }
            if (half == 0) {
                for (int s = 0; s <= NSLAB; ++s) {
                    const int srow0 = (s < NSLAB ? s : NSLAB - 1) * SLAB; const int S_len = srow0 < NP ? SEQ : DEC_SEQ; const int nseq = SLAB / S_len;
                    PH_CLS(s == 0 ? 4 : (s == NSLAB ? 6 : 5))
                    PH_OPEN
                        for (int step = 0; step < 2; ++step) {
                            if ((step ^ (bx & 1)) == 0) {
                                if (s > 0) {
                                    const int prow0 = (s - 1) * SLAB;
                                    pg8::Gemm g{MH, WB + WE_OUT, SLAB, D, D, D, D}; pg8::StaticOrder S; S.init(SLAB, D, G, bx);
                                    pg8::EpiResAdd E{XN + (size_t)prow0 * D, XN + (size_t)prow0 * D, SSQ + ((size_t)((nA + 2) % 3) * T + prow0) * 4, D, 0, lds};
                                    pg8::gemm_phase<pg8::EpiResAdd, pg8::StaticOrder>(w0, lds, g, S, E);
                                }
                            } else if (s < NSLAB) {
                                pg8::Gemm g{XN + (size_t)srow0 * D, WB + WE_IN, SLAB, ZW, D, D, D}; pg8::StaticOrder S; S.init(SLAB, ZW, G, bx);
                                pg8::EpiInProj E{Zs, rope, rope + 4096 * 64, lbs + l * 512, srow0, SSQ + ((size_t)((nA + 1) % 3) * T + srow0) * 4, lds};
                                pg8::gemm_phase<pg8::EpiInProj, pg8::StaticOrder>(w0, lds, g, S, E);
                            }
                        }
                    PH_CLOSE
                    if (s == NSLAB) break;
                    for (int mrep = 0; mrep < MIXREP; ++mrep) {
                    PH_CLS(7)
                    PH_OPEN
                        {
                            const int nuA = (SLAB / 128) * 12, perA = (nuA + G - 1) / G, a0 = bx * perA, a1 = (bx + 1) * perA < nuA ? (bx + 1) * perA : nuA;
                            const int nuB = (SLAB / 128) * 4, perB = (nuB + G - 1) / G, b0 = bx * perB, b1 = (bx + 1) * perB < nuB ? (bx + 1) * perB : nuB;
                            const int nuC = (SLAB / 64) * 4, perC = (nuC + G - 1) / G, c0 = bx * perC, c1 = (bx + 1) * perC < nuC ? (bx + 1) * perC : nuC;
                            const AUnit UA{Zs, AO, LSE, biasT, S_len, w0}; const BKvUnit UB{Zs, SB, w0}; const CKvUnit UC{Zs, SC, GC, w0};
                            BKvUnit::Regs LB; CKvUnit::Regs LC;
                            run_units_k(lds, UA, a0, a1, UA.load(a0 < nuA ? a0 : nuA - 1), [&] { LB = UB.load(b0 < nuB ? b0 : nuB - 1); });
                            run_units_k(lds, UB, b0, b1, LB, [&] { LC = UC.load(c0 < nuC ? c0 : nuC - 1); });
                            run_units_k(lds, UC, c0, c1, LC, [] {});
                        }
                    PH_CLOSE
                    PH_CLS(8)
                    PH_OPEN
                        mixer_scan(SB, SC, GC, nseq, S_len, gtid, nthr);
                    PH_CLOSE
                    PH_CLS(9)
                    PH_OPEN
                        {
                            const int nuB = (SLAB / 128) * 4, perB = (nuB + G - 1) / G, b0 = bx * perB, b1 = (bx + 1) * perB < nuB ? (bx + 1) * perB : nuB;
                            const int nuC = (SLAB / 64) * 4, perC = (nuC + G - 1) / G, c0 = bx * perC, c1 = (bx + 1) * perC < nuC ? (bx + 1) * perC : nuC;
                            const BOutUnit UB{Zs, SB, MIX, args.in[I_RETN] + l * 512, w0}; const COutUnit UC{Zs, SC, MIX, args.in[I_HGN] + l * 512, w0};
                            const BOutUnit::Regs LB = UB.load(b0 < nuB ? b0 : nuB - 1);
                            mixer_a_merge(AO, LSE, MIX, gtid, nthr);
                            COutUnit::Regs LC;
                            run_units_k(lds, UB, b0, b1, LB, [&] { UC.load1(LC, c0 < nuC ? c0 : nuC - 1); });
                            run_units2_k(lds, UC, c0, c1, LC);
                        }
                    PH_CLOSE
                    }
                    PH_CLS(10)
                    PH_OPEN
                        pg8::Gemm g{MIX, WB + WE_BR, SLAB, D, MIXW, MIXW, MIXW}; pg8::StaticOrder S; S.init(SLAB, D, G, bx);
                        pg8::EpiMerge E{MH, Zs + (size_t)SLAB * OFF_MG, D};
                        pg8::gemm_phase<pg8::EpiMerge, pg8::StaticOrder>(w0, lds, g, S, E);
                    PH_CLOSE
                }
            } else {
                PH_CLS(11)
                PH_OPEN
                    { pg8::Gemm g{XN, WB + WE_PG, T, D, D, D, D}; pg8::StaticOrder S; S.init(T, D, G, bx);
                      pg8::EpiGateBf16 E{SG, D, SSQ + (size_t)((nA + 1) % 3) * T * 4, lds};
                      pg8::gemm_phase<pg8::EpiGateBf16, pg8::StaticOrder>(w0, lds, g, S, E); }
                    { pg8::Gemm g{PB, WB + WE_PP, T, D, D_PLE, D_PLE, D_PLE}; pg8::StaticOrder S; S.init(T, D, G, bx);
                      pg8::EpiPle E{XN, SG, D, XN2, SSQ + (size_t)((nA + 2) % 3) * T * 4, lds};
                      pg8::gemm_phase<pg8::EpiPle, pg8::StaticOrder>(w0, lds, g, S, E); }
                PH_CLOSE
            }
        }
    }
    PH_CLS(12)
    PH_OPEN
#ifdef PROBE_PROF
        { const unsigned long long* P = (const unsigned long long*)(args.ws + WS_CTL + 65536); unsigned long long tot = 0; for (int k = 0; k < 12; ++k) tot += P[2 + k];
          final_norm_rows(XN2, h, args.in[I_FINN], gw, ngw, lane, 1.0f + (float)PROBE_K * (floorf((float)((double)P[2 + PROBE_PROF] / (double)tot) * (float)PROBE_Q + PROBE_OFS) * (1.0f / (float)PROBE_Q))); }
#else
        final_norm_rows(XN2, h, args.in[I_FINN], gw, ngw, lane, 1.0f);
#endif
    PH_CLOSE
#undef PH_OPEN
#undef PH_CLOSE
}

extern "C" void kernel_launch(void* const* d_in, const int* in_sizes, int n_in, void* d_out, int out_size, void* d_ws, size_t ws_size, hipStream_t stream) {
    static int grid = 0;
    if (grid == 0) {
        if (n_in != N_INPUTS || out_size != T * D || ws_size < WS_END) { fprintf(stderr, "kernel_launch: unexpected sizes (n_in %d, out %d, ws %zu, need %zu)\n", n_in, out_size, ws_size, (size_t)WS_END); grid = -1; return; }
        int dev = 0, cus = 0;
        if (hipGetDevice(&dev) != hipSuccess || hipDeviceGetAttribute(&cus, hipDeviceAttributeMultiprocessorCount, dev) != hipSuccess) { grid = -1; return; }
        if (hipFuncSetAttribute((const void*)fwd_kernel, hipFuncAttributeMaxDynamicSharedMemorySize, LDS_BYTES) != hipSuccess) { fprintf(stderr, "kernel_launch: hipFuncSetAttribute failed\n"); grid = -1; return; }
        int per_cu = 0;
        if (hipOccupancyMaxActiveBlocksPerMultiprocessor(&per_cu, (const void*)fwd_kernel, 512, LDS_BYTES) != hipSuccess || per_cu < 1) fprintf(stderr, "kernel_launch: occupancy query reports %d\n", per_cu);
        (void)hipGetLastError();
        grid = cus;
    }
    if (grid < 0) return;
    (void)in_sizes;
    hipMemsetAsync((char*)d_ws + WS_CTL, 0, CTL_BYTES, stream);
    Args a{};
    for (int i = 0; i < N_INPUTS; ++i) a.in[i] = (const float*)d_in[i];
    a.out = (float*)d_out; a.ws = (unsigned char*)d_ws;
#if ONE_LAUNCH
    a.lo = 0; a.hi = NPH;
    hipLaunchKernelGGL(fwd_kernel, dim3(grid), dim3(512), LDS_BYTES, stream, a);
#else
    for (int p = 0; p < NPH; ++p) { a.lo = p; a.hi = p + 1; hipLaunchKernelGGL(fwd_kernel, dim3(grid), dim3(512), LDS_BYTES, stream, a); }
#endif
}
```

```cpp
#ifndef CPU_EMU
#include <hip/hip_runtime.h>
#include <cstdio>
#include <cstdint>
#define LAS __attribute__((address_space(3)))
#define DEVFN __device__ __forceinline__
#define HDFN __host__ __device__ __forceinline__
#define EPI_FENCE() asm volatile("" ::: "memory")
#define OPAQUE_V(x) asm volatile("" : "+v"(x))
#define OPAQUE_V4(x) asm volatile("" : "+v"(x))
#define OPAQUE_SI(x) asm volatile("" : "+s"(x))
#else
#define OPAQUE_SI(x)
#define EPI_FENCE()
#define OPAQUE_V(x)
#define OPAQUE_V4(x)
#endif

#ifdef SMALL_CFG
constexpr int D = 256, FF = 256, BATCH = 2, SEQ = 2048, DEC_BATCH = 1, DEC_SEQ = 4096, DEPTH = 2, SLAB = 4096;
#else
constexpr int D = 1024, FF = 2816, BATCH = 32, SEQ = 2048, DEC_BATCH = 8, DEC_SEQ = 4096, DEPTH = 4, SLAB = 16384;
#endif
#ifndef ONE_LAUNCH
#define ONE_LAUNCH 1
#endif
constexpr int NP = BATCH * SEQ, NS = DEC_BATCH * DEC_SEQ, T = NP + NS, NSLAB = T / SLAB;
constexpr int D_PLE = 256, N_IN = 6912, ZW = N_IN + 3 * D, MIXW = 1280, AOW = 768;
constexpr int OFF_QA = 0, OFF_KA = 768, OFF_VA = 1536, OFF_QB = 2304, OFF_KB = 2816, OFF_VB = 3328, OFF_GB = 3840, OFF_QC = 4352, OFF_FCF = 4864, OFF_IC = 5888, OFF_GC = 6400, OFF_MG = 6912;
constexpr float EPS = 1e-6f;
static_assert(NP % SLAB == 0 && NS % SLAB == 0 && SLAB % SEQ == 0 && SLAB % DEC_SEQ == 0 && T % 256 == 0 && (2 * FF) % 256 == 0 && FF % 128 == 0 && D % 256 == 0, "shape");

constexpr size_t MiB = 1u << 20;
constexpr size_t al(size_t x) { return (x + 255) & ~(size_t)255; }
constexpr size_t WS_CTL = 0, CTL_BYTES = 1 * MiB;
constexpr size_t WS_ROPE = WS_CTL + CTL_BYTES;
constexpr size_t WS_BIAS = WS_ROPE + 2 * MiB;
constexpr size_t WS_LBS = WS_BIAS + 16384;
constexpr size_t WS_WB = WS_LBS + 16384;
constexpr size_t WE_GU1 = 0, WE_D1 = WE_GU1 + (size_t)2 * FF * D, WE_IN = WE_D1 + (size_t)D * FF, WE_BR = WE_IN + (size_t)ZW * D, WE_OUT = WE_BR + (size_t)D * MIXW,
                 WE_GU2 = WE_OUT + (size_t)D * D, WE_D2 = WE_GU2 + (size_t)2 * FF * D, WE_PG = WE_D2 + (size_t)D * FF, WE_PP = WE_PG + (size_t)D * D, WE_END = WE_PP + (size_t)D * D_PLE;
constexpr size_t WS_XN = al(WS_WB + WE_END * 2);
constexpr size_t WS_XN2 = al(WS_XN + (size_t)T * D * 2);
constexpr size_t WS_SSQ = al(WS_XN2 + (size_t)T * D * 2);
constexpr size_t WS_PB = al(WS_SSQ + (size_t)3 * T * 16);
constexpr size_t WS_R = al(WS_PB + (size_t)T * D_PLE * 2);
constexpr size_t R_ACT = 0, R_ACT_END = (size_t)T * FF * 2;
constexpr size_t R_Z = 0, R_AO = al(R_Z + (size_t)SLAB * ZW * 2), R_LSE = al(R_AO + (size_t)SLAB * AOW * 2), R_MIX = al(R_LSE + (size_t)SLAB * 12 * 4),
                 R_MH = al(R_MIX + (size_t)SLAB * MIXW * 2), R_SB = al(R_MH + (size_t)SLAB * D * 2),
                 R_SC = al(R_SB + (size_t)(SLAB / 128) * 4 * 2 * 16384 * 2), R_GC = al(R_SC + (size_t)(SLAB / 64) * 4 * 2 * 16384 * 2), R_MIX_END = al(R_GC + (size_t)(SLAB / 64) * 4 * 2 * 128 * 4);
constexpr size_t R_SG = 0, R_PLE_END = al(R_SG + (size_t)T * D * 2);
constexpr size_t cmax(size_t a, size_t b) { return a > b ? a : b; }
constexpr size_t WS_END = WS_R + cmax(cmax(R_ACT_END, R_MIX_END), R_PLE_END);
constexpr int LDS_BYTES = 147456;
#ifndef MIXREP
#define MIXREP 1
#endif
#ifndef REP_A
#define REP_A 1
#endif
#ifndef REP_KV
#define REP_KV 1
#endif
#ifndef REP_OUT
#define REP_OUT 1
#endif
constexpr int NFP = (T % 768 == 0) ? 3 : 2, TP = T / NFP;
static_assert(TP % 256 == 0, "FFN parts");
constexpr int NPH = 2 + DEPTH * (2 + 2 * (NFP + 1) + (NSLAB + 1) + NSLAB * (1 + 3 * MIXREP));

typedef unsigned short bf16_t;
typedef short bf16x8 __attribute__((ext_vector_type(8)));
typedef short s16x4 __attribute__((ext_vector_type(4)));
typedef float f32x4 __attribute__((ext_vector_type(4)));
typedef unsigned u32x4 __attribute__((ext_vector_type(4)));
typedef unsigned u32x2 __attribute__((ext_vector_type(2)));

#ifndef CPU_EMU
DEVFN int lane_id_v() { int l; asm volatile("v_mbcnt_lo_u32_b32 %0, -1, 0\n\tv_mbcnt_hi_u32_b32 %0, -1, %0" : "=v"(l)); return l; }
DEVFN int opaque_tid(int w0) { return w0 * 64 + lane_id_v(); }
#else
DEVFN int opaque_tid(int) { return threadIdx.x; }
#endif
DEVFN unsigned f2bf(float f) { unsigned u = __builtin_bit_cast(unsigned, f); return (u + 0x7fffu + ((u >> 16) & 1u)) >> 16; }
#ifndef CPU_EMU
typedef float f32x2_t __attribute__((ext_vector_type(2)));
typedef __bf16 bf16x2_t __attribute__((ext_vector_type(2)));
DEVFN unsigned pk2(float lo, float hi) { const f32x2_t v = {lo, hi}; return __builtin_bit_cast(unsigned, __builtin_convertvector(v, bf16x2_t)); }
#else
DEVFN unsigned pk2(float lo, float hi) { return f2bf(lo) | (f2bf(hi) << 16); }
#endif
DEVFN float bf2f(unsigned b) { return __builtin_bit_cast(float, b << 16); }
DEVFN float bflo(unsigned w) { return __builtin_bit_cast(float, w << 16); }
DEVFN float bfhi(unsigned w) { return __builtin_bit_cast(float, w & 0xffff0000u); }
DEVFN unsigned f2h(float f) { _Float16 h = (_Float16)f; return (unsigned)__builtin_bit_cast(unsigned short, h); }
DEVFN float h2f(unsigned b) { return (float)__builtin_bit_cast(_Float16, (unsigned short)b); }
DEVFN u32x2 pk4(f32x4 v) { u32x2 r; r.x = pk2(v[0], v[1]); r.y = pk2(v[2], v[3]); return r; }
#ifndef CPU_EMU
DEVFN f32x4 mfma16(bf16x8 a, bf16x8 b, f32x4 c) { return __builtin_amdgcn_mfma_f32_16x16x32_bf16(a, b, c, 0, 0, 0); }
DEVFN float fexp(float x) { return __expf(x); }
DEVFN float flog(float x) { return __logf(x); }
DEVFN float frcp(float x) { return __builtin_amdgcn_rcpf(x); }
#else
f32x4 mfma16(bf16x8 a, bf16x8 b, f32x4 c);
DEVFN float fexp(float x) { return expf(x); }
DEVFN float flog(float x) { return logf(x); }
DEVFN float frcp(float x) { return 1.0f / x; }
#endif
#ifndef CPU_EMU
DEVFN float rms_rinv(float ssq) { return __builtin_amdgcn_rsqf(ssq * (1.0f / D) + EPS); }
#else
DEVFN float rms_rinv(float ssq) { return 1.0f / sqrtf(ssq * (1.0f / D) + EPS); }
#endif
DEVFN float row_rinv(const float* ssqp, unsigned row) { const f32x4 q = *(const f32x4*)(ssqp + 4 * row); float t = q[0]; if (D >= 512) t += q[1]; if (D >= 768) t += q[2]; if (D >= 1024) t += q[3]; return rms_rinv(t); }
#ifndef CPU_EMU
#define EPI_BARRIER() do { asm volatile("s_waitcnt lgkmcnt(0)" ::: "memory"); __builtin_amdgcn_s_barrier(); asm volatile("" ::: "memory"); } while (0)
#else
#define EPI_BARRIER() __syncthreads()
#endif
constexpr int EPI_RED_OFF = 131072;
constexpr int EPI_RINV_OFF = EPI_RED_OFF + 4096;
DEVFN void rinv_pre(const float* ssqp, LAS unsigned char* lds, int pm, int par, int tid) {
#ifndef CPU_EMU
    asm volatile("" : "+v"(tid));
    const int wv = __builtin_amdgcn_readfirstlane(tid >> 6);
    if (wv < 4) __builtin_amdgcn_global_load_lds((const unsigned*)(ssqp + 4 * (unsigned)(pm * 256 + tid)), (LAS unsigned*)(lds + EPI_RINV_OFF + par * 4096 + wv * 1024), 16, 0, 0);
#else
    if (tid < 256) *(f32x4*)(lds + EPI_RINV_OFF + par * 4096 + tid * 16) = *(const f32x4*)(ssqp + 4 * (unsigned)(pm * 256 + tid));
#endif
}
DEVFN float rinv_get(const LAS unsigned char* lds, int par, int r) { const f32x4 q = *(const LAS f32x4*)(lds + EPI_RINV_OFF + par * 4096 + r * 16); float t = q[0]; if (D >= 512) t += q[1]; if (D >= 768) t += q[2]; if (D >= 1024) t += q[3]; return rms_rinv(t); }
#ifndef CPU_EMU
DEVFN f32x4 swiglu4(f32x4 g, f32x4 u, float ri2, float nl) {
    const f32x4 t = g * nl; f32x4 e; e[0] = __builtin_amdgcn_exp2f(t[0]); e[1] = __builtin_amdgcn_exp2f(t[1]); e[2] = __builtin_amdgcn_exp2f(t[2]); e[3] = __builtin_amdgcn_exp2f(t[3]);
    const f32x4 d = e + 1.0f; f32x4 r; r[0] = __builtin_amdgcn_rcpf(d[0]); r[1] = __builtin_amdgcn_rcpf(d[1]); r[2] = __builtin_amdgcn_rcpf(d[2]); r[3] = __builtin_amdgcn_rcpf(d[3]);
    return (g * u) * (r * ri2);
}
#else
DEVFN f32x4 swiglu4(f32x4 g, f32x4 u, float ri2, float nl) { f32x4 o; for (int j = 0; j < 4; ++j) o[j] = (g[j] * u[j]) * ri2 / (1.0f + exp2f(g[j] * nl)); return o; }
#endif
DEVFN float fsigmoid(float x) { return frcp(1.0f + fexp(-x)); }
DEVFN float fsilu(float x) { return x * fsigmoid(x); }
DEVFN bf16x8 cat8(s16x4 lo, s16x4 hi) { return __builtin_shufflevector(lo, hi, 0, 1, 2, 3, 4, 5, 6, 7); }
DEVFN bf16x8 pack8(f32x4 a, f32x4 b) { u32x4 w; w.x = pk2(a[0], a[1]); w.y = pk2(a[2], a[3]); w.z = pk2(b[0], b[1]); w.w = pk2(b[2], b[3]); return __builtin_bit_cast(bf16x8, w); }
DEVFN unsigned zoff(int sec, int hd, int head, int row, int d) { return (unsigned)SLAB * (unsigned)sec + ((unsigned)head * (unsigned)SLAB + (unsigned)row) * (unsigned)hd + (unsigned)d; }
DEVFN int pos_of(int row) { return row < NP ? (row & (SEQ - 1)) : ((row - NP) & (DEC_SEQ - 1)); }
DEVFN float ret_l2(int dir, int h) {
    return dir ? (h == 0 ? -0.03223685441264423f : h == 1 ? -0.01602838797991282f : h == 2 ? -0.007991934616642016f : -0.003990433313311714f)
               : (h == 0 ? -0.04580368961312479f : h == 1 ? -0.02272007650008353f : h == 2 ? -0.011315313227834146f : -0.005646563141142063f);
}

namespace pg8 {
constexpr int BM = 256, BK = 64, HALF = 128, HTB = HALF * BK * 2, STAGE_BYTES = 8 * HTB, NXCD = 8, WGM = 8;
HDFN int lds_byte(int r, int c) { const int st = (r >> 4) * 2 + (c >> 5), rr = r & 15, cc = c & 31, ob = rr * 64 + cc * 2; return st * 1024 + (ob ^ (((ob >> 9) & 1) << 5)); }
HDFN void stage_rc(int b, int& R, int& C) { const int st = b / 1024, sb = b % 1024, swz = sb ^ (((sb >> 9) & 1) << 5); R = (st >> 1) * 16 + swz / 64; C = (st & 1) * 32 + (swz % 64) / 2; }
HDFN int perm32(int rho) { const int n = rho >> 4, i = rho & 15; return 8 * (i >> 2) + 4 * n + (i & 3); }
struct Unit { int pm, pn; };
struct Gemm { const bf16_t* A; const bf16_t* Bt; int M, N, K, lda, ldb; };
struct StaticOrder {
    int nM, nN, nwg, G, c;
    HDFN void init(int M, int N, int G_, int c_) { nM = M / BM; nN = N / BM; nwg = nM * nN; G = G_; c = c_; }
    HDFN bool next(int i, Unit& u) const {
        const long L = (long)i * G + c; if (L >= nwg) return false;
        int wgid = (int)L; { const int q = nwg / NXCD, r = nwg % NXCD, xcd = wgid % NXCD, off = wgid / NXCD; wgid = (xcd < r ? xcd * (q + 1) : r * (q + 1) + (xcd - r) * q) + off; }
        const int nig = WGM * nN, gid = wgid / nig, fm = gid * WGM, gsz = (nM - fm) < WGM ? (nM - fm) : WGM;
        u.pm = fm + ((wgid % nig) % gsz); u.pn = (wgid % nig) / gsz; return true;
    }
    DEVFN void a_ready(const Unit&) const {}
    DEVFN void done(const Unit&) const {}
};

struct EpiSwiglu {
    static constexpr bool PERM = true, MIDK = false;
    bf16_t* O; int ldc; const float* ssq; LAS unsigned char* lds;
    DEVFN void pre(const Unit& u, int par, int tid) const { rinv_pre(ssq, lds, u.pm, par, tid); }
    DEVFN void operator()(const f32x4 (&acc)[2][2][4][2], const Unit& u, int wr, int wc, int fr, int fq, int par) const {
        const int row0 = u.pm * BM + wr * 64 + fr, col0 = u.pn * HALF + wc * 32 + 8 * fq;
#pragma unroll
        for (int ai = 0; ai < 2; ++ai)
#pragma unroll
            for (int m = 0; m < 4; ++m) {
                bf16_t* rowp = O + (size_t)(row0 + ai * HALF + m * 16) * ldc + col0;
                const float ri = rinv_get(lds, par, ai * HALF + wr * 64 + m * 16 + fr);
                const float ri2 = ri * ri, nl = ri * -1.4426950408889634f;
                f32x4 a = swiglu4(acc[ai][0][m][0], acc[ai][1][m][0], ri2, nl), b = swiglu4(acc[ai][0][m][1], acc[ai][1][m][1], ri2, nl);
                u32x4 w; w.x = pk2(a[0], a[1]); w.y = pk2(a[2], a[3]); w.z = pk2(b[0], b[1]); w.w = pk2(b[2], b[3]);
                *(u32x4*)rowp = w; EPI_FENCE();
            }
    }
};
struct EpiResAdd {
    static constexpr bool PERM = false, MIDK = false;
    const bf16_t* Hs; bf16_t* Hd; float* ssq; int ldc; int halve; LAS unsigned char* lds;
    DEVFN void pre(const Unit&, int, int) const {}
    DEVFN void operator()(const f32x4 (&acc)[2][2][4][2], const Unit& u, int wr, int wc, int fr, int fq, int) const {
        const int row0 = u.pm * BM + wr * 64 + fr, col0 = u.pn * BM + wc * 32 + 4 * fq;
        int frq = fr; OPAQUE_V(frq);
        const float scale = halve ? 0.5f : 1.0f; const f32x4 sc4 = {scale, scale, scale, scale};
        u32x2 res[2][4][2][2];
#pragma unroll
        for (int ai = 0; ai < 2; ++ai) {
            u32x2 hv[4][2][2];
#pragma unroll
            for (int m = 0; m < 4; ++m) { const unsigned off = (unsigned)(row0 + ai * HALF + m * 16) * (unsigned)ldc + (unsigned)col0;
#pragma unroll
                for (int bj = 0; bj < 2; ++bj)
#pragma unroll
                    for (int n = 0; n < 2; ++n) hv[m][bj][n] = *(const u32x2*)(Hs + (off + bj * HALF + n * 16)); }
            EPI_FENCE();
#pragma unroll
            for (int m = 0; m < 4; ++m) { float part = 0.f;
#pragma unroll
                for (int bj = 0; bj < 2; ++bj)
#pragma unroll
                    for (int n = 0; n < 2; ++n) { const u32x2 hw = hv[m][bj][n]; f32x4 v = acc[ai][bj][m][n] * sc4; v[0] += bflo(hw.x); v[1] += bfhi(hw.x); v[2] += bflo(hw.y); v[3] += bfhi(hw.y);
                        const u32x2 o = pk4(v); res[ai][m][bj][n] = o;
                        const float r0 = bflo(o.x), r1 = bfhi(o.x), r2 = bflo(o.y), r3 = bfhi(o.y); part += (r0 * r0 + r1 * r1) + (r2 * r2 + r3 * r3); }
                part += __shfl_xor(part, 16); part += __shfl_xor(part, 32);
                if (fq == 0) ((LAS float*)(lds + EPI_RED_OFF))[(ai * HALF + wr * 64 + m * 16 + frq) * 4 + wc] = part; }
            EPI_FENCE();
        }
#pragma unroll
        for (int ai = 0; ai < 2; ++ai)
#pragma unroll
            for (int m = 0; m < 4; ++m) { const unsigned off = (unsigned)(row0 + ai * HALF + m * 16) * (unsigned)ldc + (unsigned)col0;
#pragma unroll
                for (int bj = 0; bj < 2; ++bj)
#pragma unroll
                    for (int n = 0; n < 2; ++n) *(u32x2*)(Hd + (off + bj * HALF + n * 16)) = res[ai][m][bj][n]; }
        EPI_BARRIER();
        { int t = wr * 256 + wc * 64 + fq * 16 + fr; OPAQUE_V(t); if (t < 256) { const f32x4 q = *(const LAS f32x4*)(lds + EPI_RED_OFF + t * 16); ssq[(size_t)(u.pm * BM + t) * 4 + u.pn] = (q[0] + q[1]) + (q[2] + q[3]); } }
    }
};
struct EpiGateBf16 {
    static constexpr bool PERM = false, MIDK = false;
    bf16_t* SG; int ldc; const float* ssq; LAS unsigned char* lds;
    DEVFN void pre(const Unit& u, int par, int tid) const { rinv_pre(ssq, lds, u.pm, par, tid); }
    DEVFN void operator()(const f32x4 (&acc)[2][2][4][2], const Unit& u, int wr, int wc, int fr, int fq, int par) const {
        const int row0 = u.pm * BM + wr * 64 + fr, col0 = u.pn * BM + wc * 32 + 4 * fq;
#pragma unroll
        for (int ai = 0; ai < 2; ++ai)
#pragma unroll
            for (int m = 0; m < 4; ++m) { const unsigned off = (unsigned)(row0 + ai * HALF + m * 16) * (unsigned)ldc + (unsigned)col0; const float ri = rinv_get(lds, par, ai * HALF + wr * 64 + m * 16 + fr);
#pragma unroll
                for (int bj = 0; bj < 2; ++bj)
#pragma unroll
                    for (int n = 0; n < 2; ++n) { f32x4 v = acc[ai][bj][m][n];
#pragma unroll
                        for (int j = 0; j < 4; ++j) v[j] = fsigmoid(v[j] * ri);
                        *(u32x2*)(SG + (off + bj * HALF + n * 16)) = pk4(v); }
                EPI_FENCE(); }
    }
};
struct EpiPle {
    static constexpr bool PERM = false, MIDK = false;
    const bf16_t* Hs; const bf16_t* SG; int ldc; bf16_t* Hd; float* ssq_out; LAS unsigned char* lds;
    DEVFN void pre(const Unit&, int, int) const {}
    DEVFN void operator()(const f32x4 (&acc)[2][2][4][2], const Unit& u, int wr, int wc, int fr, int fq, int) const {
        const int row0 = u.pm * BM + wr * 64 + fr, col0 = u.pn * BM + wc * 32 + 4 * fq;
        int frq = fr; OPAQUE_V(frq);
        u32x2 res[2][4][2][2];
#pragma unroll
        for (int ai = 0; ai < 2; ++ai)
#pragma unroll
            for (int mp = 0; mp < 2; ++mp) {
                u32x2 hv[2][2][2], gv[2][2][2];
#pragma unroll
                for (int m2 = 0; m2 < 2; ++m2) { const unsigned ro = (unsigned)(row0 + ai * HALF + (2 * mp + m2) * 16) * (unsigned)ldc + (unsigned)col0;
#pragma unroll
                    for (int bj = 0; bj < 2; ++bj)
#pragma unroll
                        for (int n = 0; n < 2; ++n) { hv[m2][bj][n] = *(const u32x2*)(Hs + (ro + bj * HALF + n * 16)); gv[m2][bj][n] = *(const u32x2*)(SG + (ro + bj * HALF + n * 16)); } }
                EPI_FENCE();
#pragma unroll
                for (int m2 = 0; m2 < 2; ++m2) { const int m = 2 * mp + m2; float part = 0.f;
#pragma unroll
                    for (int bj = 0; bj < 2; ++bj)
#pragma unroll
                        for (int n = 0; n < 2; ++n) { const f32x4 a = acc[ai][bj][m][n]; const u32x2 gw = gv[m2][bj][n], hw = hv[m2][bj][n]; f32x4 v;
                            v[0] = bflo(hw.x) + bflo(gw.x) * a[0]; v[1] = bfhi(hw.x) + bfhi(gw.x) * a[1]; v[2] = bflo(hw.y) + bflo(gw.y) * a[2]; v[3] = bfhi(hw.y) + bfhi(gw.y) * a[3];
                            const u32x2 o = pk4(v); res[ai][m][bj][n] = o;
                            const float r0 = bflo(o.x), r1 = bfhi(o.x), r2 = bflo(o.y), r3 = bfhi(o.y); part += (r0 * r0 + r1 * r1) + (r2 * r2 + r3 * r3); }
                    part += __shfl_xor(part, 16); part += __shfl_xor(part, 32);
                    if (fq == 0) ((LAS float*)(lds + EPI_RED_OFF))[(ai * HALF + wr * 64 + m * 16 + frq) * 4 + wc] = part; }
                EPI_FENCE();
            }
#pragma unroll
        for (int ai = 0; ai < 2; ++ai)
#pragma unroll
            for (int m = 0; m < 4; ++m) { const unsigned ro = (unsigned)(row0 + ai * HALF + m * 16) * (unsigned)ldc + (unsigned)col0;
#pragma unroll
                for (int bj = 0; bj < 2; ++bj)
#pragma unroll
                    for (int n = 0; n < 2; ++n) *(u32x2*)(Hd + (ro + bj * HALF + n * 16)) = res[ai][m][bj][n]; }
        EPI_BARRIER();
        { int t = wr * 256 + wc * 64 + fq * 16 + fr; OPAQUE_V(t); if (t < 256) { const f32x4 q = *(const LAS f32x4*)(lds + EPI_RED_OFF + t * 16); ssq_out[(size_t)(u.pm * BM + t) * 4 + u.pn] = (q[0] + q[1]) + (q[2] + q[3]); } }
    }
};
struct EpiMerge {
    static constexpr bool PERM = true, MIDK = true;
    bf16_t* MH; const bf16_t* G; int ldg;
    DEVFN void pre(const Unit&, int, int) const {}
    DEVFN void gate8(unsigned off, f32x4& g0, f32x4& g1) const { unpack8(*(const u32x4*)(G + off), g0, g1); }
    DEVFN void unpack8(u32x4 w, f32x4& g0, f32x4& g1) const {
        g0[0] = fmaxf(bflo(w.x), 1e-30f); g0[1] = fmaxf(bfhi(w.x), 1e-30f); g0[2] = fmaxf(bflo(w.y), 1e-30f); g0[3] = fmaxf(bfhi(w.y), 1e-30f);
        g1[0] = fmaxf(bflo(w.z), 1e-30f); g1[1] = fmaxf(bfhi(w.z), 1e-30f); g1[2] = fmaxf(bflo(w.w), 1e-30f); g1[3] = fmaxf(bfhi(w.w), 1e-30f); }
    DEVFN void mid(f32x4 (&acc)[2][2][4][2], const Unit& u, int wr, int wc, int fr, int fq, int x) const {
        OPAQUE_V(fr); OPAQUE_V(fq);
        const int row0 = u.pm * BM + wr * 64 + fr; const unsigned col0 = (unsigned)(u.pn * BM + wc * 32 + 8 * fq) + (unsigned)x * (unsigned)(SLAB * D);
#pragma unroll
        for (int ai = 0; ai < 2; ++ai) {
            u32x4 gn[4][2], gd[4][2];
#pragma unroll
            for (int m = 0; m < 4; ++m) { const unsigned off = (unsigned)(row0 + ai * HALF + m * 16) * (unsigned)ldg + col0;
#pragma unroll
                for (int bj = 0; bj < 2; ++bj) { gn[m][bj] = *(const u32x4*)(G + (off + bj * HALF)); gd[m][bj] = *(const u32x4*)(G + (off + (unsigned)(SLAB * D) + bj * HALF)); } }
            EPI_FENCE();
#pragma unroll
            for (int m = 0; m < 4; ++m)
#pragma unroll
                for (int bj = 0; bj < 2; ++bj) { f32x4 n0, n1, d0, d1; unpack8(gn[m][bj], n0, n1); unpack8(gd[m][bj], d0, d1);
#pragma unroll
                    for (int j = 0; j < 4; ++j) { acc[ai][bj][m][0][j] *= n0[j] * frcp(d0[j]); acc[ai][bj][m][1][j] *= n1[j] * frcp(d1[j]); } }
            EPI_FENCE();
        }
    }
    DEVFN void operator()(const f32x4 (&acc)[2][2][4][2], const Unit& u, int wr, int wc, int fr, int fq, int) const {
        OPAQUE_V(fr); OPAQUE_V(fq);
        const int row0 = u.pm * BM + wr * 64 + fr, col0 = u.pn * BM + wc * 32 + 8 * fq;
        u32x4 res[2][4][2];
#pragma unroll
        for (int ai = 0; ai < 2; ++ai) {
            u32x4 gc[4][2];
#pragma unroll
            for (int m = 0; m < 4; ++m)
#pragma unroll
                for (int bj = 0; bj < 2; ++bj) gc[m][bj] = *(const u32x4*)(G + ((unsigned)(row0 + ai * HALF + m * 16) * (unsigned)ldg + 2u * (unsigned)(SLAB * D) + col0 + bj * HALF));
            EPI_FENCE();
#pragma unroll
            for (int m = 0; m < 4; ++m)
#pragma unroll
                for (int bj = 0; bj < 2; ++bj) { f32x4 g0, g1; unpack8(gc[m][bj], g0, g1);
                    const f32x4 v0 = acc[ai][bj][m][0] * g0, v1 = acc[ai][bj][m][1] * g1;
                    u32x4 w; w.x = pk2(v0[0], v0[1]); w.y = pk2(v0[2], v0[3]); w.z = pk2(v1[0], v1[1]); w.w = pk2(v1[2], v1[3]); res[ai][m][bj] = w; }
            EPI_FENCE();
        }
#pragma unroll
        for (int ai = 0; ai < 2; ++ai)
#pragma unroll
            for (int m = 0; m < 4; ++m) { const unsigned row = (unsigned)(row0 + ai * HALF + m * 16);
#pragma unroll
                for (int bj = 0; bj < 2; ++bj) *(u32x4*)(MH + row * (unsigned)D + col0 + bj * HALF) = res[ai][m][bj]; }
    }
};
struct EpiInProj {
    static constexpr bool PERM = true, MIDK = false;
    bf16_t* O; const float* cosT; const float* sinT; const float* lb; int row_base; const float* ssq; LAS unsigned char* lds;
    DEVFN void pre(const Unit& u, int par, int tid) const { rinv_pre(ssq, lds, u.pm, par, tid); }
    DEVFN unsigned zdst(int cb, int cw, int row) const {
        if (cb < OFF_QB) { const int sec = (cb / 768) * 768; return zoff(sec, 64, (cb - sec) / 64 + (cw >> 6), row, cw & 63); }
        if (cb < OFF_MG) { const int sec = OFF_QB + ((cb - OFF_QB) / 512) * 512; return zoff(sec, 128, (cb - sec) / 128, row, cw); }
        const int x = (cb - OFF_MG) / D, c = (cb - OFF_MG) % D; return (unsigned)SLAB * (unsigned)OFF_MG + (unsigned)x * (unsigned)(SLAB * D) + (unsigned)row * (unsigned)D + (unsigned)(c + cw);
    }
    DEVFN void store8(int cb, int cw, int row, f32x4 v0, f32x4 v1) const { u32x4 w; w.x = pk2(v0[0], v0[1]); w.y = pk2(v0[2], v0[3]); w.z = pk2(v1[0], v1[1]); w.w = pk2(v1[2], v1[3]); *(u32x4*)(O + zdst(cb, cw, row)) = w; }
    DEVFN void operator()(const f32x4 (&acc)[2][2][4][2], const Unit& u, int wr, int wc, int fr, int fq, int par) const {
        const int pn = u.pn;
        const int mode = pn < 9 ? 0 : pn < 13 ? 1 : pn < 15 ? 0 : pn < 19 ? 2 : pn < 23 ? 3 : pn < 25 ? 0 : pn < 27 ? 2 : 4;
        int cw = wc * 32 + 8 * fq; OPAQUE_V(cw);
        const int row0 = u.pm * BM + wr * 64 + fr, col0 = pn * BM + cw;
        if (mode == 1) {
#pragma unroll
            for (int ai = 0; ai < 2; ++ai) {
                f32x4 cq[4], sq[4];
#pragma unroll
                for (int m = 0; m < 4; ++m) { const int pos = pos_of(row_base + row0 + ai * HALF + m * 16); cq[m] = *(const f32x4*)(cosT + pos * 64 + 4 * (4 * wc + fq)); sq[m] = *(const f32x4*)(sinT + pos * 64 + 4 * (4 * wc + fq)); }
                EPI_FENCE();
#pragma unroll
                for (int m = 0; m < 4; ++m) { const int row = row0 + ai * HALF + m * 16; const float ri = rinv_get(lds, par, ai * HALF + wr * 64 + m * 16 + fr); const f32x4 c4 = cq[m], s4 = sq[m];
#pragma unroll
                    for (int bj = 0; bj < 2; ++bj) { const f32x4 v0 = acc[ai][bj][m][0] * ri, v1 = acc[ai][bj][m][1] * ri; store8(pn * BM + bj * HALF, cw, row, v0 * c4 - v1 * s4, v0 * s4 + v1 * c4); } }
                EPI_FENCE();
            }
        } else if (mode == 3) {
            f32x4 lbv[2][2];
#pragma unroll
            for (int bj = 0; bj < 2; ++bj) { const int lc = (col0 + bj * HALF - OFF_FCF) & 511; lbv[bj][0] = *(const f32x4*)(lb + lc); lbv[bj][1] = *(const f32x4*)(lb + lc + 4); }
            EPI_FENCE();
#pragma unroll
            for (int ai = 0; ai < 2; ++ai)
#pragma unroll
                for (int m = 0; m < 4; ++m) { const int row = row0 + ai * HALF + m * 16; const float ri = rinv_get(lds, par, ai * HALF + wr * 64 + m * 16 + fr);
#pragma unroll
                    for (int bj = 0; bj < 2; ++bj) { f32x4 v0 = acc[ai][bj][m][0] * ri, v1 = acc[ai][bj][m][1] * ri; const f32x4 l0 = lbv[bj][0], l1 = lbv[bj][1];
#pragma unroll
                        for (int j = 0; j < 4; ++j) { v0[j] = fmaxf(flog(l0[j] + (1.f - l0[j]) * fsigmoid(v0[j])), -30.f); v1[j] = fmaxf(flog(l1[j] + (1.f - l1[j]) * fsigmoid(v1[j])), -30.f); }
                        u32x4 w; w.x = f2h(v0[0]) | (f2h(v0[1]) << 16); w.y = f2h(v0[2]) | (f2h(v0[3]) << 16); w.z = f2h(v1[0]) | (f2h(v1[1]) << 16); w.w = f2h(v1[2]) | (f2h(v1[3]) << 16);
                        *(u32x4*)(O + zdst(pn * BM + bj * HALF, cw, row)) = w; } }
        } else {
#pragma unroll
            for (int ai = 0; ai < 2; ++ai)
#pragma unroll
                for (int m = 0; m < 4; ++m) { const int row = row0 + ai * HALF + m * 16; const float ri = rinv_get(lds, par, ai * HALF + wr * 64 + m * 16 + fr);
#pragma unroll
                    for (int bj = 0; bj < 2; ++bj) { f32x4 v0 = acc[ai][bj][m][0] * ri, v1 = acc[ai][bj][m][1] * ri;
                        if (mode == 2) {
#pragma unroll
                            for (int j = 0; j < 4; ++j) { v0[j] = fsilu(v0[j]); v1[j] = fsilu(v1[j]); } }
                        else if (mode == 4) {
#pragma unroll
                            for (int j = 0; j < 4; ++j) { v0[j] = fsigmoid(v0[j]); v1[j] = fsigmoid(v1[j]); } }
                        store8(pn * BM + bj * HALF, cw, row, v0, v1); } }
        }
    }
};

#ifndef CPU_EMU
#define PG8_LAS __attribute__((address_space(3)))
template <class Epi, class Sched, bool ALIGN_EPI = true, bool SP2 = true>
__device__ __forceinline__ void gemm_phase(int w0, PG8_LAS unsigned char* lds, const Gemm g, const Sched S, const Epi E) {
    const int tid = opaque_tid(w0), wid = __builtin_amdgcn_readfirstlane(tid >> 6), lane = tid & 63, wr = wid >> 2, wc = wid & 3, fr = lane & 15, fq = lane >> 4;
    const int K = g.K, nt = K / BK;
    unsigned voffA[2], voffB[2];
#pragma unroll
    for (int i = 0; i < 2; ++i) { int R, C; stage_rc(tid * 16 + i * 8192, R, C); const int Rb = Epi::PERM ? ((R & ~31) + perm32(R & 31)) : R;
        voffA[i] = (unsigned)(R * g.lda + C) * 2u; voffB[i] = (unsigned)(Rb * g.ldb + C) * 2u; }
    const size_t kstep = (size_t)(BK * 2);
    const size_t hstepA = (size_t)HALF * g.lda * 2, hstepB = (size_t)HALF * g.ldb * 2;
    const size_t tstepA = 2 * hstepA, tstepB = 2 * hstepB;
    const unsigned ldsw = (unsigned)wid * 1024u;
    const int aoff = lds_byte(wr * 64 + fr, fq * 8), boff = lds_byte(wc * 32 + fr, fq * 8);
#define PG8_SA(b, h) (((b) * 2 + (h)) * HTB)
#define PG8_SB(b, h) ((4 + (b) * 2 + (h)) * HTB)
#define PG8_STAGE(bufoff, gbase, voff) do { _Pragma("unroll") for (int _i = 0; _i < 2; ++_i) \
        __builtin_amdgcn_global_load_lds((const unsigned*)((const char*)(gbase) + (voff)[_i]), (PG8_LAS unsigned*)(lds + (bufoff) + ldsw + _i * 8192), 16, 0, 0); } while (0)
#define PG8_LDA(dst, b, h) do { _Pragma("unroll") for (int m = 0; m < 4; ++m) _Pragma("unroll") for (int k = 0; k < 2; ++k) dst[m][k] = *(const PG8_LAS bf16x8*)(lds + PG8_SA(b, h) + aoff + m * 2048 + k * 1024); } while (0)
#define PG8_LDB(dst, b, h) do { _Pragma("unroll") for (int n = 0; n < 2; ++n) _Pragma("unroll") for (int k = 0; k < 2; ++k) dst[n][k] = *(const PG8_LAS bf16x8*)(lds + PG8_SB(b, h) + boff + n * 2048 + k * 1024); } while (0)
#define PG8_MMA(ai, bj, At, Bt) do { __builtin_amdgcn_s_setprio(1); _Pragma("unroll") for (int m = 0; m < 4; ++m) _Pragma("unroll") for (int n = 0; n < 2; ++n) _Pragma("unroll") for (int k = 0; k < 2; ++k) \
        acc[ai][bj][m][n] = __builtin_amdgcn_mfma_f32_16x16x32_bf16(Bt[n][k], At[m][k], acc[ai][bj][m][n], 0, 0, 0); __builtin_amdgcn_s_setprio(0); } while (0)
#define PG8_WAIT_V(n) asm volatile("s_waitcnt vmcnt(" #n ")" ::: "memory")
#define PG8_WAIT_L(n) asm volatile("s_waitcnt lgkmcnt(" #n ")" ::: "memory")
#define PG8_BAR __builtin_amdgcn_s_barrier()
#define PG8_SCHED __builtin_amdgcn_sched_barrier(0)
    Unit cur, nxt; int ui = 0;
    if (!S.next(0, cur)) return;
    f32x4 acc[2][2][4][2];
#pragma unroll
    for (int a = 0; a < 2; ++a)
#pragma unroll
        for (int b = 0; b < 2; ++b)
#pragma unroll
            for (int m = 0; m < 4; ++m)
#pragma unroll
                for (int n = 0; n < 2; ++n) acc[a][b][m][n] = (f32x4){0.f, 0.f, 0.f, 0.f};
    bf16x8 At[4][2], B0[2][2], B1[2][2];
    const char* cA = (const char*)g.A + (size_t)cur.pm * tstepA; const char* cB = (const char*)g.Bt + (size_t)cur.pn * tstepB;
    S.a_ready(cur);
    E.pre(cur, 0, wid * 64 + lane_id_v());
    if constexpr (SP2) {
        PG8_STAGE(PG8_SB(0, 0), cB, voffB); PG8_STAGE(PG8_SB(0, 1), cB + hstepB, voffB); PG8_STAGE(PG8_SA(0, 0), cA, voffA); PG8_STAGE(PG8_SA(0, 1), cA + hstepA, voffA);
        if (wr == 1) PG8_BAR;
        PG8_WAIT_V(2); PG8_BAR;
        PG8_STAGE(PG8_SB(1, 0), cB + kstep, voffB); PG8_STAGE(PG8_SA(1, 0), cA + kstep, voffA); PG8_STAGE(PG8_SB(1, 1), cB + hstepB + kstep, voffB);
        PG8_WAIT_V(6); PG8_BAR;
    } else {
        PG8_STAGE(PG8_SB(0, 0), cB, voffB); PG8_STAGE(PG8_SA(0, 0), cA, voffA); PG8_STAGE(PG8_SB(0, 1), cB + hstepB, voffB); PG8_STAGE(PG8_SA(0, 1), cA + hstepA, voffA);
        if (wr == 1) PG8_BAR;
        PG8_WAIT_V(4); PG8_BAR;
        PG8_STAGE(PG8_SB(1, 0), cB + kstep, voffB); PG8_STAGE(PG8_SA(1, 0), cA + kstep, voffA); PG8_STAGE(PG8_SB(1, 1), cB + hstepB + kstep, voffB);
        PG8_WAIT_V(6); PG8_BAR;
    }
    for (;;) {
        const bool has_next = S.next(ui + 1, nxt);
        const char* nA = has_next ? (const char*)g.A + (size_t)nxt.pm * tstepA : cA; const char* nB = has_next ? (const char*)g.Bt + (size_t)nxt.pn * tstepB : cB;
        constexpr int NSEG = Epi::MIDK ? 3 : 1;
#pragma nounroll
        for (int seg = 0; seg < NSEG; ++seg) {
        const int tb = Epi::MIDK ? (seg == 0 ? 0 : (seg == 1 ? 4 : 12)) : 0, te = Epi::MIDK ? (seg == 0 ? 4 : (seg == 1 ? 12 : nt)) : nt;
#pragma nounroll
        for (int t = tb; t < te; t += 2) {
            const bool last = (t == nt - 2);
            const char* a1 = cA + (size_t)(t + 1) * kstep;
            const char* a2 = last ? nA : cA + (size_t)(t + 2) * kstep; const char* b2 = last ? nB : cB + (size_t)(t + 2) * kstep;
            const char* a3 = a2 + kstep; const char* b3 = b2 + kstep;
            if (last && has_next) S.a_ready(nxt);
            if constexpr (SP2) {
            PG8_LDB(B0, 0, 0); PG8_LDB(B1, 0, 1); PG8_SCHED; PG8_LDA(At, 0, 0); PG8_STAGE(PG8_SA(1, 1), a1 + hstepA, voffA);
            PG8_WAIT_V(8); PG8_WAIT_L(0); PG8_BAR; PG8_MMA(0, 0, At, B0); PG8_MMA(0, 1, At, B1); PG8_BAR; PG8_SCHED;
            PG8_LDA(At, 0, 1); PG8_STAGE(PG8_SB(0, 0), b2, voffB); PG8_STAGE(PG8_SB(0, 1), b2 + hstepB, voffB); PG8_STAGE(PG8_SA(0, 0), a2, voffA);
            PG8_WAIT_V(8); PG8_WAIT_L(0); PG8_BAR; PG8_MMA(1, 0, At, B0); PG8_MMA(1, 1, At, B1); PG8_BAR; PG8_SCHED;
            PG8_LDB(B0, 1, 0); PG8_LDB(B1, 1, 1); PG8_SCHED; PG8_LDA(At, 1, 0); PG8_STAGE(PG8_SA(0, 1), a2 + hstepA, voffA);
            PG8_WAIT_V(8); PG8_WAIT_L(0); PG8_BAR; PG8_MMA(0, 0, At, B0); PG8_MMA(0, 1, At, B1); PG8_BAR; PG8_SCHED;
            PG8_LDA(At, 1, 1); PG8_STAGE(PG8_SB(1, 0), b3, voffB); PG8_STAGE(PG8_SB(1, 1), b3 + hstepB, voffB); PG8_STAGE(PG8_SA(1, 0), a3, voffA);
            PG8_WAIT_V(8); PG8_WAIT_L(0); PG8_BAR; PG8_MMA(1, 0, At, B0); PG8_MMA(1, 1, At, B1); PG8_BAR; PG8_SCHED;
            } else {
            PG8_LDB(B0, 0, 0); PG8_SCHED; PG8_LDA(At, 0, 0); PG8_STAGE(PG8_SA(1, 1), a1 + hstepA, voffA);
            PG8_WAIT_L(8); PG8_BAR; PG8_WAIT_L(0); PG8_MMA(0, 0, At, B0); PG8_BAR; PG8_SCHED;
            PG8_LDB(B1, 0, 1); PG8_STAGE(PG8_SB(0, 0), b2, voffB);
            PG8_BAR; PG8_WAIT_L(0); PG8_MMA(0, 1, At, B1); PG8_BAR;
            PG8_LDA(At, 0, 1); PG8_STAGE(PG8_SA(0, 0), a2, voffA);
            PG8_BAR; PG8_WAIT_L(0); PG8_MMA(1, 0, At, B0); PG8_BAR; PG8_SCHED;
            PG8_STAGE(PG8_SB(0, 1), b2 + hstepB, voffB);
            PG8_WAIT_V(6); PG8_BAR; PG8_MMA(1, 1, At, B1); PG8_BAR;
            PG8_LDB(B0, 1, 0); PG8_SCHED; PG8_LDA(At, 1, 0); PG8_STAGE(PG8_SA(0, 1), a2 + hstepA, voffA);
            PG8_WAIT_L(8); PG8_BAR; PG8_WAIT_L(0); PG8_MMA(0, 0, At, B0); PG8_BAR; PG8_SCHED;
            PG8_LDB(B1, 1, 1); PG8_STAGE(PG8_SB(1, 0), b3, voffB);
            PG8_BAR; PG8_WAIT_L(0); PG8_MMA(0, 1, At, B1); PG8_BAR;
            PG8_LDA(At, 1, 1); PG8_STAGE(PG8_SA(1, 0), a3, voffA);
            PG8_BAR; PG8_WAIT_L(0); PG8_MMA(1, 0, At, B0); PG8_BAR; PG8_SCHED;
            PG8_STAGE(PG8_SB(1, 1), b3 + hstepB, voffB);
            PG8_WAIT_V(6); PG8_BAR; PG8_MMA(1, 1, At, B1); PG8_BAR;
            }
        }
        if constexpr (Epi::MIDK) { if (seg < 2) E.mid(acc, cur, wr, wc, fr, fq, seg); }
        }
        if constexpr (ALIGN_EPI) { if (wr == 0) PG8_BAR; }
        E(acc, cur, wr, wc, fr, fq, ui & 1); S.done(cur);
        if (!has_next) break;
        E.pre(nxt, (ui + 1) & 1, wid * 64 + lane_id_v());
#pragma unroll
        for (int a = 0; a < 2; ++a)
#pragma unroll
            for (int b = 0; b < 2; ++b)
#pragma unroll
                for (int m = 0; m < 4; ++m)
#pragma unroll
                    for (int n = 0; n < 2; ++n) acc[a][b][m][n] = (f32x4){0.f, 0.f, 0.f, 0.f};
        cur = nxt; cA = nA; cB = nB; ++ui;
        if constexpr (ALIGN_EPI) { if (wr == 1) PG8_BAR; }
    }
    PG8_WAIT_V(0);
    if constexpr (!ALIGN_EPI) { if (wr == 0) PG8_BAR; }
    PG8_BAR;
#undef PG8_SA
#undef PG8_SB
#undef PG8_STAGE
#undef PG8_LDA
#undef PG8_LDB
#undef PG8_MMA
#undef PG8_WAIT_V
#undef PG8_WAIT_L
#undef PG8_BAR
#undef PG8_SCHED
}
#else
template <class Epi, class Sched, bool ALIGN_EPI = true, bool SP2 = true>
void gemm_phase(int w0, unsigned char* lds, const Gemm g, const Sched& S, const Epi& E) {
    (void)lds; const int tid = opaque_tid(w0), wid = tid >> 6, lane = tid & 63, wr = wid >> 2, wc = wid & 3, fr = lane & 15, fq = lane >> 4;
    Unit cur;
    for (int ui = 0; S.next(ui, cur); ++ui) {
        E.pre(cur, ui & 1, tid); __syncthreads();
        f32x4 acc[2][2][4][2];
        for (int ai = 0; ai < 2; ++ai) for (int bj = 0; bj < 2; ++bj) for (int m = 0; m < 4; ++m) for (int n = 0; n < 2; ++n) for (int j = 0; j < 4; ++j) {
            const int row = 256 * cur.pm + 128 * ai + 64 * wr + 16 * m + fr;
            const int col = Epi::PERM ? 256 * cur.pn + 128 * bj + 32 * wc + 8 * fq + 4 * n + j : 256 * cur.pn + 128 * bj + 32 * wc + 16 * n + 4 * fq + j;
            acc[ai][bj][m][n][j] = 0.f; }
        const int nseg = Epi::MIDK ? 3 : 1; const int kb[4] = {0, Epi::MIDK ? 256 : g.K, 768, g.K};
        for (int sg = 0; sg < nseg; ++sg) {
            for (int ai = 0; ai < 2; ++ai) for (int bj = 0; bj < 2; ++bj) for (int m = 0; m < 4; ++m) for (int n = 0; n < 2; ++n) for (int j = 0; j < 4; ++j) {
                const int row = 256 * cur.pm + 128 * ai + 64 * wr + 16 * m + fr;
                const int col = Epi::PERM ? 256 * cur.pn + 128 * bj + 32 * wc + 8 * fq + 4 * n + j : 256 * cur.pn + 128 * bj + 32 * wc + 16 * n + 4 * fq + j;
                const bf16_t* a = g.A + (size_t)row * g.lda; const bf16_t* b = g.Bt + (size_t)col * g.ldb; float s = 0.f;
                for (int k = kb[sg]; k < kb[sg + 1]; ++k) s += bf2f(a[k]) * bf2f(b[k]);
                acc[ai][bj][m][n][j] += s; }
            if constexpr (Epi::MIDK) { if (sg < 2) E.mid(acc, cur, wr, wc, fr, fq, sg); }
        }
        E(acc, cur, wr, wc, fr, fq, ui & 1);
    }
}
#endif
}

#ifndef CPU_EMU
#define XB_TMO      128
#define XB_XCNT(j)  (256  + 64 * (j))
#define XB_XSUB(j)  (1280 + 64 * (j))
#define XB_XGEN(j)  (2304 + 64 * (j))
#define XB_TOP      3328
#define XB_TOPGEN   3392
#define XCD_BAR_WORDS 3456
#define XB_SPIN_CAP (1u << 22)
__device__ __forceinline__ unsigned xb_ld(unsigned* p)              { return __hip_atomic_load(p, __ATOMIC_RELAXED, __HIP_MEMORY_SCOPE_AGENT); }
__device__ __forceinline__ unsigned xb_add(unsigned* p, unsigned v) { return __hip_atomic_fetch_add(p, v, __ATOMIC_RELAXED, __HIP_MEMORY_SCOPE_AGENT); }
__device__ __forceinline__ unsigned xb_xcc_id() { return (unsigned)__builtin_amdgcn_s_getreg((3 << 11) | 20) & 0xFu; }
#define XB_SPIN(cond, bar) do { unsigned _sp = 0; while (cond) { __builtin_amdgcn_s_sleep(1); \
    if ((++_sp & 255u) == 0u) { if (xb_ld(&(bar)[XB_TMO])) break; if (_sp > XB_SPIN_CAP) { atomicAdd(&(bar)[XB_TMO], 1u); break; } } } } while (0)
struct XcdBarrier { unsigned* bar; unsigned x; volatile LAS unsigned* st; };
__device__ __forceinline__ XcdBarrier xcd_barrier_post(unsigned* bar, volatile LAS unsigned* st) {
    XcdBarrier b; b.bar = bar; b.x = xb_xcc_id(); b.st = st;
    if (threadIdx.x == 0) (void)xb_add(&bar[XB_XCNT(b.x)], 1u);
    return b;
}
__device__ __forceinline__ void xcd_barrier_complete(unsigned* bar, unsigned x, unsigned& nloc, unsigned& nx) {
    const unsigned G = gridDim.x * gridDim.y * gridDim.z;
    unsigned sum, cnt, mine, sp = 0u;
    for (;;) {
        sum = 0u; cnt = 0u; mine = 0u;
#pragma unroll
        for (unsigned j = 0; j < 16; ++j) { const unsigned c = xb_ld(&bar[XB_XCNT(j)]); sum += c; cnt += (c > 0u) ? 1u : 0u; mine = (j == x) ? c : mine; }
        if (sum == G) break;
        __builtin_amdgcn_s_sleep(1);
        if ((++sp & 255u) == 0u) { if (xb_ld(&bar[XB_TMO])) break; if (sp > XB_SPIN_CAP) { atomicAdd(&bar[XB_TMO], 1u); break; } }
    }
    nloc = mine > 0u ? mine : 1u; nx = cnt > 0u ? cnt : 1u;
}
__device__ __forceinline__ void xcd_barrier(const XcdBarrier& b, int w0) {
    asm volatile("s_waitcnt vmcnt(0)" ::: "memory");
    __syncthreads();
    if (w0 == 0 && lane_id_v() == 0) {
        unsigned* bar = b.bar;
        __builtin_amdgcn_s_waitcnt(0);
        unsigned nloc = b.st[0], nx = b.st[1];
        if (nloc == 0u) { xcd_barrier_complete(bar, b.x, nloc, nx); b.st[0] = nloc; b.st[1] = nx; }
        const unsigned old = xb_add(&bar[XB_XSUB(b.x)], 1u);
        const unsigned gen = old / nloc;
        if (old + 1u == (gen + 1u) * nloc) {
            __builtin_amdgcn_fence(__ATOMIC_RELEASE, "agent");
            asm volatile("s_waitcnt vmcnt(0)" ::: "memory");
            const unsigned og = xb_add(&bar[XB_TOP], 1u);
            const unsigned tg = og / nx;
            if (og + 1u == (tg + 1u) * nx) xb_add(&bar[XB_TOPGEN], 1u);
            else XB_SPIN(xb_ld(&bar[XB_TOPGEN]) == tg, bar);
            __builtin_amdgcn_fence(__ATOMIC_ACQUIRE, "agent");
            xb_add(&bar[XB_XGEN(b.x)], 1u);
            asm volatile("s_waitcnt vmcnt(0)" ::: "memory");
        } else {
            XB_SPIN(xb_ld(&bar[XB_XGEN(b.x)]) == gen, bar);
            __builtin_amdgcn_fence(__ATOMIC_ACQUIRE, "agent");
            asm volatile("s_waitcnt vmcnt(0)" ::: "memory");
        }
    }
    __syncthreads();
}
#endif

enum { I_XP = 0, I_XS, I_PP, I_PS, I_F1N, I_F1G, I_F1U, I_F1D, I_MIXN, I_WIN, I_RELB, I_RETN, I_HLB, I_HGN, I_WBA, I_WBB, I_WBC, I_WMG, I_WOUT, I_F2N, I_F2G, I_F2U, I_F2D, I_PLEN, I_WPG, I_WPP, I_FINN, N_INPUTS };
struct Args { const float* in[N_INPUTS]; float* out; unsigned char* ws; int lo, hi; };

DEVFN float wave_sum(float v) {
#pragma unroll
    for (int o = 1; o < 64; o <<= 1) v += __shfl_xor(v, o);
    return v;
}
DEVFN void init_rows(const Args& a, bf16_t* H, float* ssq0, int gw, int ngw, int lane) {
    constexpr int NC = D / 256, RB = 4;
    for (int row0 = gw; row0 < T; row0 += RB * ngw) {
        f32x4 x[RB][NC];
#pragma unroll
        for (int r = 0; r < RB; ++r) { const int row = row0 + r * ngw < T ? row0 + r * ngw : row0;
            const float* src = row < NP ? a.in[I_XP] + (size_t)row * D : a.in[I_XS] + (size_t)(row - NP) * D;
#pragma unroll
            for (int j = 0; j < NC; ++j) x[r][j] = *(const f32x4*)(src + 4 * (lane + 64 * j)); }
#pragma unroll
        for (int r = 0; r < RB; ++r) { const int row = row0 + r * ngw; if (row >= T) break;
            float s = 0.f;
#pragma unroll
            for (int j = 0; j < NC; ++j) { const int c = 4 * (lane + 64 * j); const u32x2 o = pk4(x[r][j]); *(u32x2*)(H + (size_t)row * D + c) = o;
                const float r0 = bflo(o.x), r1 = bfhi(o.x), r2 = bflo(o.y), r3 = bfhi(o.y); s += (r0 * r0 + r1 * r1) + (r2 * r2 + r3 * r3); }
            s = wave_sum(s);
            if (lane == 0) *(f32x4*)(ssq0 + 4 * (size_t)row) = (f32x4){s, 0.f, 0.f, 0.f}; }
    }
}
DEVFN void final_norm_rows(const bf16_t* H, float* out, const float* gfin, int gw, int ngw, int lane, float oscale) {
    constexpr int NC = D / 256, RB = 4;
    f32x4 gq[NC];
#pragma unroll
    for (int j = 0; j < NC; ++j) gq[j] = *(const f32x4*)(gfin + 4 * (lane + 64 * j));
    for (int row0 = gw; row0 < T; row0 += RB * ngw) {
        u32x2 w[RB][NC];
#pragma unroll
        for (int r = 0; r < RB; ++r) { const int row = row0 + r * ngw < T ? row0 + r * ngw : row0;
#pragma unroll
            for (int j = 0; j < NC; ++j) w[r][j] = *(const u32x2*)(H + (size_t)row * D + 4 * (lane + 64 * j)); }
#pragma unroll
        for (int r = 0; r < RB; ++r) { const int row = row0 + r * ngw; if (row >= T) break;
            f32x4 v[NC]; float s = 0.f;
#pragma unroll
            for (int j = 0; j < NC; ++j) { const u32x2 x = w[r][j]; v[j] = (f32x4){bflo(x.x), bfhi(x.x), bflo(x.y), bfhi(x.y)}; s += (v[j][0] * v[j][0] + v[j][1] * v[j][1]) + (v[j][2] * v[j][2] + v[j][3] * v[j][3]); }
            const float rinv = rms_rinv(wave_sum(s)) * oscale;
#pragma unroll
            for (int j = 0; j < NC; ++j) *(f32x4*)(out + (size_t)row * D + 4 * (lane + 64 * j)) = v[j] * rinv * gq[j]; }
    }
}
DEVFN void cvt_ple(const Args& a, int l, bf16_t* PB, int gtid, int nthr) {
    for (size_t it = gtid; it < (size_t)T * D_PLE / 8; it += nthr) {
        const size_t e = it * 8; const int row = (int)(e / D_PLE), c = (int)(e % D_PLE);
        const float* src = row < NP ? a.in[I_PP] + ((size_t)l * NP + row) * D_PLE + c : a.in[I_PS] + ((size_t)l * NS + (row - NP)) * D_PLE + c;
        const f32x4 x = *(const f32x4*)src, y = *(const f32x4*)(src + 4);
        u32x4 w; w.x = pk2(x[0], x[1]); w.y = pk2(x[2], x[3]); w.z = pk2(y[0], y[1]); w.w = pk2(y[2], y[3]);
        *(u32x4*)(PB + e) = w;
    }
}
DEVFN int t5_bucket(int rel) {
    const int ret = rel > 0 ? 16 : 0; const int n = rel < 0 ? -rel : rel;
    if (n < 8) return ret + n;
    int large = 8 + (int)(logf((float)n / 8.0f) / logf(128.0f) * 8.0f);
    large = large < 15 ? large : 15;
    return ret + large;
}
DEVFN void prologue_tables(const Args& a, float* rope, float* biasT, float* lbs, int gtid, int nthr) {
    for (int it = gtid; it < 4096 * 64; it += nthr) { const int pos = it >> 6, i = it & 63;
        const float inv = powf(10000.0f, -(float)i / 64.0f); const float ang = (float)pos * inv;
        rope[it] = cosf(ang); rope[4096 * 64 + it] = sinf(ang); }
    for (int it = gtid; it < 3 * 4 * 160; it += nthr) { const int idx = it % 160, gh = it / 160, g = gh >> 2, hh = gh & 3; const int o = idx - 16; const int dil = g == 0 ? 1 : (g == 1 ? 4 : 16);
        biasT[it] = (o >= 0 && o <= 128) ? a.in[I_RELB][t5_bucket((o - 64) * dil) * 12 + 4 * g + hh] : -1e30f; }
    for (int c = gtid; c < 512; c += nthr) {
        float mx = -3.0e38f; for (int l = 0; l < DEPTH; ++l) mx = fmaxf(mx, a.in[I_HLB][l * 512 + c]);
        float den = 0.f; for (int l = 0; l < DEPTH; ++l) den += expf(a.in[I_HLB][l * 512 + c] - mx);
        float cum = 0.f, first = 0.f;
        for (int l = 0; l < DEPTH; ++l) { cum += expf(a.in[I_HLB][l * 512 + c] - mx) / den; if (l == 0) first = cum; lbs[l * 512 + c] = cum - first; }
    }
}
DEVFN int rowmap(int mode, int nl) {
    if (mode == 1) return (nl >> 7) * 256 + (nl & 127);
    if (mode == 2) return (nl >> 7) * 256 + 128 + (nl & 127);
    if (mode == 3) { const int dl = nl & 127, nn = dl >> 6, rem = dl & 63; return (nl & ~127) + 8 * (rem >> 2) + 4 * nn + (rem & 3); }
    return nl;
}
struct CvtDesc { const float* W; int K, ldw, col0, ncols; bf16_t* dst; int ldd, koff, mode, row_off; const float* gain; float cscale; };
DEVFN void cvt_item(const CvtDesc& d, int item, LAS float* scr, int lane) {
    const int nblk = d.ncols / 32, kb = item / nblk, nb = item % nblk, k0 = 64 * kb, n0 = 32 * nb;
#pragma unroll
    for (int i = 0; i < 8; ++i) { const int kk = 8 * i + (lane >> 3), n4 = 4 * (lane & 7); const float gsc = (d.gain ? d.gain[k0 + kk] : 1.0f) * d.cscale;
        const f32x4 w = *(const f32x4*)(d.W + (size_t)(k0 + kk) * d.ldw + d.col0 + n0 + n4) * gsc;
        LAS float* p = scr + kk * 33 + n4; p[0] = w[0]; p[1] = w[1]; p[2] = w[2]; p[3] = w[3]; }
    __builtin_amdgcn_wave_barrier();
    const int c = lane & 7;
#pragma unroll
    for (int j = 0; j < 4; ++j) { const int n = (lane >> 3) + 8 * j; const LAS float* s = scr + (8 * c) * 33 + n;
        u32x4 o; o.x = pk2(s[0 * 33], s[1 * 33]); o.y = pk2(s[2 * 33], s[3 * 33]); o.z = pk2(s[4 * 33], s[5 * 33]); o.w = pk2(s[6 * 33], s[7 * 33]);
        *(u32x4*)(d.dst + (size_t)(d.row_off + rowmap(d.mode, n0 + n)) * d.ldd + d.koff + k0 + 8 * c) = o; }
    __builtin_amdgcn_wave_barrier();
}
constexpr int N_CVT = 18;
DEVFN CvtDesc cvt_desc(const Args& a, int l, bf16_t* WB, int i) {
    CvtDesc d; d.col0 = 0; d.koff = 0; d.mode = 0; d.row_off = 0; d.gain = nullptr; d.cscale = 1.0f;
    const float* win = a.in[I_WIN] + (size_t)l * D * N_IN;
    switch (i) {
    case 0: d.W = a.in[I_F1G] + (size_t)l * D * FF; d.K = D; d.ldw = FF; d.ncols = FF; d.dst = WB + WE_GU1; d.ldd = D; d.mode = 1; d.gain = a.in[I_F1N] + l * D; break;
    case 1: d.W = a.in[I_F1U] + (size_t)l * D * FF; d.K = D; d.ldw = FF; d.ncols = FF; d.dst = WB + WE_GU1; d.ldd = D; d.mode = 2; d.gain = a.in[I_F1N] + l * D; break;
    case 2: d.W = a.in[I_F1D] + (size_t)l * FF * D; d.K = FF; d.ldw = D; d.ncols = D; d.dst = WB + WE_D1; d.ldd = FF; break;
    case 3: d.W = win; d.K = D; d.ldw = N_IN; d.col0 = 0; d.ncols = 768; d.dst = WB + WE_IN; d.ldd = D; d.gain = a.in[I_MIXN] + l * D; d.cscale = 0.125f; break;
    case 4: d.W = win; d.K = D; d.ldw = N_IN; d.col0 = 768; d.ncols = 1536; d.dst = WB + WE_IN; d.ldd = D; d.row_off = 768; d.gain = a.in[I_MIXN] + l * D; break;
    case 5: d.W = win; d.K = D; d.ldw = N_IN; d.col0 = OFF_QB; d.ncols = 512; d.dst = WB + WE_IN; d.ldd = D; d.row_off = OFF_QB; d.mode = 3; d.gain = a.in[I_MIXN] + l * D; break;
    case 6: d.W = win; d.K = D; d.ldw = N_IN; d.col0 = OFF_KB; d.ncols = 512; d.dst = WB + WE_IN; d.ldd = D; d.row_off = OFF_KB; d.mode = 3; d.gain = a.in[I_MIXN] + l * D; d.cscale = 0.08838834764831845f; break;
    case 7: d.W = win; d.K = D; d.ldw = N_IN; d.col0 = OFF_VB; d.ncols = N_IN - OFF_VB; d.dst = WB + WE_IN; d.ldd = D; d.row_off = OFF_VB; d.gain = a.in[I_MIXN] + l * D; break;
    case 8: d.W = a.in[I_WMG] + (size_t)l * D * 3 * D; d.K = D; d.ldw = 3 * D; d.ncols = 3 * D; d.dst = WB + WE_IN; d.ldd = D; d.row_off = OFF_MG; d.gain = a.in[I_MIXN] + l * D; break;
    case 9: d.W = a.in[I_WBA] + (size_t)l * 256 * D; d.K = 256; d.ldw = D; d.ncols = D; d.dst = WB + WE_BR; d.ldd = MIXW; d.koff = 0; break;
    case 10: d.W = a.in[I_WBB] + (size_t)l * 512 * D; d.K = 512; d.ldw = D; d.ncols = D; d.dst = WB + WE_BR; d.ldd = MIXW; d.koff = 256; break;
    case 11: d.W = a.in[I_WBC] + (size_t)l * 512 * D; d.K = 512; d.ldw = D; d.ncols = D; d.dst = WB + WE_BR; d.ldd = MIXW; d.koff = 768; break;
    case 12: d.W = a.in[I_WOUT] + (size_t)l * D * D; d.K = D; d.ldw = D; d.ncols = D; d.dst = WB + WE_OUT; d.ldd = D; break;
    case 13: d.W = a.in[I_F2G] + (size_t)l * D * FF; d.K = D; d.ldw = FF; d.ncols = FF; d.dst = WB + WE_GU2; d.ldd = D; d.mode = 1; d.gain = a.in[I_F2N] + l * D; break;
    case 14: d.W = a.in[I_F2U] + (size_t)l * D * FF; d.K = D; d.ldw = FF; d.ncols = FF; d.dst = WB + WE_GU2; d.ldd = D; d.mode = 2; d.gain = a.in[I_F2N] + l * D; break;
    case 15: d.W = a.in[I_F2D] + (size_t)l * FF * D; d.K = FF; d.ldw = D; d.ncols = D; d.dst = WB + WE_D2; d.ldd = FF; break;
    case 16: d.W = a.in[I_WPG] + (size_t)l * D * D; d.K = D; d.ldw = D; d.ncols = D; d.dst = WB + WE_PG; d.ldd = D; d.gain = a.in[I_PLEN] + l * D; break;
    default: d.W = a.in[I_WPP] + (size_t)l * D_PLE * D; d.K = D_PLE; d.ldw = D; d.ncols = D; d.dst = WB + WE_PP; d.ldd = D_PLE; break;
    }
    return d;
}
DEVFN void convert_weights(const Args& a, int l, bf16_t* WB, LAS unsigned char* lds, int gw, int ngw, int wave, int lane) {
    LAS float* scr = (LAS float*)(lds + wave * 8704);
    for (int i = 0; i < N_CVT; ++i) {
        const CvtDesc d = cvt_desc(a, l, WB, i);
        const int nitems = (d.K / 64) * (d.ncols / 32);
        for (int it = gw; it < nitems; it += ngw) cvt_item(d, it, scr, lane);
    }
}

#ifndef CPU_EMU
DEVFN s16x4 lds_tr(const LAS bf16_t* p) { return __builtin_amdgcn_ds_read_tr16_b64_v4i16((LAS s16x4*)p); }
#else
s16x4 lds_tr(const bf16_t* p);
#endif
DEVFN bf16x8 tr8(const LAS bf16_t* X, int stride, int r0, int col0, int c16, int g4) {
    const LAS bf16_t* p = X + (r0 + 8 * g4 + (c16 >> 2)) * stride + col0 + 4 * (c16 & 3);
    return cat8(lds_tr(p), lds_tr(p + 4 * stride));
}
DEVFN bf16x8 tr8p(const LAS bf16_t* X, int stride, int r0, int col0, int c16, int g4) {
    const LAS bf16_t* p = X + (r0 + 4 * g4 + (c16 >> 2)) * stride + col0 + 4 * (c16 & 3);
    return cat8(lds_tr(p), lds_tr(p + 16 * stride));
}
DEVFN u32x4 scale8(u32x4 v, float s) {
    u32x4 o; o.x = pk2(bflo(v.x) * s, bfhi(v.x) * s); o.y = pk2(bflo(v.y) * s, bfhi(v.y) * s); o.z = pk2(bflo(v.z) * s, bfhi(v.z) * s); o.w = pk2(bflo(v.w) * s, bfhi(v.w) * s); return o;
}
template <class U> DEVFN void run_units(LAS unsigned char* lds, const U& ctx, int u0, int u1) {
    if (u0 >= u1) return;
    typename U::Regs L = ctx.load(u0);
    for (int u = u0; u < u1; ++u) {
        __syncthreads();
        ctx.stage(lds, L);
        const typename U::Regs N = ctx.load(u + 1 < u1 ? u + 1 : u);
        __syncthreads();
        ctx.compute(lds, L, u);
        L = N;
    }
}

template <class U, class F> DEVFN void run_units_k(LAS unsigned char* lds, const U& ctx, int u0, int u1, typename U::Regs L, F tail) {
    if (u0 >= u1) { tail(); return; }
    for (int u = u0; u + 1 < u1; ++u) {
        __syncthreads();
        ctx.stage(lds, L);
        const typename U::Regs N = ctx.load(u + 1);
        __syncthreads();
        ctx.compute(lds, L, u);
        L = N;
    }
    __syncthreads();
    ctx.stage(lds, L);
    tail();
    __syncthreads();
    int ul = u1 - 1; OPAQUE_SI(ul);
    ctx.compute(lds, L, ul);
}
template <class U> DEVFN void run_units2(LAS unsigned char* lds, const U& ctx, int u0, int u1) {
    if (u0 >= u1) return;
    typename U::Regs L; ctx.load1(L, u0); ctx.load2(L, u0);
    for (int u = u0; u < u1; ++u) {
        __syncthreads();
        ctx.stage(lds, L);
        typename U::Regs N; const int nu = u + 1 < u1 ? u + 1 : u;
        ctx.load1(N, nu);
        __syncthreads();
        ctx.compute(lds, L, u, N, nu);
        L = N;
    }
}
template <class U> DEVFN void run_units2_k(LAS unsigned char* lds, const U& ctx, int u0, int u1, typename U::Regs L) {
    if (u0 >= u1) return;
    ctx.load2(L, u0);
    for (int u = u0; u < u1; ++u) {
        __syncthreads();
        ctx.stage(lds, L);
        typename U::Regs N; const int nu = u + 1 < u1 ? u + 1 : u;
        ctx.load1(N, nu);
        __syncthreads();
        ctx.compute(lds, L, u, N, nu);
        L = N;
    }
}
struct AUnit {
    const bf16_t* Z; bf16_t* AO; float* LSE; const float* biasT; int S; int w0;
    struct Regs { u32x4 kv[4], vv[4]; bf16x8 bq[2]; f32x4 b; };
    struct Idx { int hh, g, dil, L, cb, head, rowbase, k0; };
    DEVFN Idx decode(int unit) const {
        Idx x; const int upb = S / 128; const int ub = unit % upb; int t = unit / upb; x.hh = t & 3; t >>= 2; x.g = t % 3; const int seq = t / 3;
        x.dil = x.g == 0 ? 1 : (x.g == 1 ? 4 : 16); x.L = S / x.dil; const int bpr = x.L / 128; const int r = ub / bpr; x.cb = ub % bpr;
        x.head = 4 * x.g + x.hh; x.rowbase = seq * S + r; x.k0 = 128 * x.cb - 64; return x;
    }
    DEVFN Regs load(int unit) const {
        const int tid = opaque_tid(w0), lane = tid & 63, w = tid >> 6, c16 = lane & 15, g4 = lane >> 4; const Idx x = decode(unit); Regs R;
#pragma unroll
        for (int i = 0; i < 4; ++i) {
            const int id = tid + 512 * i, key = id >> 3, ch = id & 7, ik = x.k0 + key;
            const int ikc = ik < 0 ? 0 : (ik < x.L ? ik : x.L - 1); const int zr = x.rowbase + ikc * x.dil;
            R.kv[i] = *(const u32x4*)(Z + zoff(OFF_KA, 64, x.head, zr, 8 * ch)); R.vv[i] = *(const u32x4*)(Z + zoff(OFF_VA, 64, x.head, zr, 8 * ch));
        }
        R.b = (f32x4){tid < 160 ? biasT[(x.g * 4 + x.hh) * 160 + tid] : 0.f, 0.f, 0.f, 0.f};
        const size_t qrow = (size_t)(x.rowbase + (128 * x.cb + 16 * w + c16) * x.dil);
#pragma unroll
        for (int ks = 0; ks < 2; ++ks) R.bq[ks] = *(const bf16x8*)(Z + zoff(OFF_QA, 64, x.head, (int)qrow, 32 * ks + 8 * g4));
        return R;
    }
    DEVFN void stage(LAS unsigned char* lds, const Regs& R) const {
        const int tid = opaque_tid(w0);
        LAS bf16_t* Ks = (LAS bf16_t*)lds; LAS bf16_t* Vs = (LAS bf16_t*)(lds + 256 * 72 * 2); LAS float* bs = (LAS float*)(lds + 2 * 256 * 72 * 2);
#pragma unroll
        for (int i = 0; i < 4; ++i) { const int id = tid + 512 * i, key = id >> 3, ch = id & 7; *(LAS u32x4*)(Ks + key * 72 + 8 * ch) = R.kv[i]; *(LAS u32x4*)(Vs + key * 72 + 8 * ch) = R.vv[i]; }
        if (tid < 160) bs[tid] = R.b[0];
    }
    DEVFN void compute(LAS unsigned char* lds, const Regs& R, int unit) const {
        const int tid = opaque_tid(w0), lane = tid & 63, w = tid >> 6, c16 = lane & 15, g4 = lane >> 4; const Idx x = decode(unit);
        const LAS bf16_t* Ks = (const LAS bf16_t*)lds; const LAS bf16_t* Vs = (const LAS bf16_t*)(lds + 256 * 72 * 2); const LAS float* bs = (const LAS float*)(lds + 2 * 256 * 72 * 2);
        const size_t qrow = (size_t)(x.rowbase + (128 * x.cb + 16 * w + c16) * x.dil);
        f32x4 sc[9]; float mx = -3.0e38f;
#pragma unroll
        for (int kt = 0; kt < 9; ++kt) {
            f32x4 acc = {0.f, 0.f, 0.f, 0.f};
#pragma unroll
            for (int ks = 0; ks < 2; ++ks) acc = mfma16(*(const LAS bf16x8*)(Ks + (16 * (w + kt) + c16) * 72 + 32 * ks + 8 * g4), R.bq[ks], acc);
            f32x4 bv;
#pragma unroll
            for (int rr = 0; rr < 4; ++rr) bv[rr] = bs[16 * kt + 4 * g4 + rr - c16 + 16];
            OPAQUE_V4(bv);
#pragma unroll
            for (int rr = 0; rr < 4; ++rr) {
                const int ik = x.k0 + 16 * (w + kt) + 4 * g4 + rr;
                const float s = (unsigned)ik < (unsigned)x.L ? acc[rr] + bv[rr] : -1e30f;
                acc[rr] = s; mx = fmaxf(mx, s);
            }
            sc[kt] = acc;
        }
        mx = fmaxf(mx, __shfl_xor(mx, 16)); mx = fmaxf(mx, __shfl_xor(mx, 32));
        float sum = 0.f;
#pragma unroll
        for (int kt = 0; kt < 9; ++kt)
#pragma unroll
            for (int rr = 0; rr < 4; ++rr) { const float p = fexp(sc[kt][rr] - mx); sc[kt][rr] = p; sum += p; }
        sum += __shfl_xor(sum, 16); sum += __shfl_xor(sum, 32);
        bf16x8 bp[5];
        const f32x4 zero4 = {0.f, 0.f, 0.f, 0.f};
#pragma unroll
        for (int pp = 0; pp < 5; ++pp) bp[pp] = pack8(sc[2 * pp], pp < 4 ? sc[2 * pp + 1] : zero4);
        const float inv = 1.0f / sum;
#pragma unroll
        for (int dt = 0; dt < 4; ++dt) {
            f32x4 acc = {0.f, 0.f, 0.f, 0.f};
#pragma unroll
            for (int pp = 0; pp < 5; ++pp) {
                const LAS bf16_t* p = Vs + (16 * (w + 2 * pp) + 4 * g4 + (c16 >> 2)) * 72 + 16 * dt + 4 * (c16 & 3);
                acc = mfma16(cat8(lds_tr(p), lds_tr(p + (pp < 4 ? 16 * 72 : 0))), bp[pp], acc);
            }
            *(u32x2*)(AO + qrow * AOW + x.head * 64 + 16 * dt + 4 * g4) = pk4(acc * inv);
        }
        if (g4 == 0) LSE[qrow * 12 + x.head] = mx + logf(sum);
    }
};
DEVFN void mixer_a_merge(const bf16_t* AO, const float* LSE, bf16_t* MIX, int gtid, int nthr) {
    for (int it = gtid; it < SLAB * 32; it += nthr) {
        const int row = it >> 5, hh = (it >> 3) & 3, c = it & 7;
        const float l0 = LSE[(size_t)row * 12 + hh], l1 = LSE[(size_t)row * 12 + 4 + hh], l2 = LSE[(size_t)row * 12 + 8 + hh];
        const float m = fmaxf(l0, fmaxf(l1, l2)); float w0 = fexp(l0 - m), w1 = fexp(l1 - m), w2 = fexp(l2 - m); const float inv = 1.0f / (w0 + w1 + w2); w0 *= inv; w1 *= inv; w2 *= inv;
        const u32x4 a0 = *(const u32x4*)(AO + (size_t)row * AOW + hh * 64 + 8 * c), a1 = *(const u32x4*)(AO + (size_t)row * AOW + (4 + hh) * 64 + 8 * c), a2 = *(const u32x4*)(AO + (size_t)row * AOW + (8 + hh) * 64 + 8 * c);
        u32x4 o;
        o.x = pk2(w0 * bflo(a0.x) + w1 * bflo(a1.x) + w2 * bflo(a2.x), w0 * bfhi(a0.x) + w1 * bfhi(a1.x) + w2 * bfhi(a2.x));
        o.y = pk2(w0 * bflo(a0.y) + w1 * bflo(a1.y) + w2 * bflo(a2.y), w0 * bfhi(a0.y) + w1 * bfhi(a1.y) + w2 * bfhi(a2.y));
        o.z = pk2(w0 * bflo(a0.z) + w1 * bflo(a1.z) + w2 * bflo(a2.z), w0 * bfhi(a0.z) + w1 * bfhi(a1.z) + w2 * bfhi(a2.z));
        o.w = pk2(w0 * bflo(a0.w) + w1 * bflo(a1.w) + w2 * bflo(a2.w), w0 * bfhi(a0.w) + w1 * bfhi(a1.w) + w2 * bfhi(a2.w));
        *(u32x4*)(MIX + (size_t)row * MIXW + hh * 64 + 8 * c) = o;
    }
}

struct BKvUnit {
    const bf16_t* Z; bf16_t* SB; int w0;
    struct Regs { u32x4 kv[4], vv[4]; };
    DEVFN Regs load(int unit) const {
        const int tid = opaque_tid(w0); const int h = unit & 3, row0 = (unit >> 2) * 128; Regs R;
#pragma unroll
        for (int i = 0; i < 4; ++i) { const int id = tid + 512 * i, j = id >> 4, ch = id & 15; R.kv[i] = *(const u32x4*)(Z + zoff(OFF_KB, 128, h, row0 + j, 8 * ch)); R.vv[i] = *(const u32x4*)(Z + zoff(OFF_VB, 128, h, row0 + j, 8 * ch)); }
        return R;
    }
    DEVFN void stage(LAS unsigned char* lds, const Regs& R) const { (void)lds; (void)R; }
    DEVFN void compute(LAS unsigned char* lds, const Regs& R, int unit) const {
        const int tid = opaque_tid(w0), lane = tid & 63, w = tid >> 6, c16 = lane & 15, g4 = lane >> 4;
        const int h = unit & 3;
        LAS bf16_t* Ks = (LAS bf16_t*)lds;
        LAS bf16_t* Vf = (LAS bf16_t*)(lds + 128 * 136 * 2);
        LAS bf16_t* Vb = (LAS bf16_t*)(lds + 2 * 128 * 136 * 2);
        const float l2f = ret_l2(0, h), l2b = ret_l2(1, h);
#pragma unroll
        for (int i = 0; i < 4; ++i) {
            const int id = tid + 512 * i, j = id >> 4, ch = id & 15;
            *(LAS u32x4*)(Ks + j * 136 + 8 * ch) = R.kv[i];
            *(LAS u32x4*)(Vf + j * 136 + 8 * ch) = scale8(R.vv[i], exp2f((float)(127 - j) * l2f));
            *(LAS u32x4*)(Vb + j * 136 + 8 * ch) = scale8(R.vv[i], exp2f((float)j * l2b));
        }
        __syncthreads();
        bf16x8 af[4];
#pragma unroll
        for (int ks = 0; ks < 4; ++ks) af[ks] = tr8(Ks, 136, 32 * ks, 16 * w, c16, g4);
#pragma unroll
        for (int dir = 0; dir < 2; ++dir) {
            const LAS bf16_t* V = dir ? Vb : Vf;
            bf16_t* dst = SB + ((size_t)unit * 2 + dir) * 16384;
#pragma unroll
            for (int b = 0; b < 8; ++b) {
                f32x4 acc = {0.f, 0.f, 0.f, 0.f};
#pragma unroll
                for (int ks = 0; ks < 4; ++ks) acc = mfma16(af[ks], tr8(V, 136, 32 * ks, 16 * b, c16, g4), acc);
                *(u32x2*)(dst + (16 * b + c16) * 128 + 16 * w + 4 * g4) = pk4(acc);
            }
        }
    }
};
DEVFN void mixer_scan(bf16_t* SB, bf16_t* SC, const float* GC, int nseq, int S, int gtid, int nthr) {
    const int nb = S / 128, nc = S / 64;
    for (int it = gtid; it < nseq * 8 * 2048; it += nthr) {
        const int e8 = it & 2047; int t = it >> 11; const int dir = t & 1, h = (t >> 1) & 3, seq = t >> 3;
        const float G = exp2f(128.0f * ret_l2(dir, h));
        float carry[8];
#pragma unroll
        for (int j = 0; j < 8; ++j) carry[j] = 0.f;
        for (int cc = 0; cc < nb; ++cc) {
            const int c = dir ? nb - 1 - cc : cc;
            bf16_t* p = SB + ((size_t)((seq * nb + c) * 4 + h) * 2 + dir) * 16384 + e8 * 8;
            const u32x4 v = *(const u32x4*)p;
            u32x4 o; o.x = pk2(carry[0], carry[1]); o.y = pk2(carry[2], carry[3]); o.z = pk2(carry[4], carry[5]); o.w = pk2(carry[6], carry[7]);
            *(u32x4*)p = o;
            carry[0] = carry[0] * G + bflo(v.x); carry[1] = carry[1] * G + bfhi(v.x); carry[2] = carry[2] * G + bflo(v.y); carry[3] = carry[3] * G + bfhi(v.y);
            carry[4] = carry[4] * G + bflo(v.z); carry[5] = carry[5] * G + bfhi(v.z); carry[6] = carry[6] * G + bflo(v.w); carry[7] = carry[7] * G + bfhi(v.w);
        }
    }
    for (int it = gtid; it < nseq * 8 * 2048; it += nthr) {
        const int e8 = it & 2047; int t = it >> 11; const int dir = t & 1, h = (t >> 1) & 3, seq = t >> 3;
        const int dk0 = (e8 & 15) * 8;
        float carry[8];
#pragma unroll
        for (int j = 0; j < 8; ++j) carry[j] = 0.f;
        for (int cc = 0; cc < nc; ++cc) {
            const int c = dir ? nc - 1 - cc : cc;
            const size_t ui = (size_t)((seq * nc + c) * 4 + h) * 2 + dir;
            bf16_t* p = SC + ui * 16384 + e8 * 8;
            const f32x4 g0 = *(const f32x4*)(GC + ui * 128 + dk0), g1 = *(const f32x4*)(GC + ui * 128 + dk0 + 4);
            const u32x4 v = *(const u32x4*)p;
            u32x4 o; o.x = pk2(carry[0], carry[1]); o.y = pk2(carry[2], carry[3]); o.z = pk2(carry[4], carry[5]); o.w = pk2(carry[6], carry[7]);
            *(u32x4*)p = o;
            carry[0] = carry[0] * g0[0] + bflo(v.x); carry[1] = carry[1] * g0[1] + bfhi(v.x); carry[2] = carry[2] * g0[2] + bflo(v.y); carry[3] = carry[3] * g0[3] + bfhi(v.y);
            carry[4] = carry[4] * g1[0] + bflo(v.z); carry[5] = carry[5] * g1[1] + bfhi(v.z); carry[6] = carry[6] * g1[2] + bflo(v.w); carry[7] = carry[7] * g1[3] + bfhi(v.w);
        }
    }
}
struct BOutUnit {
    const bf16_t* Z; const bf16_t* SB; bf16_t* MIX; const float* gain; int w0;
    struct Regs { u32x4 kv[4], vv[4], sf[4], sb[4]; bf16x8 bq[4]; f32x4 gn; };
    DEVFN Regs load(int unit) const {
        const int tid = opaque_tid(w0), lane = tid & 63, w = tid >> 6, c16 = lane & 15, g4 = lane >> 4; const int h = unit & 3, row0 = (unit >> 2) * 128; Regs R;
        const bf16_t* gSf = SB + ((size_t)unit * 2 + 0) * 16384; const bf16_t* gSb = SB + ((size_t)unit * 2 + 1) * 16384;
#pragma unroll
        for (int i = 0; i < 4; ++i) {
            const int id = tid + 512 * i, j = id >> 4, ch = id & 15;
            R.kv[i] = *(const u32x4*)(Z + zoff(OFF_KB, 128, h, row0 + j, 8 * ch)); R.vv[i] = *(const u32x4*)(Z + zoff(OFF_VB, 128, h, row0 + j, 8 * ch)); R.sf[i] = *(const u32x4*)(gSf + j * 128 + 8 * ch); R.sb[i] = *(const u32x4*)(gSb + j * 128 + 8 * ch);
        }
        const size_t row = (size_t)(row0 + 16 * w + c16);
#pragma unroll
        for (int ks = 0; ks < 4; ++ks) R.bq[ks] = *(const bf16x8*)(Z + zoff(OFF_QB, 128, h, (int)row, 32 * ks + 8 * g4));
        R.gn = (f32x4){gain[h * 128 + (tid & 127)], 0.f, 0.f, 0.f};
        return R;
    }
    DEVFN void stage(LAS unsigned char* lds, const Regs& R) const {
        const int tid = opaque_tid(w0);
        LAS bf16_t* Ks = (LAS bf16_t*)lds; LAS bf16_t* Vs = (LAS bf16_t*)(lds + 128 * 136 * 2); LAS bf16_t* Sf = (LAS bf16_t*)(lds + 2 * 128 * 136 * 2); LAS bf16_t* Sb = (LAS bf16_t*)(lds + 3 * 128 * 136 * 2);
#pragma unroll
        for (int i = 0; i < 4; ++i) { const int id = tid + 512 * i, j = id >> 4, ch = id & 15; const int o = j * 136 + 8 * ch;
            *(LAS u32x4*)(Ks + o) = R.kv[i]; *(LAS u32x4*)(Vs + o) = R.vv[i]; *(LAS u32x4*)(Sf + o) = R.sf[i]; *(LAS u32x4*)(Sb + o) = R.sb[i]; }
        if (tid < 128) ((LAS float*)(lds + 4 * 128 * 136 * 2))[tid] = R.gn[0];
    }
    DEVFN void compute(LAS unsigned char* lds, const Regs& R, int unit) const {
        const int tid = opaque_tid(w0), lane = tid & 63, w = tid >> 6, c16 = lane & 15, g4 = lane >> 4;
        const int h = unit & 3, row0 = (unit >> 2) * 128;
        const LAS bf16_t* Ks = (const LAS bf16_t*)lds;
        const LAS bf16_t* Vs = (const LAS bf16_t*)(lds + 128 * 136 * 2);
        const LAS bf16_t* Sf = (const LAS bf16_t*)(lds + 2 * 128 * 136 * 2);
        const LAS bf16_t* Sb = (const LAS bf16_t*)(lds + 3 * 128 * 136 * 2);
        const LAS float* gtab = (const LAS float*)(lds + 4 * 128 * 136 * 2);
        const float l2f = ret_l2(0, h), l2b = ret_l2(1, h);
        const int i = 16 * w + c16; const size_t row = (size_t)(row0 + i);
        u32x2 gwv[8];
#pragma unroll
        for (int dvt = 0; dvt < 8; ++dvt) gwv[dvt] = *(const u32x2*)(Z + zoff(OFF_GB, 128, h, (int)row, 16 * dvt + 4 * g4));
        f32x4 P[8];
#pragma unroll
        for (int jt = 0; jt < 8; ++jt) {
            f32x4 acc = {0.f, 0.f, 0.f, 0.f};
#pragma unroll
            for (int ks = 0; ks < 4; ++ks) acc = mfma16(*(const LAS bf16x8*)(Ks + (16 * jt + c16) * 136 + 32 * ks + 8 * g4), R.bq[ks], acc);
#pragma unroll
            for (int rr = 0; rr < 4; ++rr) { const int d = i - (16 * jt + 4 * g4 + rr); const float wgt = d > 0 ? exp2f((float)d * l2f) : (d < 0 ? exp2f((float)(-d) * l2b) : 2.0f); acc[rr] *= wgt; }
            P[jt] = acc;
        }
        bf16x8 bp[4];
#pragma unroll
        for (int k2 = 0; k2 < 4; ++k2) bp[k2] = pack8(P[2 * k2], P[2 * k2 + 1]);
        const float cf = exp2f((float)(i + 1) * l2f), cb = exp2f((float)(128 - i) * l2b);
        f32x4 o[8]; float s1 = 0.f;
#pragma unroll
        for (int dvt = 0; dvt < 8; ++dvt) {
            f32x4 aO = {0.f, 0.f, 0.f, 0.f}, aF = {0.f, 0.f, 0.f, 0.f}, aB = {0.f, 0.f, 0.f, 0.f};
#pragma unroll
            for (int k2 = 0; k2 < 4; ++k2) aO = mfma16(tr8p(Vs, 136, 32 * k2, 16 * dvt, c16, g4), bp[k2], aO);
#pragma unroll
            for (int ks = 0; ks < 4; ++ks) {
                aF = mfma16(*(const LAS bf16x8*)(Sf + (16 * dvt + c16) * 136 + 32 * ks + 8 * g4), R.bq[ks], aF);
                aB = mfma16(*(const LAS bf16x8*)(Sb + (16 * dvt + c16) * 136 + 32 * ks + 8 * g4), R.bq[ks], aB);
            }
            o[dvt] = aO + aF * cf + aB * cb;
            s1 += (o[dvt][0] + o[dvt][1]) + (o[dvt][2] + o[dvt][3]);
            EPI_FENCE();
        }
        s1 += __shfl_xor(s1, 16); s1 += __shfl_xor(s1, 32);
        const float mu = s1 * (1.0f / 128.0f); float s2 = 0.f;
#pragma unroll
        for (int dvt = 0; dvt < 8; ++dvt) { o[dvt] = o[dvt] - mu; s2 += (o[dvt][0] * o[dvt][0] + o[dvt][1] * o[dvt][1]) + (o[dvt][2] * o[dvt][2] + o[dvt][3] * o[dvt][3]); }
        s2 += __shfl_xor(s2, 16); s2 += __shfl_xor(s2, 32);
        const float rstd = 1.0f / sqrtf(s2 * (1.0f / 128.0f) + EPS);
#pragma unroll
        for (int dvt = 0; dvt < 8; ++dvt) {
            const int col = h * 128 + 16 * dvt + 4 * g4;
            const f32x4 gn = *(const LAS f32x4*)(gtab + 16 * dvt + 4 * g4); const u32x2 gw = gwv[dvt];
            f32x4 v = o[dvt] * rstd * gn; v[0] *= bflo(gw.x); v[1] *= bfhi(gw.x); v[2] *= bflo(gw.y); v[3] *= bfhi(gw.y);
            *(u32x2*)(MIX + row * MIXW + 256 + col) = pk4(v);
        }
    }
};

struct CRegs { u32x4 lf[4], v[2]; };
DEVFN CRegs c_load_common(const bf16_t* Z, int row0, int h, int tid) {
    CRegs R;
#pragma unroll
    for (int i = 0; i < 4; ++i) { const int id = tid + 512 * i, dir = id >> 10, j = (id >> 4) & 63, ch = id & 15; R.lf[i] = *(const u32x4*)(Z + zoff(OFF_FCF + dir * 512, 128, h, row0 + j, 8 * ch)); }
#pragma unroll
    for (int i = 0; i < 2; ++i) { const int id = tid + 512 * i, j = id >> 4, ch = id & 15; R.v[i] = *(const u32x4*)(Z + zoff(OFF_IC, 128, h, row0 + j, 8 * ch)); }
    return R;
}
DEVFN void c_stage_common(LAS float* LF, LAS bf16_t* Vs, const CRegs& R, int tid) {
#pragma unroll
    for (int i = 0; i < 4; ++i) {
        const int id = tid + 512 * i, dir = id >> 10, j = (id >> 4) & 63, ch = id & 15; const u32x4 v = R.lf[i];
        LAS float* d = LF + (dir * 64 + j) * 128 + 8 * ch;
        f32x4 a, b; a[0] = h2f(v.x & 0xffffu); a[1] = h2f(v.x >> 16); a[2] = h2f(v.y & 0xffffu); a[3] = h2f(v.y >> 16); b[0] = h2f(v.z & 0xffffu); b[1] = h2f(v.z >> 16); b[2] = h2f(v.w & 0xffffu); b[3] = h2f(v.w >> 16);
        *(LAS f32x4*)d = a; *(LAS f32x4*)(d + 4) = b;
    }
#pragma unroll
    for (int i = 0; i < 2; ++i) { const int id = tid + 512 * i, j = id >> 4, ch = id & 15; *(LAS u32x4*)(Vs + j * 136 + 8 * ch) = R.v[i]; }
}
struct CKvUnit {
    const bf16_t* Z; bf16_t* SC; float* GC; int w0;
    struct Regs { CRegs c; };
    DEVFN Regs load(int unit) const { Regs R; R.c = c_load_common(Z, (unit >> 2) * 64, unit & 3, opaque_tid(w0)); return R; }
    DEVFN void stage(LAS unsigned char* lds, const Regs& R) const { c_stage_common((LAS float*)lds, (LAS bf16_t*)(lds + 65536 + 2 * 64 * 136 * 2), R.c, opaque_tid(w0)); }
    DEVFN void compute(LAS unsigned char* lds, const Regs& R, int unit) const {
        (void)R; const int tid = opaque_tid(w0), lane = tid & 63, w = tid >> 6, c16 = lane & 15, g4 = lane >> 4;
        LAS float* LF = (LAS float*)lds;
        LAS bf16_t* Kx = (LAS bf16_t*)(lds + 65536);
        LAS bf16_t* Vs = (LAS bf16_t*)(lds + 65536 + 2 * 64 * 136 * 2);
        LAS float* tot = (LAS float*)(lds + 65536 + 3 * 64 * 136 * 2);
        {
            const int dir = tid >> 8, half = (tid >> 7) & 1, dk = tid & 127;
            LAS float* lf = LF + (dir * 64 + half * 32) * 128 + dk;
            float run = 0.f;
            if (dir == 0) { for (int j = 31; j >= 0; --j) { const float x = lf[j * 128]; lf[j * 128] = (1.0f - fexp(x)) * fexp(run); run += x; } }
            else { for (int j = 0; j < 32; ++j) { const float x = lf[j * 128]; lf[j * 128] = (1.0f - fexp(x)) * fexp(run); run += x; } }
            tot[(dir * 2 + half) * 128 + dk] = run;
        }
        __syncthreads();
#pragma unroll
        for (int i = 0; i < 4; ++i) {
            const int id = tid + 512 * i, dir = id >> 10, j = (id >> 4) & 63, ch = id & 15, half = j >> 5;
            const LAS float* s = LF + (dir * 64 + j) * 128 + 8 * ch; f32x4 a = *(const LAS f32x4*)s, b = *(const LAS f32x4*)(s + 4);
            if (half == dir) {
                const LAS float* tp = tot + (dir * 2 + (1 - half)) * 128 + 8 * ch; const f32x4 t0 = *(const LAS f32x4*)tp, t1 = *(const LAS f32x4*)(tp + 4);
#pragma unroll
                for (int e = 0; e < 4; ++e) { a[e] *= fexp(t0[e]); b[e] *= fexp(t1[e]); }
            }
            *(LAS bf16x8*)(Kx + (dir * 64 + j) * 136 + 8 * ch) = pack8(a, b);
        }
        if (tid < 256) { const int dir = tid >> 7, dk = tid & 127; GC[((size_t)unit * 2 + dir) * 128 + dk] = fexp(tot[(dir * 2) * 128 + dk] + tot[(dir * 2 + 1) * 128 + dk]); }
        __syncthreads();
#pragma unroll
        for (int dir = 0; dir < 2; ++dir) {
            bf16x8 af[2];
#pragma unroll
            for (int ks = 0; ks < 2; ++ks) af[ks] = tr8(Kx + dir * 64 * 136, 136, 32 * ks, 16 * w, c16, g4);
            bf16_t* dst = SC + ((size_t)unit * 2 + dir) * 16384;
#pragma unroll
            for (int b = 0; b < 8; ++b) {
                f32x4 acc = {0.f, 0.f, 0.f, 0.f};
#pragma unroll
                for (int ks = 0; ks < 2; ++ks) acc = mfma16(af[ks], tr8(Vs, 136, 32 * ks, 16 * b, c16, g4), acc);
                *(u32x2*)(dst + (16 * b + c16) * 128 + 16 * w + 4 * g4) = pk4(acc);
            }
        }
    }
};
struct COutUnit {
    const bf16_t* Z; const bf16_t* SC; bf16_t* MIX; const float* gain; int w0;
    struct Regs { CRegs c; u32x4 qv[4], sf[4], sb[4]; u32x2 gw[4]; f32x4 gn; };
    DEVFN void load1(Regs& R, int unit) const {
        const int tid = opaque_tid(w0), lane = tid & 63, w = tid >> 6, c16 = lane & 15, g4 = lane >> 4; const int h = unit & 3, row0 = (unit >> 2) * 64; R.c = c_load_common(Z, row0, h, tid);
        const size_t row = (size_t)(row0 + 16 * (w & 3) + c16);
#pragma unroll
        for (int ks = 0; ks < 4; ++ks) R.qv[ks] = *(const u32x4*)(Z + zoff(OFF_QC, 128, h, (int)row, 32 * ks + 8 * g4));
    }
    DEVFN void load2(Regs& R, int unit) const {
        const int tid = opaque_tid(w0), lane = tid & 63, w = tid >> 6, c16 = lane & 15, g4 = lane >> 4; const int h = unit & 3, row0 = (unit >> 2) * 64;
        const size_t row = (size_t)(row0 + 16 * (w & 3) + c16);
        const bf16_t* gSf = SC + ((size_t)unit * 2 + 0) * 16384; const bf16_t* gSb = SC + ((size_t)unit * 2 + 1) * 16384;
#pragma unroll
        for (int i = 0; i < 4; ++i) { const int id = tid + 512 * i; R.sf[i] = *(const u32x4*)(gSf + id * 8); R.sb[i] = *(const u32x4*)(gSb + id * 8); }
#pragma unroll
        for (int dd = 0; dd < 4; ++dd) R.gw[dd] = *(const u32x2*)(Z + zoff(OFF_GC, 128, h, (int)row, 16 * (4 * (w >> 2) + dd) + 4 * g4));
        R.gn = (f32x4){gain[h * 128 + (tid & 127)], 0.f, 0.f, 0.f};
    }
    DEVFN void stage(LAS unsigned char* lds, const Regs& R) const { const int tid = opaque_tid(w0); c_stage_common((LAS float*)lds, (LAS bf16_t*)(lds + 65536 + 2 * 64 * 136 * 2), R.c, tid);
        }
    DEVFN void compute(LAS unsigned char* lds, const Regs& R, int unit, Regs& N, int next) const {
        const int tid = opaque_tid(w0), lane = tid & 63, w = tid >> 6, c16 = lane & 15, g4 = lane >> 4;
        const int h = unit & 3, row0 = (unit >> 2) * 64;
        const LAS float* gtab = (const LAS float*)(lds + 65536 + 3 * 64 * 136 * 2 + 2048);
        LAS float* LF = (LAS float*)lds;
        LAS bf16_t* Kx = (LAS bf16_t*)(lds + 65536);
        LAS bf16_t* Vs = (LAS bf16_t*)(lds + 65536 + 2 * 64 * 136 * 2);
        LAS float* bref = (LAS float*)(lds + 65536 + 3 * 64 * 136 * 2);
        LAS float* ssq = bref + 256;
        {
            const int dir = tid >> 8, half = (tid >> 7) & 1, dk = tid & 127;
            LAS float* lf = LF + dir * 64 * 128 + dk; LAS bf16_t* kx = Kx + dir * 64 * 136 + dk;
            float run = 0.f;
            if (dir == 0) {
                if (half == 1) { for (int i = 32; i < 64; ++i) { const float x = lf[i * 128]; run += x; lf[i * 128] = run; kx[i * 136] = (bf16_t)f2bf((1.0f - fexp(x)) * fexp(-run)); } }
                else { for (int i = 31; i >= 0; --i) { const float x = lf[i * 128]; lf[i * 128] = run; kx[i * 136] = (bf16_t)f2bf((1.0f - fexp(x)) * fexp(-run)); run -= x; } bref[dk] = -run; }
            } else {
                if (half == 0) { for (int i = 31; i >= 0; --i) { const float x = lf[i * 128]; run += x; lf[i * 128] = run; kx[i * 136] = (bf16_t)f2bf((1.0f - fexp(x)) * fexp(-run)); } }
                else { for (int i = 32; i < 64; ++i) { const float x = lf[i * 128]; lf[i * 128] = run; kx[i * 136] = (bf16_t)f2bf((1.0f - fexp(x)) * fexp(-run)); run -= x; } bref[128 + dk] = -run; }
            }
        }
        const int it = w & 3, dvh = w >> 2, i = 16 * it + c16; const size_t row = (size_t)(row0 + i);
        __syncthreads();
        bf16x8 Qpf[4], Qpb[4];
#pragma unroll
        for (int ks = 0; ks < 4; ++ks) {
            const int dk0 = 32 * ks + 8 * g4; const u32x4 qv = R.qv[ks];
            f32x4 q0, q1; q0[0] = bflo(qv.x); q0[1] = bfhi(qv.x); q0[2] = bflo(qv.y); q0[3] = bfhi(qv.y); q1[0] = bflo(qv.z); q1[1] = bfhi(qv.z); q1[2] = bflo(qv.w); q1[3] = bfhi(qv.w);
            const f32x4 df0 = *(const LAS f32x4*)(LF + i * 128 + dk0), df1 = *(const LAS f32x4*)(LF + i * 128 + dk0 + 4);
            const f32x4 db0 = *(const LAS f32x4*)(LF + (64 + i) * 128 + dk0), db1 = *(const LAS f32x4*)(LF + (64 + i) * 128 + dk0 + 4);
            f32x4 a0, a1, e0, e1;
#pragma unroll
            for (int j = 0; j < 4; ++j) { a0[j] = q0[j] * fexp(df0[j]); a1[j] = q1[j] * fexp(df1[j]); e0[j] = q0[j] * fexp(db0[j]); e1[j] = q1[j] * fexp(db1[j]); }
            Qpf[ks] = pack8(a0, a1); Qpb[ks] = pack8(e0, e1);
            EPI_FENCE();
        }
        f32x4 P[4];
#pragma unroll
        for (int jt = 0; jt < 4; ++jt) {
            f32x4 af = {0.f, 0.f, 0.f, 0.f}, ab = {0.f, 0.f, 0.f, 0.f};
#pragma unroll
            for (int ks = 0; ks < 4; ++ks) {
                af = mfma16(*(const LAS bf16x8*)(Kx + (16 * jt + c16) * 136 + 32 * ks + 8 * g4), Qpf[ks], af);
                ab = mfma16(*(const LAS bf16x8*)(Kx + (64 + 16 * jt + c16) * 136 + 32 * ks + 8 * g4), Qpb[ks], ab);
            }
#pragma unroll
            for (int rr = 0; rr < 4; ++rr) { const int j = 16 * jt + 4 * g4 + rr; P[jt][rr] = (j <= i ? af[rr] : 0.f) + (j >= i ? ab[rr] : 0.f); }
        }
        bf16x8 bp[2];
#pragma unroll
        for (int k2 = 0; k2 < 2; ++k2) bp[k2] = pack8(P[2 * k2], P[2 * k2 + 1]);
        LAS bf16_t* Sl = (LAS bf16_t*)lds;
        __syncthreads();
#pragma unroll
        for (int q = 0; q < 4; ++q) { const int id = tid + 512 * q, r = id >> 4, ch = id & 15; const int o = r * 128 + ((ch ^ (r & 15)) * 8);
            *(LAS u32x4*)(Sl + o) = R.sf[q]; *(LAS u32x4*)(Sl + 16384 + o) = R.sb[q]; }
        if (tid < 128) ((LAS float*)(lds + 65536 + 3 * 64 * 136 * 2 + 2048))[tid] = R.gn[0];
        const u32x2 gw0 = R.gw[0], gw1 = R.gw[1], gw2 = R.gw[2], gw3 = R.gw[3];
        load2(N, next);
        __syncthreads();
        bf16x8 Qqf[4], Qqb[4];
#pragma unroll
        for (int ks = 0; ks < 4; ++ks) {
            const int dk0 = 32 * ks + 8 * g4;
            const f32x4 rf0 = *(const LAS f32x4*)(bref + dk0), rf1 = *(const LAS f32x4*)(bref + dk0 + 4), rb0 = *(const LAS f32x4*)(bref + 128 + dk0), rb1 = *(const LAS f32x4*)(bref + 128 + dk0 + 4);
            const u32x4 pf = __builtin_bit_cast(u32x4, Qpf[ks]), pb = __builtin_bit_cast(u32x4, Qpb[ks]);
            f32x4 c0, c1, f0, f1;
            c0[0] = bflo(pf.x) * fexp(rf0[0]); c0[1] = bfhi(pf.x) * fexp(rf0[1]); c0[2] = bflo(pf.y) * fexp(rf0[2]); c0[3] = bfhi(pf.y) * fexp(rf0[3]);
            c1[0] = bflo(pf.z) * fexp(rf1[0]); c1[1] = bfhi(pf.z) * fexp(rf1[1]); c1[2] = bflo(pf.w) * fexp(rf1[2]); c1[3] = bfhi(pf.w) * fexp(rf1[3]);
            f0[0] = bflo(pb.x) * fexp(rb0[0]); f0[1] = bfhi(pb.x) * fexp(rb0[1]); f0[2] = bflo(pb.y) * fexp(rb0[2]); f0[3] = bfhi(pb.y) * fexp(rb0[3]);
            f1[0] = bflo(pb.z) * fexp(rb1[0]); f1[1] = bfhi(pb.z) * fexp(rb1[1]); f1[2] = bflo(pb.w) * fexp(rb1[2]); f1[3] = bfhi(pb.w) * fexp(rb1[3]);
            Qqf[ks] = pack8(c0, c1); Qqb[ks] = pack8(f0, f1);
        }
        f32x4 o[4]; float s2 = 0.f;
#pragma unroll
        for (int dd = 0; dd < 4; ++dd) {
            const int dvt = 4 * dvh + dd;
            f32x4 acc = {0.f, 0.f, 0.f, 0.f};
#pragma unroll
            for (int k2 = 0; k2 < 2; ++k2) acc = mfma16(tr8p(Vs, 136, 32 * k2, 16 * dvt, c16, g4), bp[k2], acc);
#pragma unroll
            for (int ks = 0; ks < 4; ++ks) {
                const int so = (16 * dvt + c16) * 128 + (((4 * ks + g4) ^ c16) * 8);
                acc = mfma16(*(const LAS bf16x8*)(Sl + so), Qqf[ks], acc);
                acc = mfma16(*(const LAS bf16x8*)(Sl + 16384 + so), Qqb[ks], acc);
            }
            o[dd] = acc; s2 += (acc[0] * acc[0] + acc[1] * acc[1]) + (acc[2] * acc[2] + acc[3] * acc[3]);
            EPI_FENCE();
        }
        s2 += __shfl_xor(s2, 16); s2 += __shfl_xor(s2, 32);
        if (g4 == 0) ssq[w * 16 + c16] = s2;
        __syncthreads();
        const float rinv = 1.0f / sqrtf((ssq[w * 16 + c16] + ssq[(w ^ 4) * 16 + c16]) * (1.0f / 128.0f) + EPS);
#pragma unroll
        for (int dd = 0; dd < 4; ++dd) {
            const int col = h * 128 + 16 * (4 * dvh + dd) + 4 * g4;
            const f32x4 gn = *(const LAS f32x4*)(gtab + 16 * (4 * dvh + dd) + 4 * g4); const u32x2 gw = dd == 0 ? gw0 : (dd == 1 ? gw1 : (dd == 2 ? gw2 : gw3));
            f32x4 v = o[dd] * rinv * gn; v[0] *= bflo(gw.x); v[1] *= bfhi(gw.x); v[2] *= bflo(gw.y); v[3] *= bfhi(gw.y);
            *(u32x2*)(MIX + row * MIXW + 768 + col) = pk4(v);
        }
    }
};

#ifndef CPU_EMU
#define KERNEL_LDS extern __shared__ __attribute__((aligned(16))) unsigned char lds_raw[]; LAS unsigned char* lds = (LAS unsigned char*)lds_raw;
#ifdef VGPR_LIMIT
__attribute__((amdgpu_num_vgpr(VGPR_LIMIT)))
#endif
__global__ void __launch_bounds__(512, 2) fwd_kernel(Args args)
#else
#define KERNEL_LDS unsigned char* lds = emu_lds();
void fwd_kernel(Args args)
#endif
{
    KERNEL_LDS
    const int G = gridDim.x, bx = blockIdx.x;
#ifndef CPU_EMU
    const int w0 = __builtin_amdgcn_readfirstlane((int)threadIdx.x >> 6);
#else
    const int w0 = 0;
#endif
#ifndef CPU_EMU
#define PH_IDS const int tid = opaque_tid(w0), lane = tid & 63, wave = __builtin_amdgcn_readfirstlane(tid >> 6), gw = bx * 8 + wave, gtid = bx * 512 + tid; int Gs_ = G; asm volatile("" : "+s"(Gs_)); const int ngw = Gs_ * 8, nthr = Gs_ * 512; (void)lane; (void)gw; (void)gtid; (void)ngw; (void)nthr;
#else
#define PH_IDS const int tid = opaque_tid(w0), lane = tid & 63, wave = tid >> 6, gw = bx * 8 + wave, gtid = bx * 512 + tid; const int ngw = G * 8, nthr = G * 512; (void)lane; (void)gw; (void)gtid; (void)ngw; (void)nthr;
#endif
#ifndef CPU_EMU
#define OPAQUE_S(p) asm volatile("" : "+s"(p))
#else
#define OPAQUE_S(p)
#endif
#define GAS_ __attribute__((address_space(1)))
#ifndef CPU_EMU
#define PH_PTRS GAS_ unsigned char* ws_g = (GAS_ unsigned char*)args.ws; OPAQUE_S(ws_g); unsigned char* ws = (unsigned char*)ws_g; GAS_ float* h_g = (GAS_ float*)args.out; OPAQUE_S(h_g); float* h = (float*)h_g; PH_PTRS2
#else
#define PH_PTRS unsigned char* ws = args.ws; float* h = args.out; PH_PTRS2
#endif
#define PH_PTRS2 \
    float* rope = (float*)(ws + WS_ROPE); float* biasT = (float*)(ws + WS_BIAS); float* lbs = (float*)(ws + WS_LBS); \
    bf16_t* WB = (bf16_t*)(ws + WS_WB); bf16_t* XN = (bf16_t*)(ws + WS_XN); unsigned char* R = ws + WS_R; bf16_t* ACT = (bf16_t*)(R + R_ACT); \
    bf16_t* Zs = (bf16_t*)(R + R_Z); bf16_t* AO = (bf16_t*)(R + R_AO); float* LSE = (float*)(R + R_LSE); bf16_t* MIX = (bf16_t*)(R + R_MIX); \
    bf16_t* MH = (bf16_t*)(R + R_MH); bf16_t* SB = (bf16_t*)(R + R_SB); bf16_t* SC = (bf16_t*)(R + R_SC); float* GC = (float*)(R + R_GC); \
    bf16_t* PB = (bf16_t*)(ws + WS_PB); bf16_t* SG = (bf16_t*)(R + R_SG); bf16_t* XN2 = (bf16_t*)(ws + WS_XN2); float* SSQ = (float*)(ws + WS_SSQ); \
    (void)h; (void)rope; (void)biasT; (void)lbs; (void)WB; (void)XN; (void)ACT; (void)Zs; (void)AO; (void)LSE; (void)MIX; (void)MH; (void)SB; (void)SC; (void)GC; (void)PB; (void)SG; (void)XN2; (void)SSQ;
    const int lo = args.lo, hi = args.hi;
#ifndef CPU_EMU
    LAS unsigned* misc = (LAS unsigned*)(lds + LDS_BYTES - 64);
    if (threadIdx.x < 4) misc[threadIdx.x] = 0u;
    __syncthreads();
    XcdBarrier bar = xcd_barrier_post((unsigned*)(args.ws + WS_CTL) + 1024, (volatile LAS unsigned*)misc);
#define GRID_BAR() xcd_barrier(bar, w0)
#else
#define GRID_BAR() emu_grid_barrier()
#endif
    int ph = 0;
#ifdef PROBE_PROF
    int cls_ = 0;
    if (bx == 0 && threadIdx.x == 0) { unsigned long long* P = (unsigned long long*)(args.ws + WS_CTL + 65536); P[0] = __builtin_amdgcn_s_memrealtime(); }
#define PH_CLS(k) cls_ = (k);
#define PROF_END() if (bx == 0 && w0 == 0 && lane_id_v() == 0) { unsigned long long* P = (unsigned long long*)(args.ws + WS_CTL + 65536); const unsigned long long now = __builtin_amdgcn_s_memrealtime(); P[2 + cls_] += now - P[0]; P[0] = now; }
#else
#define PH_CLS(k)
#define PROF_END()
#endif
#define PH_OPEN if (ph >= lo && ph < hi) { PH_IDS PH_PTRS
#define PH_CLOSE PROF_END() if (ph + 1 < hi) GRID_BAR(); } ++ph;

    PH_CLS(0)
    PH_OPEN
        prologue_tables(args, rope, biasT, lbs, gtid, nthr);
    PH_CLOSE

    for (int l = 0; l < DEPTH; ++l) {
        PH_CLS(0)
        PH_OPEN
            convert_weights(args, l, WB, lds, gw, ngw, wave, lane);
            cvt_ple(args, l, PB, gtid, nthr);
            if (l == 0) init_rows(args, XN2, SSQ, gw, ngw, lane);
        PH_CLOSE
        for (int half = 0; half < 2; ++half) {
            const int nA = 4 * l + 2 * half;
            for (int q = 0; q <= NFP; ++q) {
            PH_CLS(q == 0 ? 1 : (q == NFP ? 3 : 2))
            PH_OPEN
                for (int step = 0; step < 2; ++step) {
                    if ((step ^ (bx & 1)) == 0) {
                        if (q > 0) {
                            const size_t r0 = (size_t)(q - 1) * TP;
                            pg8::Gemm g{ACT + r0 * FF, WB + (half ? WE_D2 : WE_D1), TP, D, FF, FF, FF}; pg8::StaticOrder S; S.init(TP, D, G, bx);
                            pg8::EpiResAdd E{(half ? XN : XN2) + r0 * D, XN + r0 * D, SSQ + ((size_t)((nA + 1) % 3) * T + r0) * 4, D, 1, lds};
                            pg8::gemm_phase<pg8::EpiResAdd, pg8::StaticOrder>(w0, lds, g, S, E);
                        }
                    } else if (q < NFP) {
                        const size_t r0 = (size_t)q * TP;
                        pg8::Gemm g{(half ? XN : XN2) + r0 * D, WB + (half ? WE_GU2 : WE_GU1), TP, 2 * FF, D, D, D}; pg8::StaticOrder S; S.init(TP, 2 * FF, G, bx);
                        pg8::EpiSwiglu E{ACT + r0 * FF, FF, SSQ + ((size_t)(nA % 3) * T + r0) * 4, lds};
                        pg8::gemm_phase<pg8::EpiSwiglu, pg8::StaticOrder>(w0, lds, g, S, E);
                    }
                }
            PH_CLOSE
            }
            if (half == 0) {
                for (int s = 0; s <= NSLAB; ++s) {
                    const int srow0 = (s < NSLAB ? s : NSLAB - 1) * SLAB; const int S_len = srow0 < NP ? SEQ : DEC_SEQ; const int nseq = SLAB / S_len;
                    PH_CLS(s == 0 ? 4 : (s == NSLAB ? 6 : 5))
                    PH_OPEN
                        for (int step = 0; step < 2; ++step) {
                            if ((step ^ (bx & 1)) == 0) {
                                if (s > 0) {
                                    const int prow0 = (s - 1) * SLAB;
                                    pg8::Gemm g{MH, WB + WE_OUT, SLAB, D, D, D, D}; pg8::StaticOrder S; S.init(SLAB, D, G, bx);
                                    pg8::EpiResAdd E{XN + (size_t)prow0 * D, XN + (size_t)prow0 * D, SSQ + ((size_t)((nA + 2) % 3) * T + prow0) * 4, D, 0, lds};
                                    pg8::gemm_phase<pg8::EpiResAdd, pg8::StaticOrder>(w0, lds, g, S, E);
                                }
                            } else if (s < NSLAB) {
                                pg8::Gemm g{XN + (size_t)srow0 * D, WB + WE_IN, SLAB, ZW, D, D, D}; pg8::StaticOrder S; S.init(SLAB, ZW, G, bx);
                                pg8::EpiInProj E{Zs, rope, rope + 4096 * 64, lbs + l * 512, srow0, SSQ + ((size_t)((nA + 1) % 3) * T + srow0) * 4, lds};
                                pg8::gemm_phase<pg8::EpiInProj, pg8::StaticOrder>(w0, lds, g, S, E);
                            }
                        }
                    PH_CLOSE
                    if (s == NSLAB) break;
                    for (int mrep = 0; mrep < MIXREP; ++mrep) {
                    PH_CLS(7)
                    PH_OPEN
                        {
                            const int nuA = (SLAB / 128) * 12, perA = (nuA + G - 1) / G, a0 = bx * perA, a1 = (bx + 1) * perA < nuA ? (bx + 1) * perA : nuA;
                            const int nuB = (SLAB / 128) * 4, perB = (nuB + G - 1) / G, b0 = bx * perB, b1 = (bx + 1) * perB < nuB ? (bx + 1) * perB : nuB;
                            const int nuC = (SLAB / 64) * 4, perC = (nuC + G - 1) / G, c0 = bx * perC, c1 = (bx + 1) * perC < nuC ? (bx + 1) * perC : nuC;
                            const AUnit UA{Zs, AO, LSE, biasT, S_len, w0}; const BKvUnit UB{Zs, SB, w0}; const CKvUnit UC{Zs, SC, GC, w0};
                            BKvUnit::Regs LB; CKvUnit::Regs LC;
                            run_units_k(lds, UA, a0, a1, UA.load(a0 < nuA ? a0 : nuA - 1), [&] { LB = UB.load(b0 < nuB ? b0 : nuB - 1); });
                            run_units_k(lds, UB, b0, b1, LB, [&] { LC = UC.load(c0 < nuC ? c0 : nuC - 1); });
                            run_units_k(lds, UC, c0, c1, LC, [] {});
                        }
                    PH_CLOSE
                    PH_CLS(8)
                    PH_OPEN
                        mixer_scan(SB, SC, GC, nseq, S_len, gtid, nthr);
                    PH_CLOSE
                    PH_CLS(9)
                    PH_OPEN
                        {
                            const int nuB = (SLAB / 128) * 4, perB = (nuB + G - 1) / G, b0 = bx * perB, b1 = (bx + 1) * perB < nuB ? (bx + 1) * perB : nuB;
                            const int nuC = (SLAB / 64) * 4, perC = (nuC + G - 1) / G, c0 = bx * perC, c1 = (bx + 1) * perC < nuC ? (bx + 1) * perC : nuC;
                            const BOutUnit UB{Zs, SB, MIX, args.in[I_RETN] + l * 512, w0}; const COutUnit UC{Zs, SC, MIX, args.in[I_HGN] + l * 512, w0};
                            const BOutUnit::Regs LB = UB.load(b0 < nuB ? b0 : nuB - 1);
                            mixer_a_merge(AO, LSE, MIX, gtid, nthr);
                            COutUnit::Regs LC;
                            run_units_k(lds, UB, b0, b1, LB, [&] { UC.load1(LC, c0 < nuC ? c0 : nuC - 1); });
                            run_units2_k(lds, UC, c0, c1, LC);
                        }
                    PH_CLOSE
                    }
                    PH_CLS(10)
                    PH_OPEN
                        pg8::Gemm g{MIX, WB + WE_BR, SLAB, D, MIXW, MIXW, MIXW}; pg8::StaticOrder S; S.init(SLAB, D, G, bx);
                        pg8::EpiMerge E{MH, Zs + (size_t)SLAB * OFF_MG, D};
                        pg8::gemm_phase<pg8::EpiMerge, pg8::StaticOrder>(w0, lds, g, S, E);
                    PH_CLOSE
                }
            } else {
                PH_CLS(11)
                PH_OPEN
                    { pg8::Gemm g{XN, WB + WE_PG, T, D, D, D, D}; pg8::StaticOrder S; S.init(T, D, G, bx);
                      pg8::EpiGateBf16 E{SG, D, SSQ + (size_t)((nA + 1) % 3) * T * 4, lds};
                      pg8::gemm_phase<pg8::EpiGateBf16, pg8::StaticOrder>(w0, lds, g, S, E); }
                    { pg8::Gemm g{PB, WB + WE_PP, T, D, D_PLE, D_PLE, D_PLE}; pg8::StaticOrder S; S.init(T, D, G, bx);
                      pg8::EpiPle E{XN, SG, D, XN2, SSQ + (size_t)((nA + 2) % 3) * T * 4, lds};
                      pg8::gemm_phase<pg8::EpiPle, pg8::StaticOrder>(w0, lds, g, S, E); }
                PH_CLOSE
            }
        }
    }
    PH_CLS(12)
    PH_OPEN
#ifdef PROBE_PROF
        { const unsigned long long* P = (const unsigned long long*)(args.ws + WS_CTL + 65536); unsigned long long tot = 0; for (int k = 0; k < 12; ++k) tot += P[2 + k];
          final_norm_rows(XN2, h, args.in[I_FINN], gw, ngw, lane, 1.0f + (float)PROBE_K * (floorf((float)((double)P[2 + PROBE_PROF] / (double)tot) * (float)PROBE_Q + PROBE_OFS) * (1.0f / (float)PROBE_Q))); }
#else
        final_norm_rows(XN2, h, args.in[I_FINN], gw, ngw, lane, 1.0f);
#endif
    PH_CLOSE
#undef PH_OPEN
#undef PH_CLOSE
}

extern "C" void kernel_launch(void* const* d_in, const int* in_sizes, int n_in, void* d_out, int out_size, void* d_ws, size_t ws_size, hipStream_t stream) {
    static int grid = 0;
    if (grid == 0) {
        if (n_in != N_INPUTS || out_size != T * D || ws_size < WS_END) { fprintf(stderr, "kernel_launch: unexpected sizes (n_in %d, out %d, ws %zu, need %zu)\n", n_in, out_size, ws_size, (size_t)WS_END); grid = -1; return; }
        int dev = 0, cus = 0;
        if (hipGetDevice(&dev) != hipSuccess || hipDeviceGetAttribute(&cus, hipDeviceAttributeMultiprocessorCount, dev) != hipSuccess) { grid = -1; return; }
        if (hipFuncSetAttribute((const void*)fwd_kernel, hipFuncAttributeMaxDynamicSharedMemorySize, LDS_BYTES) != hipSuccess) { fprintf(stderr, "kernel_launch: hipFuncSetAttribute failed\n"); grid = -1; return; }
        int per_cu = 0;
        if (hipOccupancyMaxActiveBlocksPerMultiprocessor(&per_cu, (const void*)fwd_kernel, 512, LDS_BYTES) != hipSuccess || per_cu < 1) fprintf(stderr, "kernel_launch: occupancy query reports %d\n", per_cu);
        (void)hipGetLastError();
        grid = cus;
    }
    if (grid < 0) return;
    (void)in_sizes;
    hipMemsetAsync((char*)d_ws + WS_CTL, 0, CTL_BYTES, stream);
    Args a{};
    for (int i = 0; i < N_INPUTS; ++i) a.in[i] = (const float*)d_in[i];
    a.out = (float*)d_out; a.ws = (unsigned char*)d_ws;
#if ONE_LAUNCH
    a.lo = 0; a.hi = NPH;
    hipLaunchKernelGGL(fwd_kernel, dim3(grid), dim3(512), LDS_BYTES, stream, a);
#else
    for (int p = 0; p < NPH; ++p) { a.lo = p; a.hi = p + 1; hipLaunchKernelGGL(fwd_kernel, dim3(grid), dim3(512), LDS_BYTES, stream, a); }
#endif
}
```

```cpp
#ifndef CPU_EMU
#include <hip/hip_runtime.h>
#include <cstdio>
#include <cstdint>
#define LAS __attribute__((address_space(3)))
#define DEVFN __device__ __forceinline__
#define HDFN __host__ __device__ __forceinline__
#define EPI_FENCE() asm volatile("" ::: "memory")
#define OPAQUE_V(x) asm volatile("" : "+v"(x))
#define OPAQUE_V4(x) asm volatile("" : "+v"(x))
#define OPAQUE_SI(x) asm volatile("" : "+s"(x))
#else
#define OPAQUE_SI(x)
#define EPI_FENCE()
#define OPAQUE_V(x)
#define OPAQUE_V4(x)
#endif

#ifdef SMALL_CFG
constexpr int D = 256, FF = 256, BATCH = 2, SEQ = 2048, DEC_BATCH = 1, DEC_SEQ = 4096, DEPTH = 2, SLAB = 4096;
#else
constexpr int D = 1024, FF = 2816, BATCH = 32, SEQ = 2048, DEC_BATCH = 8, DEC_SEQ = 4096, DEPTH = 4, SLAB = 16384;
#endif
#ifndef ONE_LAUNCH
#define ONE_LAUNCH 1
#endif
constexpr int NP = BATCH * SEQ, NS = DEC_BATCH * DEC_SEQ, T = NP + NS, NSLAB = T / SLAB;
constexpr int D_PLE = 256, N_IN = 6912, ZW = N_IN + 3 * D, MIXW = 1280, AOW = 768;
constexpr int OFF_QA = 0, OFF_KA = 768, OFF_VA = 1536, OFF_QB = 2304, OFF_KB = 2816, OFF_VB = 3328, OFF_GB = 3840, OFF_QC = 4352, OFF_FCF = 4864, OFF_IC = 5888, OFF_GC = 6400, OFF_MG = 6912;
constexpr float EPS = 1e-6f;
static_assert(NP % SLAB == 0 && NS % SLAB == 0 && SLAB % SEQ == 0 && SLAB % DEC_SEQ == 0 && T % 256 == 0 && (2 * FF) % 256 == 0 && FF % 128 == 0 && D % 256 == 0, "shape");

constexpr size_t MiB = 1u << 20;
constexpr size_t al(size_t x) { return (x + 255) & ~(size_t)255; }
constexpr size_t WS_CTL = 0, CTL_BYTES = 1 * MiB;
constexpr size_t WS_ROPE = WS_CTL + CTL_BYTES;
constexpr size_t WS_BIAS = WS_ROPE + 2 * MiB;
constexpr size_t WS_LBS = WS_BIAS + 16384;
constexpr size_t WS_WB = WS_LBS + 16384;
constexpr size_t WE_GU1 = 0, WE_D1 = WE_GU1 + (size_t)2 * FF * D, WE_IN = WE_D1 + (size_t)D * FF, WE_BR = WE_IN + (size_t)ZW * D, WE_OUT = WE_BR + (size_t)D * MIXW,
                 WE_GU2 = WE_OUT + (size_t)D * D, WE_D2 = WE_GU2 + (size_t)2 * FF * D, WE_PG = WE_D2 + (size_t)D * FF, WE_PP = WE_PG + (size_t)D * D, WE_END = WE_PP + (size_t)D * D_PLE;
constexpr size_t WS_XN = al(WS_WB + WE_END * 2);
constexpr size_t WS_XN2 = al(WS_XN + (size_t)T * D * 2);
constexpr size_t WS_SSQ = al(WS_XN2 + (size_t)T * D * 2);
constexpr size_t WS_PB = al(WS_SSQ + (size_t)3 * T * 16);
constexpr size_t WS_R = al(WS_PB + (size_t)T * D_PLE * 2);
constexpr size_t R_ACT = 0, R_ACT_END = (size_t)T * FF * 2;
constexpr size_t R_Z = 0, R_AO = al(R_Z + (size_t)SLAB * ZW * 2), R_LSE = al(R_AO + (size_t)SLAB * AOW * 2), R_MIX = al(R_LSE + (size_t)SLAB * 12 * 4),
                 R_MH = al(R_MIX + (size_t)SLAB * MIXW * 2), R_SB = al(R_MH + (size_t)SLAB * D * 2),
                 R_SC = al(R_SB + (size_t)(SLAB / 128) * 4 * 2 * 16384 * 2), R_GC = al(R_SC + (size_t)(SLAB / 64) * 4 * 2 * 16384 * 2), R_MIX_END = al(R_GC + (size_t)(SLAB / 64) * 4 * 2 * 128 * 4);
constexpr size_t R_SG = 0, R_PLE_END = al(R_SG + (size_t)T * D * 2);
constexpr size_t cmax(size_t a, size_t b) { return a > b ? a : b; }
constexpr size_t WS_END = WS_R + cmax(cmax(R_ACT_END, R_MIX_END), R_PLE_END);
constexpr int LDS_BYTES = 147456;
#ifndef MIXREP
#define MIXREP 1
#endif
#ifndef REP_A
#define REP_A 1
#endif
#ifndef REP_KV
#define REP_KV 1
#endif
#ifndef REP_OUT
#define REP_OUT 1
#endif
constexpr int NFP = (T % 768 == 0) ? 3 : 2, TP = T / NFP;
static_assert(TP % 256 == 0, "FFN parts");
constexpr int NPH = 2 + DEPTH * (2 + 2 * (NFP + 1) + (NSLAB + 1) + NSLAB * (1 + 3 * MIXREP));

typedef unsigned short bf16_t;
typedef short bf16x8 __attribute__((ext_vector_type(8)));
typedef short s16x4 __attribute__((ext_vector_type(4)));
typedef float f32x4 __attribute__((ext_vector_type(4)));
typedef unsigned u32x4 __attribute__((ext_vector_type(4)));
typedef unsigned u32x2 __attribute__((ext_vector_type(2)));

#ifndef CPU_EMU
DEVFN int lane_id_v() { int l; asm volatile("v_mbcnt_lo_u32_b32 %0, -1, 0\n\tv_mbcnt_hi_u32_b32 %0, -1, %0" : "=v"(l)); return l; }
DEVFN int opaque_tid(int w0) { return w0 * 64 + lane_id_v(); }
#else
DEVFN int opaque_tid(int) { return threadIdx.x; }
#endif
DEVFN unsigned f2bf(float f) { unsigned u = __builtin_bit_cast(unsigned, f); return (u + 0x7fffu + ((u >> 16) & 1u)) >> 16; }
#ifndef CPU_EMU
typedef float f32x2_t __attribute__((ext_vector_type(2)));
typedef __bf16 bf16x2_t __attribute__((ext_vector_type(2)));
DEVFN unsigned pk2(float lo, float hi) { const f32x2_t v = {lo, hi}; return __builtin_bit_cast(unsigned, __builtin_convertvector(v, bf16x2_t)); }
#else
DEVFN unsigned pk2(float lo, float hi) { return f2bf(lo) | (f2bf(hi) << 16); }
#endif
DEVFN float bf2f(unsigned b) { return __builtin_bit_cast(float, b << 16); }
DEVFN float bflo(unsigned w) { return __builtin_bit_cast(float, w << 16); }
DEVFN float bfhi(unsigned w) { return __builtin_bit_cast(float, w & 0xffff0000u); }
DEVFN unsigned f2h(float f) { _Float16 h = (_Float16)f; return (unsigned)__builtin_bit_cast(unsigned short, h); }
DEVFN float h2f(unsigned b) { return (float)__builtin_bit_cast(_Float16, (unsigned short)b); }
DEVFN u32x2 pk4(f32x4 v) { u32x2 r; r.x = pk2(v[0], v[1]); r.y = pk2(v[2], v[3]); return r; }
#ifndef CPU_EMU
DEVFN f32x4 mfma16(bf16x8 a, bf16x8 b, f32x4 c) { return __builtin_amdgcn_mfma_f32_16x16x32_bf16(a, b, c, 0, 0, 0); }
DEVFN float fexp(float x) { return __expf(x); }
DEVFN float fexp2(float x) { return __builtin_amdgcn_exp2f(x); }
DEVFN float flog2(float x) { return __builtin_amdgcn_logf(x); }
DEVFN float flog(float x) { return __logf(x); }
DEVFN float frcp(float x) { return __builtin_amdgcn_rcpf(x); }
#else
f32x4 mfma16(bf16x8 a, bf16x8 b, f32x4 c);
DEVFN float fexp(float x) { return expf(x); }
DEVFN float fexp2(float x) { return exp2f(x); }
DEVFN float flog2(float x) { return log2f(x); }
DEVFN float flog(float x) { return logf(x); }
DEVFN float frcp(float x) { return 1.0f / x; }
#endif
#ifndef CPU_EMU
DEVFN float rms_rinv(float ssq) { return __builtin_amdgcn_rsqf(ssq * (1.0f / D) + EPS); }
#else
DEVFN float rms_rinv(float ssq) { return 1.0f / sqrtf(ssq * (1.0f / D) + EPS); }
#endif
DEVFN float row_rinv(const float* ssqp, unsigned row) { const f32x4 q = *(const f32x4*)(ssqp + 4 * row); float t = q[0]; if (D >= 512) t += q[1]; if (D >= 768) t += q[2]; if (D >= 1024) t += q[3]; return rms_rinv(t); }
#ifndef CPU_EMU
#define EPI_BARRIER() do { asm volatile("s_waitcnt lgkmcnt(0)" ::: "memory"); __builtin_amdgcn_s_barrier(); asm volatile("" ::: "memory"); } while (0)
#else
#define EPI_BARRIER() __syncthreads()
#endif
constexpr int EPI_RED_OFF = 131072;
constexpr int EPI_RINV_OFF = EPI_RED_OFF + 4096;
DEVFN void rinv_pre(const float* ssqp, LAS unsigned char* lds, int pm, int par, int tid) {
#ifndef CPU_EMU
    asm volatile("" : "+v"(tid));
    const int wv = __builtin_amdgcn_readfirstlane(tid >> 6);
    if (wv < 4) __builtin_amdgcn_global_load_lds((const unsigned*)(ssqp + 4 * (unsigned)(pm * 256 + tid)), (LAS unsigned*)(lds + EPI_RINV_OFF + par * 4096 + wv * 1024), 16, 0, 0);
#else
    if (tid < 256) *(f32x4*)(lds + EPI_RINV_OFF + par * 4096 + tid * 16) = *(const f32x4*)(ssqp + 4 * (unsigned)(pm * 256 + tid));
#endif
}
DEVFN float rinv_get(const LAS unsigned char* lds, int par, int r) { const f32x4 q = *(const LAS f32x4*)(lds + EPI_RINV_OFF + par * 4096 + r * 16); float t = q[0]; if (D >= 512) t += q[1]; if (D >= 768) t += q[2]; if (D >= 1024) t += q[3]; return rms_rinv(t); }
#ifndef CPU_EMU
DEVFN f32x4 swiglu4(f32x4 g, f32x4 u, float ri2, float nl) {
    const f32x4 t = g * nl; f32x4 e; e[0] = __builtin_amdgcn_exp2f(t[0]); e[1] = __builtin_amdgcn_exp2f(t[1]); e[2] = __builtin_amdgcn_exp2f(t[2]); e[3] = __builtin_amdgcn_exp2f(t[3]);
    const f32x4 d = e + 1.0f; f32x4 r; r[0] = __builtin_amdgcn_rcpf(d[0]); r[1] = __builtin_amdgcn_rcpf(d[1]); r[2] = __builtin_amdgcn_rcpf(d[2]); r[3] = __builtin_amdgcn_rcpf(d[3]);
    return (g * u) * (r * ri2);
}
#else
DEVFN f32x4 swiglu4(f32x4 g, f32x4 u, float ri2, float nl) { f32x4 o; for (int j = 0; j < 4; ++j) o[j] = (g[j] * u[j]) * ri2 / (1.0f + exp2f(g[j] * nl)); return o; }
#endif
DEVFN float fsigmoid(float x) { return frcp(1.0f + fexp(-x)); }
DEVFN float fsilu(float x) { return x * fsigmoid(x); }
DEVFN bf16x8 cat8(s16x4 lo, s16x4 hi) { return __builtin_shufflevector(lo, hi, 0, 1, 2, 3, 4, 5, 6, 7); }
DEVFN bf16x8 pack8(f32x4 a, f32x4 b) { u32x4 w; w.x = pk2(a[0], a[1]); w.y = pk2(a[2], a[3]); w.z = pk2(b[0], b[1]); w.w = pk2(b[2], b[3]); return __builtin_bit_cast(bf16x8, w); }
DEVFN unsigned zoff(int sec, int hd, int head, int row, int d) { return (unsigned)SLAB * (unsigned)sec + ((unsigned)head * (unsigned)SLAB + (unsigned)row) * (unsigned)hd + (unsigned)d; }
DEVFN int pos_of(int row) { return row < NP ? (row & (SEQ - 1)) : ((row - NP) & (DEC_SEQ - 1)); }
DEVFN float ret_l2(int dir, int h) {
    return dir ? (h == 0 ? -0.03223685441264423f : h == 1 ? -0.01602838797991282f : h == 2 ? -0.007991934616642016f : -0.003990433313311714f)
               : (h == 0 ? -0.04580368961312479f : h == 1 ? -0.02272007650008353f : h == 2 ? -0.011315313227834146f : -0.005646563141142063f);
}

namespace pg8 {
constexpr int BM = 256, BK = 64, HALF = 128, HTB = HALF * BK * 2, STAGE_BYTES = 8 * HTB, NXCD = 8, WGM = 8;
HDFN int lds_byte(int r, int c) { const int st = (r >> 4) * 2 + (c >> 5), rr = r & 15, cc = c & 31, ob = rr * 64 + cc * 2; return st * 1024 + (ob ^ (((ob >> 9) & 1) << 5)); }
HDFN void stage_rc(int b, int& R, int& C) { const int st = b / 1024, sb = b % 1024, swz = sb ^ (((sb >> 9) & 1) << 5); R = (st >> 1) * 16 + swz / 64; C = (st & 1) * 32 + (swz % 64) / 2; }
HDFN int perm32(int rho) { const int n = rho >> 4, i = rho & 15; return 8 * (i >> 2) + 4 * n + (i & 3); }
struct Unit { int pm, pn; };
struct Gemm { const bf16_t* A; const bf16_t* Bt; int M, N, K, lda, ldb; };
struct StaticOrder {
    int nM, nN, nwg, G, c;
    HDFN void init(int M, int N, int G_, int c_) { nM = M / BM; nN = N / BM; nwg = nM * nN; G = G_; c = c_; }
    HDFN bool next(int i, Unit& u) const {
        const long L = (long)i * G + c; if (L >= nwg) return false;
        int wgid = (int)L; { const int q = nwg / NXCD, r = nwg % NXCD, xcd = wgid % NXCD, off = wgid / NXCD; wgid = (xcd < r ? xcd * (q + 1) : r * (q + 1) + (xcd - r) * q) + off; }
        const int nig = WGM * nN, gid = wgid / nig, fm = gid * WGM, gsz = (nM - fm) < WGM ? (nM - fm) : WGM;
        u.pm = fm + ((wgid % nig) % gsz); u.pn = (wgid % nig) / gsz; return true;
    }
    DEVFN void a_ready(const Unit&) const {}
    DEVFN void done(const Unit&) const {}
};

struct EpiSwiglu {
    static constexpr bool PERM = true, MIDK = false;
    bf16_t* O; int ldc; const float* ssq; LAS unsigned char* lds;
    DEVFN void pre(const Unit& u, int par, int tid) const { rinv_pre(ssq, lds, u.pm, par, tid); }
    DEVFN void operator()(const f32x4 (&acc)[2][2][4][2], const Unit& u, int wr, int wc, int fr, int fq, int par) const {
        const int row0 = u.pm * BM + wr * 64 + fr, col0 = u.pn * HALF + wc * 32 + 8 * fq;
#pragma unroll
        for (int ai = 0; ai < 2; ++ai)
#pragma unroll
            for (int m = 0; m < 4; ++m) {
                bf16_t* rowp = O + (size_t)(row0 + ai * HALF + m * 16) * ldc + col0;
                const float ri = rinv_get(lds, par, ai * HALF + wr * 64 + m * 16 + fr);
                const float ri2 = ri * ri, nl = ri * -1.4426950408889634f;
                f32x4 a = swiglu4(acc[ai][0][m][0], acc[ai][1][m][0], ri2, nl), b = swiglu4(acc[ai][0][m][1], acc[ai][1][m][1], ri2, nl);
                u32x4 w; w.x = pk2(a[0], a[1]); w.y = pk2(a[2], a[3]); w.z = pk2(b[0], b[1]); w.w = pk2(b[2], b[3]);
                *(u32x4*)rowp = w; EPI_FENCE();
            }
    }
};
struct EpiResAdd {
    static constexpr bool PERM = false, MIDK = false;
    const bf16_t* Hs; bf16_t* Hd; float* ssq; int ldc; int halve; LAS unsigned char* lds;
    DEVFN void pre(const Unit&, int, int) const {}
    DEVFN void operator()(const f32x4 (&acc)[2][2][4][2], const Unit& u, int wr, int wc, int fr, int fq, int) const {
        const int row0 = u.pm * BM + wr * 64 + fr, col0 = u.pn * BM + wc * 32 + 4 * fq;
        int frq = fr; OPAQUE_V(frq);
        const float scale = halve ? 0.5f : 1.0f; const f32x4 sc4 = {scale, scale, scale, scale};
        u32x2 res[2][4][2][2];
#pragma unroll
        for (int ai = 0; ai < 2; ++ai) {
            u32x2 hv[4][2][2];
#pragma unroll
            for (int m = 0; m < 4; ++m) { const unsigned off = (unsigned)(row0 + ai * HALF + m * 16) * (unsigned)ldc + (unsigned)col0;
#pragma unroll
                for (int bj = 0; bj < 2; ++bj)
#pragma unroll
                    for (int n = 0; n < 2; ++n) hv[m][bj][n] = *(const u32x2*)(Hs + (off + bj * HALF + n * 16)); }
            EPI_FENCE();
#pragma unroll
            for (int m = 0; m < 4; ++m) { float part = 0.f;
#pragma unroll
                for (int bj = 0; bj < 2; ++bj)
#pragma unroll
                    for (int n = 0; n < 2; ++n) { const u32x2 hw = hv[m][bj][n]; f32x4 v = acc[ai][bj][m][n] * sc4; v[0] += bflo(hw.x); v[1] += bfhi(hw.x); v[2] += bflo(hw.y); v[3] += bfhi(hw.y);
                        const u32x2 o = pk4(v); res[ai][m][bj][n] = o;
                        const float r0 = bflo(o.x), r1 = bfhi(o.x), r2 = bflo(o.y), r3 = bfhi(o.y); part += (r0 * r0 + r1 * r1) + (r2 * r2 + r3 * r3); }
                part += __shfl_xor(part, 16); part += __shfl_xor(part, 32);
                if (fq == 0) ((LAS float*)(lds + EPI_RED_OFF))[(ai * HALF + wr * 64 + m * 16 + frq) * 4 + wc] = part; }
            EPI_FENCE();
        }
#pragma unroll
        for (int ai = 0; ai < 2; ++ai)
#pragma unroll
            for (int m = 0; m < 4; ++m) { const unsigned off = (unsigned)(row0 + ai * HALF + m * 16) * (unsigned)ldc + (unsigned)col0;
#pragma unroll
                for (int bj = 0; bj < 2; ++bj)
#pragma unroll
                    for (int n = 0; n < 2; ++n) *(u32x2*)(Hd + (off + bj * HALF + n * 16)) = res[ai][m][bj][n]; }
        EPI_BARRIER();
        { int t = wr * 256 + wc * 64 + fq * 16 + fr; OPAQUE_V(t); if (t < 256) { const f32x4 q = *(const LAS f32x4*)(lds + EPI_RED_OFF + t * 16); ssq[(size_t)(u.pm * BM + t) * 4 + u.pn] = (q[0] + q[1]) + (q[2] + q[3]); } }
    }
};
struct EpiGateBf16 {
    static constexpr bool PERM = false, MIDK = false;
    bf16_t* SG; int ldc; const float* ssq; LAS unsigned char* lds;
    DEVFN void pre(const Unit& u, int par, int tid) const { rinv_pre(ssq, lds, u.pm, par, tid); }
    DEVFN void operator()(const f32x4 (&acc)[2][2][4][2], const Unit& u, int wr, int wc, int fr, int fq, int par) const {
        const int row0 = u.pm * BM + wr * 64 + fr, col0 = u.pn * BM + wc * 32 + 4 * fq;
#pragma unroll
        for (int ai = 0; ai < 2; ++ai)
#pragma unroll
            for (int m = 0; m < 4; ++m) { const unsigned off = (unsigned)(row0 + ai * HALF + m * 16) * (unsigned)ldc + (unsigned)col0; const float ri = rinv_get(lds, par, ai * HALF + wr * 64 + m * 16 + fr);
#pragma unroll
                for (int bj = 0; bj < 2; ++bj)
#pragma unroll
                    for (int n = 0; n < 2; ++n) { f32x4 v = acc[ai][bj][m][n];
#pragma unroll
                        for (int j = 0; j < 4; ++j) v[j] = fsigmoid(v[j] * ri);
                        *(u32x2*)(SG + (off + bj * HALF + n * 16)) = pk4(v); }
                EPI_FENCE(); }
    }
};
struct EpiPle {
    static constexpr bool PERM = false, MIDK = false;
    const bf16_t* Hs; const bf16_t* SG; int ldc; bf16_t* Hd; float* ssq_out; LAS unsigned char* lds;
    DEVFN void pre(const Unit&, int, int) const {}
    DEVFN void operator()(const f32x4 (&acc)[2][2][4][2], const Unit& u, int wr, int wc, int fr, int fq, int) const {
        const int row0 = u.pm * BM + wr * 64 + fr, col0 = u.pn * BM + wc * 32 + 4 * fq;
        int frq = fr; OPAQUE_V(frq);
        u32x2 res[2][4][2][2];
#pragma unroll
        for (int ai = 0; ai < 2; ++ai)
#pragma unroll
            for (int mp = 0; mp < 2; ++mp) {
                u32x2 hv[2][2][2], gv[2][2][2];
#pragma unroll
                for (int m2 = 0; m2 < 2; ++m2) { const unsigned ro = (unsigned)(row0 + ai * HALF + (2 * mp + m2) * 16) * (unsigned)ldc + (unsigned)col0;
#pragma unroll
                    for (int bj = 0; bj < 2; ++bj)
#pragma unroll
                        for (int n = 0; n < 2; ++n) { hv[m2][bj][n] = *(const u32x2*)(Hs + (ro + bj * HALF + n * 16)); gv[m2][bj][n] = *(const u32x2*)(SG + (ro + bj * HALF + n * 16)); } }
                EPI_FENCE();
#pragma unroll
                for (int m2 = 0; m2 < 2; ++m2) { const int m = 2 * mp + m2; float part = 0.f;
#pragma unroll
                    for (int bj = 0; bj < 2; ++bj)
#pragma unroll
                        for (int n = 0; n < 2; ++n) { const f32x4 a = acc[ai][bj][m][n]; const u32x2 gw = gv[m2][bj][n], hw = hv[m2][bj][n]; f32x4 v;
                            v[0] = bflo(hw.x) + bflo(gw.x) * a[0]; v[1] = bfhi(hw.x) + bfhi(gw.x) * a[1]; v[2] = bflo(hw.y) + bflo(gw.y) * a[2]; v[3] = bfhi(hw.y) + bfhi(gw.y) * a[3];
                            const u32x2 o = pk4(v); res[ai][m][bj][n] = o;
                            const float r0 = bflo(o.x), r1 = bfhi(o.x), r2 = bflo(o.y), r3 = bfhi(o.y); part += (r0 * r0 + r1 * r1) + (r2 * r2 + r3 * r3); }
                    part += __shfl_xor(part, 16); part += __shfl_xor(part, 32);
                    if (fq == 0) ((LAS float*)(lds + EPI_RED_OFF))[(ai * HALF + wr * 64 + m * 16 + frq) * 4 + wc] = part; }
                EPI_FENCE();
            }
#pragma unroll
        for (int ai = 0; ai < 2; ++ai)
#pragma unroll
            for (int m = 0; m < 4; ++m) { const unsigned ro = (unsigned)(row0 + ai * HALF + m * 16) * (unsigned)ldc + (unsigned)col0;
#pragma unroll
                for (int bj = 0; bj < 2; ++bj)
#pragma unroll
                    for (int n = 0; n < 2; ++n) *(u32x2*)(Hd + (ro + bj * HALF + n * 16)) = res[ai][m][bj][n]; }
        EPI_BARRIER();
        { int t = wr * 256 + wc * 64 + fq * 16 + fr; OPAQUE_V(t); if (t < 256) { const f32x4 q = *(const LAS f32x4*)(lds + EPI_RED_OFF + t * 16); ssq_out[(size_t)(u.pm * BM + t) * 4 + u.pn] = (q[0] + q[1]) + (q[2] + q[3]); } }
    }
};
struct EpiMerge {
    static constexpr bool PERM = true, MIDK = true;
    bf16_t* MH; const bf16_t* G; int ldg;
    DEVFN void pre(const Unit&, int, int) const {}
    DEVFN void gate8(unsigned off, f32x4& g0, f32x4& g1) const { unpack8(*(const u32x4*)(G + off), g0, g1); }
    DEVFN void unpack8(u32x4 w, f32x4& g0, f32x4& g1) const {
        g0[0] = fmaxf(bflo(w.x), 1e-30f); g0[1] = fmaxf(bfhi(w.x), 1e-30f); g0[2] = fmaxf(bflo(w.y), 1e-30f); g0[3] = fmaxf(bfhi(w.y), 1e-30f);
        g1[0] = fmaxf(bflo(w.z), 1e-30f); g1[1] = fmaxf(bfhi(w.z), 1e-30f); g1[2] = fmaxf(bflo(w.w), 1e-30f); g1[3] = fmaxf(bfhi(w.w), 1e-30f); }
    DEVFN void mid(f32x4 (&acc)[2][2][4][2], const Unit& u, int wr, int wc, int fr, int fq, int x) const {
        OPAQUE_V(fr); OPAQUE_V(fq);
        const int row0 = u.pm * BM + wr * 64 + fr; const unsigned col0 = (unsigned)(u.pn * BM + wc * 32 + 8 * fq) + (unsigned)x * (unsigned)(SLAB * D);
#pragma unroll
        for (int ai = 0; ai < 2; ++ai) {
            u32x4 gn[4][2], gd[4][2];
#pragma unroll
            for (int m = 0; m < 4; ++m) { const unsigned off = (unsigned)(row0 + ai * HALF + m * 16) * (unsigned)ldg + col0;
#pragma unroll
                for (int bj = 0; bj < 2; ++bj) { gn[m][bj] = *(const u32x4*)(G + (off + bj * HALF)); gd[m][bj] = *(const u32x4*)(G + (off + (unsigned)(SLAB * D) + bj * HALF)); } }
            EPI_FENCE();
#pragma unroll
            for (int m = 0; m < 4; ++m)
#pragma unroll
                for (int bj = 0; bj < 2; ++bj) { f32x4 n0, n1, d0, d1; unpack8(gn[m][bj], n0, n1); unpack8(gd[m][bj], d0, d1);
#pragma unroll
                    for (int j = 0; j < 4; ++j) { acc[ai][bj][m][0][j] *= n0[j] * frcp(d0[j]); acc[ai][bj][m][1][j] *= n1[j] * frcp(d1[j]); } }
            EPI_FENCE();
        }
    }
    DEVFN void operator()(const f32x4 (&acc)[2][2][4][2], const Unit& u, int wr, int wc, int fr, int fq, int) const {
        OPAQUE_V(fr); OPAQUE_V(fq);
        const int row0 = u.pm * BM + wr * 64 + fr, col0 = u.pn * BM + wc * 32 + 8 * fq;
        u32x4 res[2][4][2];
#pragma unroll
        for (int ai = 0; ai < 2; ++ai) {
            u32x4 gc[4][2];
#pragma unroll
            for (int m = 0; m < 4; ++m)
#pragma unroll
                for (int bj = 0; bj < 2; ++bj) gc[m][bj] = *(const u32x4*)(G + ((unsigned)(row0 + ai * HALF + m * 16) * (unsigned)ldg + 2u * (unsigned)(SLAB * D) + col0 + bj * HALF));
            EPI_FENCE();
#pragma unroll
            for (int m = 0; m < 4; ++m)
#pragma unroll
                for (int bj = 0; bj < 2; ++bj) { f32x4 g0, g1; unpack8(gc[m][bj], g0, g1);
                    const f32x4 v0 = acc[ai][bj][m][0] * g0, v1 = acc[ai][bj][m][1] * g1;
                    u32x4 w; w.x = pk2(v0[0], v0[1]); w.y = pk2(v0[2], v0[3]); w.z = pk2(v1[0], v1[1]); w.w = pk2(v1[2], v1[3]); res[ai][m][bj] = w; }
            EPI_FENCE();
        }
#pragma unroll
        for (int ai = 0; ai < 2; ++ai)
#pragma unroll
            for (int m = 0; m < 4; ++m) { const unsigned row = (unsigned)(row0 + ai * HALF + m * 16);
#pragma unroll
                for (int bj = 0; bj < 2; ++bj) *(u32x4*)(MH + row * (unsigned)D + col0 + bj * HALF) = res[ai][m][bj]; }
    }
};
struct EpiInProj {
    static constexpr bool PERM = true, MIDK = false;
    bf16_t* O; const float* cosT; const float* sinT; const float* lb; int row_base; const float* ssq; LAS unsigned char* lds;
    DEVFN void pre(const Unit& u, int par, int tid) const { rinv_pre(ssq, lds, u.pm, par, tid); }
    DEVFN unsigned zdst(int cb, int cw, int row) const {
        if (cb < OFF_QB) { const int sec = (cb / 768) * 768; return zoff(sec, 64, (cb - sec) / 64 + (cw >> 6), row, cw & 63); }
        if (cb < OFF_MG) { const int sec = OFF_QB + ((cb - OFF_QB) / 512) * 512; return zoff(sec, 128, (cb - sec) / 128, row, cw); }
        const int x = (cb - OFF_MG) / D, c = (cb - OFF_MG) % D; return (unsigned)SLAB * (unsigned)OFF_MG + (unsigned)x * (unsigned)(SLAB * D) + (unsigned)row * (unsigned)D + (unsigned)(c + cw);
    }
    DEVFN void store8(int cb, int cw, int row, f32x4 v0, f32x4 v1) const { u32x4 w; w.x = pk2(v0[0], v0[1]); w.y = pk2(v0[2], v0[3]); w.z = pk2(v1[0], v1[1]); w.w = pk2(v1[2], v1[3]); *(u32x4*)(O + zdst(cb, cw, row)) = w; }
    DEVFN void operator()(const f32x4 (&acc)[2][2][4][2], const Unit& u, int wr, int wc, int fr, int fq, int par) const {
        const int pn = u.pn;
        const int mode = pn < 9 ? 0 : pn < 13 ? 1 : pn < 15 ? 0 : pn < 19 ? 2 : pn < 23 ? 3 : pn < 25 ? 0 : pn < 27 ? 2 : 4;
        int cw = wc * 32 + 8 * fq; OPAQUE_V(cw);
        const int row0 = u.pm * BM + wr * 64 + fr, col0 = pn * BM + cw;
        if (mode == 1) {
#pragma unroll
            for (int ai = 0; ai < 2; ++ai) {
                f32x4 cq[4], sq[4];
#pragma unroll
                for (int m = 0; m < 4; ++m) { const int pos = pos_of(row_base + row0 + ai * HALF + m * 16); cq[m] = *(const f32x4*)(cosT + pos * 64 + 4 * (4 * wc + fq)); sq[m] = *(const f32x4*)(sinT + pos * 64 + 4 * (4 * wc + fq)); }
                EPI_FENCE();
#pragma unroll
                for (int m = 0; m < 4; ++m) { const int row = row0 + ai * HALF + m * 16; const float ri = rinv_get(lds, par, ai * HALF + wr * 64 + m * 16 + fr); const f32x4 c4 = cq[m], s4 = sq[m];
#pragma unroll
                    for (int bj = 0; bj < 2; ++bj) { const f32x4 v0 = acc[ai][bj][m][0] * ri, v1 = acc[ai][bj][m][1] * ri; store8(pn * BM + bj * HALF, cw, row, v0 * c4 - v1 * s4, v0 * s4 + v1 * c4); } }
                EPI_FENCE();
            }
        } else if (mode == 3) {
            f32x4 lbv[2][2];
#pragma unroll
            for (int bj = 0; bj < 2; ++bj) { const int lc = (col0 + bj * HALF - OFF_FCF) & 511; lbv[bj][0] = *(const f32x4*)(lb + lc); lbv[bj][1] = *(const f32x4*)(lb + lc + 4); }
            EPI_FENCE();
#pragma unroll
            for (int ai = 0; ai < 2; ++ai)
#pragma unroll
                for (int m = 0; m < 4; ++m) { const int row = row0 + ai * HALF + m * 16; const float ri = rinv_get(lds, par, ai * HALF + wr * 64 + m * 16 + fr);
#pragma unroll
                    for (int bj = 0; bj < 2; ++bj) { f32x4 v0 = acc[ai][bj][m][0] * ri, v1 = acc[ai][bj][m][1] * ri; const f32x4 l0 = lbv[bj][0], l1 = lbv[bj][1];
#pragma unroll
                        for (int j = 0; j < 4; ++j) { v0[j] = fmaxf(flog2(l0[j] + (1.f - l0[j]) * fsigmoid(v0[j])), -43.28f); v1[j] = fmaxf(flog2(l1[j] + (1.f - l1[j]) * fsigmoid(v1[j])), -43.28f); }
                        u32x4 w; w.x = f2h(v0[0]) | (f2h(v0[1]) << 16); w.y = f2h(v0[2]) | (f2h(v0[3]) << 16); w.z = f2h(v1[0]) | (f2h(v1[1]) << 16); w.w = f2h(v1[2]) | (f2h(v1[3]) << 16);
                        *(u32x4*)(O + zdst(pn * BM + bj * HALF, cw, row)) = w; } }
        } else {
#pragma unroll
            for (int ai = 0; ai < 2; ++ai)
#pragma unroll
                for (int m = 0; m < 4; ++m) { const int row = row0 + ai * HALF + m * 16; const float ri = rinv_get(lds, par, ai * HALF + wr * 64 + m * 16 + fr);
#pragma unroll
                    for (int bj = 0; bj < 2; ++bj) { f32x4 v0 = acc[ai][bj][m][0] * ri, v1 = acc[ai][bj][m][1] * ri;
                        if (mode == 2) {
#pragma unroll
                            for (int j = 0; j < 4; ++j) { v0[j] = fsilu(v0[j]); v1[j] = fsilu(v1[j]); } }
                        else if (mode == 4) {
#pragma unroll
                            for (int j = 0; j < 4; ++j) { v0[j] = fsigmoid(v0[j]); v1[j] = fsigmoid(v1[j]); } }
                        store8(pn * BM + bj * HALF, cw, row, v0, v1); } }
        }
    }
};

#ifndef CPU_EMU
#define PG8_LAS __attribute__((address_space(3)))
template <class Epi, class Sched, bool ALIGN_EPI = true, bool SP2 = true>
__device__ __forceinline__ void gemm_phase(int w0, PG8_LAS unsigned char* lds, const Gemm g, const Sched S, const Epi E) {
    const int tid = opaque_tid(w0), wid = __builtin_amdgcn_readfirstlane(tid >> 6), lane = tid & 63, wr = wid >> 2, wc = wid & 3, fr = lane & 15, fq = lane >> 4;
    const int K = g.K, nt = K / BK;
    unsigned voffA[2], voffB[2];
#pragma unroll
    for (int i = 0; i < 2; ++i) { int R, C; stage_rc(tid * 16 + i * 8192, R, C); const int Rb = Epi::PERM ? ((R & ~31) + perm32(R & 31)) : R;
        voffA[i] = (unsigned)(R * g.lda + C) * 2u; voffB[i] = (unsigned)(Rb * g.ldb + C) * 2u; }
    const size_t kstep = (size_t)(BK * 2);
    const size_t hstepA = (size_t)HALF * g.lda * 2, hstepB = (size_t)HALF * g.ldb * 2;
    const size_t tstepA = 2 * hstepA, tstepB = 2 * hstepB;
    const unsigned ldsw = (unsigned)wid * 1024u;
    const int aoff = lds_byte(wr * 64 + fr, fq * 8), boff = lds_byte(wc * 32 + fr, fq * 8);
#define PG8_SA(b, h) (((b) * 2 + (h)) * HTB)
#define PG8_SB(b, h) ((4 + (b) * 2 + (h)) * HTB)
#define PG8_STAGE(bufoff, gbase, voff) do { _Pragma("unroll") for (int _i = 0; _i < 2; ++_i) \
        __builtin_amdgcn_global_load_lds((const unsigned*)((const char*)(gbase) + (voff)[_i]), (PG8_LAS unsigned*)(lds + (bufoff) + ldsw + _i * 8192), 16, 0, 0); } while (0)
#define PG8_LDA(dst, b, h) do { _Pragma("unroll") for (int m = 0; m < 4; ++m) _Pragma("unroll") for (int k = 0; k < 2; ++k) dst[m][k] = *(const PG8_LAS bf16x8*)(lds + PG8_SA(b, h) + aoff + m * 2048 + k * 1024); } while (0)
#define PG8_LDB(dst, b, h) do { _Pragma("unroll") for (int n = 0; n < 2; ++n) _Pragma("unroll") for (int k = 0; k < 2; ++k) dst[n][k] = *(const PG8_LAS bf16x8*)(lds + PG8_SB(b, h) + boff + n * 2048 + k * 1024); } while (0)
#define PG8_MMA(ai, bj, At, Bt) do { __builtin_amdgcn_s_setprio(1); _Pragma("unroll") for (int m = 0; m < 4; ++m) _Pragma("unroll") for (int n = 0; n < 2; ++n) _Pragma("unroll") for (int k = 0; k < 2; ++k) \
        acc[ai][bj][m][n] = __builtin_amdgcn_mfma_f32_16x16x32_bf16(Bt[n][k], At[m][k], acc[ai][bj][m][n], 0, 0, 0); __builtin_amdgcn_s_setprio(0); } while (0)
#define PG8_WAIT_V(n) asm volatile("s_waitcnt vmcnt(" #n ")" ::: "memory")
#define PG8_WAIT_L(n) asm volatile("s_waitcnt lgkmcnt(" #n ")" ::: "memory")
#define PG8_BAR __builtin_amdgcn_s_barrier()
#define PG8_SCHED __builtin_amdgcn_sched_barrier(0)
    Unit cur, nxt; int ui = 0;
    if (!S.next(0, cur)) return;
    f32x4 acc[2][2][4][2];
#pragma unroll
    for (int a = 0; a < 2; ++a)
#pragma unroll
        for (int b = 0; b < 2; ++b)
#pragma unroll
            for (int m = 0; m < 4; ++m)
#pragma unroll
                for (int n = 0; n < 2; ++n) acc[a][b][m][n] = (f32x4){0.f, 0.f, 0.f, 0.f};
    bf16x8 At[4][2], B0[2][2], B1[2][2];
    const char* cA = (const char*)g.A + (size_t)cur.pm * tstepA; const char* cB = (const char*)g.Bt + (size_t)cur.pn * tstepB;
    S.a_ready(cur);
    E.pre(cur, 0, wid * 64 + lane_id_v());
    if constexpr (SP2) {
        PG8_STAGE(PG8_SB(0, 0), cB, voffB); PG8_STAGE(PG8_SB(0, 1), cB + hstepB, voffB); PG8_STAGE(PG8_SA(0, 0), cA, voffA); PG8_STAGE(PG8_SA(0, 1), cA + hstepA, voffA);
        if (wr == 1) PG8_BAR;
        PG8_WAIT_V(2); PG8_BAR;
        PG8_STAGE(PG8_SB(1, 0), cB + kstep, voffB); PG8_STAGE(PG8_SA(1, 0), cA + kstep, voffA); PG8_STAGE(PG8_SB(1, 1), cB + hstepB + kstep, voffB);
        PG8_WAIT_V(6); PG8_BAR;
    } else {
        PG8_STAGE(PG8_SB(0, 0), cB, voffB); PG8_STAGE(PG8_SA(0, 0), cA, voffA); PG8_STAGE(PG8_SB(0, 1), cB + hstepB, voffB); PG8_STAGE(PG8_SA(0, 1), cA + hstepA, voffA);
        if (wr == 1) PG8_BAR;
        PG8_WAIT_V(4); PG8_BAR;
        PG8_STAGE(PG8_SB(1, 0), cB + kstep, voffB); PG8_STAGE(PG8_SA(1, 0), cA + kstep, voffA); PG8_STAGE(PG8_SB(1, 1), cB + hstepB + kstep, voffB);
        PG8_WAIT_V(6); PG8_BAR;
    }
    for (;;) {
        const bool has_next = S.next(ui + 1, nxt);
        const char* nA = has_next ? (const char*)g.A + (size_t)nxt.pm * tstepA : cA; const char* nB = has_next ? (const char*)g.Bt + (size_t)nxt.pn * tstepB : cB;
        constexpr int NSEG = Epi::MIDK ? 3 : 1;
#pragma nounroll
        for (int seg = 0; seg < NSEG; ++seg) {
        const int tb = Epi::MIDK ? (seg == 0 ? 0 : (seg == 1 ? 4 : 12)) : 0, te = Epi::MIDK ? (seg == 0 ? 4 : (seg == 1 ? 12 : nt)) : nt;
#pragma nounroll
        for (int t = tb; t < te; t += 2) {
            const bool last = (t == nt - 2);
            const char* a1 = cA + (size_t)(t + 1) * kstep;
            const char* a2 = last ? nA : cA + (size_t)(t + 2) * kstep; const char* b2 = last ? nB : cB + (size_t)(t + 2) * kstep;
            const char* a3 = a2 + kstep; const char* b3 = b2 + kstep;
            if (last && has_next) S.a_ready(nxt);
            if constexpr (SP2) {
            PG8_LDB(B0, 0, 0); PG8_LDB(B1, 0, 1); PG8_SCHED; PG8_LDA(At, 0, 0); PG8_STAGE(PG8_SA(1, 1), a1 + hstepA, voffA);
            PG8_WAIT_V(8); PG8_WAIT_L(0); PG8_BAR; PG8_MMA(0, 0, At, B0); PG8_MMA(0, 1, At, B1); PG8_BAR; PG8_SCHED;
            PG8_LDA(At, 0, 1); PG8_STAGE(PG8_SB(0, 0), b2, voffB); PG8_STAGE(PG8_SB(0, 1), b2 + hstepB, voffB); PG8_STAGE(PG8_SA(0, 0), a2, voffA);
            PG8_WAIT_V(8); PG8_WAIT_L(0); PG8_BAR; PG8_MMA(1, 0, At, B0); PG8_MMA(1, 1, At, B1); PG8_BAR; PG8_SCHED;
            PG8_LDB(B0, 1, 0); PG8_LDB(B1, 1, 1); PG8_SCHED; PG8_LDA(At, 1, 0); PG8_STAGE(PG8_SA(0, 1), a2 + hstepA, voffA);
            PG8_WAIT_V(8); PG8_WAIT_L(0); PG8_BAR; PG8_MMA(0, 0, At, B0); PG8_MMA(0, 1, At, B1); PG8_BAR; PG8_SCHED;
            PG8_LDA(At, 1, 1); PG8_STAGE(PG8_SB(1, 0), b3, voffB); PG8_STAGE(PG8_SB(1, 1), b3 + hstepB, voffB); PG8_STAGE(PG8_SA(1, 0), a3, voffA);
            PG8_WAIT_V(8); PG8_WAIT_L(0); PG8_BAR; PG8_MMA(1, 0, At, B0); PG8_MMA(1, 1, At, B1); PG8_BAR; PG8_SCHED;
            } else {
            PG8_LDB(B0, 0, 0); PG8_SCHED; PG8_LDA(At, 0, 0); PG8_STAGE(PG8_SA(1, 1), a1 + hstepA, voffA);
            PG8_WAIT_L(8); PG8_BAR; PG8_WAIT_L(0); PG8_MMA(0, 0, At, B0); PG8_BAR; PG8_SCHED;
            PG8_LDB(B1, 0, 1); PG8_STAGE(PG8_SB(0, 0), b2, voffB);
            PG8_BAR; PG8_WAIT_L(0); PG8_MMA(0, 1, At, B1); PG8_BAR;
            PG8_LDA(At, 0, 1); PG8_STAGE(PG8_SA(0, 0), a2, voffA);
            PG8_BAR; PG8_WAIT_L(0); PG8_MMA(1, 0, At, B0); PG8_BAR; PG8_SCHED;
            PG8_STAGE(PG8_SB(0, 1), b2 + hstepB, voffB);
            PG8_WAIT_V(6); PG8_BAR; PG8_MMA(1, 1, At, B1); PG8_BAR;
            PG8_LDB(B0, 1, 0); PG8_SCHED; PG8_LDA(At, 1, 0); PG8_STAGE(PG8_SA(0, 1), a2 + hstepA, voffA);
            PG8_WAIT_L(8); PG8_BAR; PG8_WAIT_L(0); PG8_MMA(0, 0, At, B0); PG8_BAR; PG8_SCHED;
            PG8_LDB(B1, 1, 1); PG8_STAGE(PG8_SB(1, 0), b3, voffB);
            PG8_BAR; PG8_WAIT_L(0); PG8_MMA(0, 1, At, B1); PG8_BAR;
            PG8_LDA(At, 1, 1); PG8_STAGE(PG8_SA(1, 0), a3, voffA);
            PG8_BAR; PG8_WAIT_L(0); PG8_MMA(1, 0, At, B0); PG8_BAR; PG8_SCHED;
            PG8_STAGE(PG8_SB(1, 1), b3 + hstepB, voffB);
            PG8_WAIT_V(6); PG8_BAR; PG8_MMA(1, 1, At, B1); PG8_BAR;
            }
        }
        if constexpr (Epi::MIDK) { if (seg < 2) E.mid(acc, cur, wr, wc, fr, fq, seg); }
        }
        if constexpr (ALIGN_EPI) { if (wr == 0) PG8_BAR; }
        E(acc, cur, wr, wc, fr, fq, ui & 1); S.done(cur);
        if (!has_next) break;
        E.pre(nxt, (ui + 1) & 1, wid * 64 + lane_id_v());
#pragma unroll
        for (int a = 0; a < 2; ++a)
#pragma unroll
            for (int b = 0; b < 2; ++b)
#pragma unroll
                for (int m = 0; m < 4; ++m)
#pragma unroll
                    for (int n = 0; n < 2; ++n) acc[a][b][m][n] = (f32x4){0.f, 0.f, 0.f, 0.f};
        cur = nxt; cA = nA; cB = nB; ++ui;
        if constexpr (ALIGN_EPI) { if (wr == 1) PG8_BAR; }
    }
    PG8_WAIT_V(0);
    if constexpr (!ALIGN_EPI) { if (wr == 0) PG8_BAR; }
    PG8_BAR;
#undef PG8_SA
#undef PG8_SB
#undef PG8_STAGE
#undef PG8_LDA
#undef PG8_LDB
#undef PG8_MMA
#undef PG8_WAIT_V
#undef PG8_WAIT_L
#undef PG8_BAR
#undef PG8_SCHED
}
#else
template <class Epi, class Sched, bool ALIGN_EPI = true, bool SP2 = true>
void gemm_phase(int w0, unsigned char* lds, const Gemm g, const Sched& S, const Epi& E) {
    (void)lds; const int tid = opaque_tid(w0), wid = tid >> 6, lane = tid & 63, wr = wid >> 2, wc = wid & 3, fr = lane & 15, fq = lane >> 4;
    Unit cur;
    for (int ui = 0; S.next(ui, cur); ++ui) {
        E.pre(cur, ui & 1, tid); __syncthreads();
        f32x4 acc[2][2][4][2];
        for (int ai = 0; ai < 2; ++ai) for (int bj = 0; bj < 2; ++bj) for (int m = 0; m < 4; ++m) for (int n = 0; n < 2; ++n) for (int j = 0; j < 4; ++j) {
            const int row = 256 * cur.pm + 128 * ai + 64 * wr + 16 * m + fr;
            const int col = Epi::PERM ? 256 * cur.pn + 128 * bj + 32 * wc + 8 * fq + 4 * n + j : 256 * cur.pn + 128 * bj + 32 * wc + 16 * n + 4 * fq + j;
            acc[ai][bj][m][n][j] = 0.f; }
        const int nseg = Epi::MIDK ? 3 : 1; const int kb[4] = {0, Epi::MIDK ? 256 : g.K, 768, g.K};
        for (int sg = 0; sg < nseg; ++sg) {
            for (int ai = 0; ai < 2; ++ai) for (int bj = 0; bj < 2; ++bj) for (int m = 0; m < 4; ++m) for (int n = 0; n < 2; ++n) for (int j = 0; j < 4; ++j) {
                const int row = 256 * cur.pm + 128 * ai + 64 * wr + 16 * m + fr;
                const int col = Epi::PERM ? 256 * cur.pn + 128 * bj + 32 * wc + 8 * fq + 4 * n + j : 256 * cur.pn + 128 * bj + 32 * wc + 16 * n + 4 * fq + j;
                const bf16_t* a = g.A + (size_t)row * g.lda; const bf16_t* b = g.Bt + (size_t)col * g.ldb; float s = 0.f;
                for (int k = kb[sg]; k < kb[sg + 1]; ++k) s += bf2f(a[k]) * bf2f(b[k]);
                acc[ai][bj][m][n][j] += s; }
            if constexpr (Epi::MIDK) { if (sg < 2) E.mid(acc, cur, wr, wc, fr, fq, sg); }
        }
        E(acc, cur, wr, wc, fr, fq, ui & 1);
    }
}
#endif
}

#ifndef CPU_EMU
#define XB_TMO      128
#define XB_XCNT(j)  (256  + 64 * (j))
#define XB_XSUB(j)  (1280 + 64 * (j))
#define XB_XGEN(j)  (2304 + 64 * (j))
#define XB_TOP      3328
#define XB_TOPGEN   3392
#define XCD_BAR_WORDS 3456
#define XB_SPIN_CAP (1u << 22)
__device__ __forceinline__ unsigned xb_ld(unsigned* p)              { return __hip_atomic_load(p, __ATOMIC_RELAXED, __HIP_MEMORY_SCOPE_AGENT); }
__device__ __forceinline__ unsigned xb_add(unsigned* p, unsigned v) { return __hip_atomic_fetch_add(p, v, __ATOMIC_RELAXED, __HIP_MEMORY_SCOPE_AGENT); }
__device__ __forceinline__ unsigned xb_xcc_id() { return (unsigned)__builtin_amdgcn_s_getreg((3 << 11) | 20) & 0xFu; }
#define XB_SPIN(cond, bar) do { unsigned _sp = 0; while (cond) { __builtin_amdgcn_s_sleep(1); \
    if ((++_sp & 255u) == 0u) { if (xb_ld(&(bar)[XB_TMO])) break; if (_sp > XB_SPIN_CAP) { atomicAdd(&(bar)[XB_TMO], 1u); break; } } } } while (0)
struct XcdBarrier { unsigned* bar; unsigned x; volatile LAS unsigned* st; };
__device__ __forceinline__ XcdBarrier xcd_barrier_post(unsigned* bar, volatile LAS unsigned* st) {
    XcdBarrier b; b.bar = bar; b.x = xb_xcc_id(); b.st = st;
    if (threadIdx.x == 0) (void)xb_add(&bar[XB_XCNT(b.x)], 1u);
    return b;
}
__device__ __forceinline__ void xcd_barrier_complete(unsigned* bar, unsigned x, unsigned& nloc, unsigned& nx) {
    const unsigned G = gridDim.x * gridDim.y * gridDim.z;
    unsigned sum, cnt, mine, sp = 0u;
    for (;;) {
        sum = 0u; cnt = 0u; mine = 0u;
#pragma unroll
        for (unsigned j = 0; j < 16; ++j) { const unsigned c = xb_ld(&bar[XB_XCNT(j)]); sum += c; cnt += (c > 0u) ? 1u : 0u; mine = (j == x) ? c : mine; }
        if (sum == G) break;
        __builtin_amdgcn_s_sleep(1);
        if ((++sp & 255u) == 0u) { if (xb_ld(&bar[XB_TMO])) break; if (sp > XB_SPIN_CAP) { atomicAdd(&bar[XB_TMO], 1u); break; } }
    }
    nloc = mine > 0u ? mine : 1u; nx = cnt > 0u ? cnt : 1u;
}
__device__ __forceinline__ void xcd_barrier(const XcdBarrier& b, int w0) {
    asm volatile("s_waitcnt vmcnt(0)" ::: "memory");
    __syncthreads();
    if (w0 == 0 && lane_id_v() == 0) {
        unsigned* bar = b.bar;
        __builtin_amdgcn_s_waitcnt(0);
        unsigned nloc = b.st[0], nx = b.st[1];
        if (nloc == 0u) { xcd_barrier_complete(bar, b.x, nloc, nx); b.st[0] = nloc; b.st[1] = nx; }
        const unsigned old = xb_add(&bar[XB_XSUB(b.x)], 1u);
        const unsigned gen = old / nloc;
        if (old + 1u == (gen + 1u) * nloc) {
            __builtin_amdgcn_fence(__ATOMIC_RELEASE, "agent");
            asm volatile("s_waitcnt vmcnt(0)" ::: "memory");
            const unsigned og = xb_add(&bar[XB_TOP], 1u);
            const unsigned tg = og / nx;
            if (og + 1u == (tg + 1u) * nx) xb_add(&bar[XB_TOPGEN], 1u);
            else XB_SPIN(xb_ld(&bar[XB_TOPGEN]) == tg, bar);
            __builtin_amdgcn_fence(__ATOMIC_ACQUIRE, "agent");
            xb_add(&bar[XB_XGEN(b.x)], 1u);
            asm volatile("s_waitcnt vmcnt(0)" ::: "memory");
        } else {
            XB_SPIN(xb_ld(&bar[XB_XGEN(b.x)]) == gen, bar);
            __builtin_amdgcn_fence(__ATOMIC_ACQUIRE, "agent");
            asm volatile("s_waitcnt vmcnt(0)" ::: "memory");
        }
    }
    __syncthreads();
}
#endif

enum { I_XP = 0, I_XS, I_PP, I_PS, I_F1N, I_F1G, I_F1U, I_F1D, I_MIXN, I_WIN, I_RELB, I_RETN, I_HLB, I_HGN, I_WBA, I_WBB, I_WBC, I_WMG, I_WOUT, I_F2N, I_F2G, I_F2U, I_F2D, I_PLEN, I_WPG, I_WPP, I_FINN, N_INPUTS };
struct Args { const float* in[N_INPUTS]; float* out; unsigned char* ws; int lo, hi; };

DEVFN float wave_sum(float v) {
#pragma unroll
    for (int o = 1; o < 64; o <<= 1) v += __shfl_xor(v, o);
    return v;
}
DEVFN void init_rows(const Args& a, bf16_t* H, float* ssq0, int gw, int ngw, int lane) {
    constexpr int NC = D / 256, RB = 4;
    for (int row0 = gw; row0 < T; row0 += RB * ngw) {
        f32x4 x[RB][NC];
#pragma unroll
        for (int r = 0; r < RB; ++r) { const int row = row0 + r * ngw < T ? row0 + r * ngw : row0;
            const float* src = row < NP ? a.in[I_XP] + (size_t)row * D : a.in[I_XS] + (size_t)(row - NP) * D;
#pragma unroll
            for (int j = 0; j < NC; ++j) x[r][j] = *(const f32x4*)(src + 4 * (lane + 64 * j)); }
#pragma unroll
        for (int r = 0; r < RB; ++r) { const int row = row0 + r * ngw; if (row >= T) break;
            float s = 0.f;
#pragma unroll
            for (int j = 0; j < NC; ++j) { const int c = 4 * (lane + 64 * j); const u32x2 o = pk4(x[r][j]); *(u32x2*)(H + (size_t)row * D + c) = o;
                const float r0 = bflo(o.x), r1 = bfhi(o.x), r2 = bflo(o.y), r3 = bfhi(o.y); s += (r0 * r0 + r1 * r1) + (r2 * r2 + r3 * r3); }
            s = wave_sum(s);
            if (lane == 0) *(f32x4*)(ssq0 + 4 * (size_t)row) = (f32x4){s, 0.f, 0.f, 0.f}; }
    }
}
DEVFN void final_norm_rows(const bf16_t* H, float* out, const float* gfin, int gw, int ngw, int lane, float oscale) {
    constexpr int NC = D / 256, RB = 4;
    f32x4 gq[NC];
#pragma unroll
    for (int j = 0; j < NC; ++j) gq[j] = *(const f32x4*)(gfin + 4 * (lane + 64 * j));
    for (int row0 = gw; row0 < T; row0 += RB * ngw) {
        u32x2 w[RB][NC];
#pragma unroll
        for (int r = 0; r < RB; ++r) { const int row = row0 + r * ngw < T ? row0 + r * ngw : row0;
#pragma unroll
            for (int j = 0; j < NC; ++j) w[r][j] = *(const u32x2*)(H + (size_t)row * D + 4 * (lane + 64 * j)); }
#pragma unroll
        for (int r = 0; r < RB; ++r) { const int row = row0 + r * ngw; if (row >= T) break;
            f32x4 v[NC]; float s = 0.f;
#pragma unroll
            for (int j = 0; j < NC; ++j) { const u32x2 x = w[r][j]; v[j] = (f32x4){bflo(x.x), bfhi(x.x), bflo(x.y), bfhi(x.y)}; s += (v[j][0] * v[j][0] + v[j][1] * v[j][1]) + (v[j][2] * v[j][2] + v[j][3] * v[j][3]); }
            const float rinv = rms_rinv(wave_sum(s)) * oscale;
#pragma unroll
            for (int j = 0; j < NC; ++j) *(f32x4*)(out + (size_t)row * D + 4 * (lane + 64 * j)) = v[j] * rinv * gq[j]; }
    }
}
DEVFN void cvt_ple(const Args& a, int l, bf16_t* PB, int gtid, int nthr) {
    for (size_t it = gtid; it < (size_t)T * D_PLE / 8; it += nthr) {
        const size_t e = it * 8; const int row = (int)(e / D_PLE), c = (int)(e % D_PLE);
        const float* src = row < NP ? a.in[I_PP] + ((size_t)l * NP + row) * D_PLE + c : a.in[I_PS] + ((size_t)l * NS + (row - NP)) * D_PLE + c;
        const f32x4 x = *(const f32x4*)src, y = *(const f32x4*)(src + 4);
        u32x4 w; w.x = pk2(x[0], x[1]); w.y = pk2(x[2], x[3]); w.z = pk2(y[0], y[1]); w.w = pk2(y[2], y[3]);
        *(u32x4*)(PB + e) = w;
    }
}
DEVFN int t5_bucket(int rel) {
    const int ret = rel > 0 ? 16 : 0; const int n = rel < 0 ? -rel : rel;
    if (n < 8) return ret + n;
    int large = 8 + (int)(logf((float)n / 8.0f) / logf(128.0f) * 8.0f);
    large = large < 15 ? large : 15;
    return ret + large;
}
DEVFN void prologue_tables(const Args& a, float* rope, float* biasT, float* lbs, int gtid, int nthr) {
    for (int it = gtid; it < 4096 * 64; it += nthr) { const int pos = it >> 6, i = it & 63;
        const float inv = powf(10000.0f, -(float)i / 64.0f); const float ang = (float)pos * inv;
        rope[it] = cosf(ang); rope[4096 * 64 + it] = sinf(ang); }
    for (int it = gtid; it < 3 * 4 * 160; it += nthr) { const int idx = it % 160, gh = it / 160, g = gh >> 2, hh = gh & 3; const int o = idx - 16; const int dil = g == 0 ? 1 : (g == 1 ? 4 : 16);
        biasT[it] = (o >= 0 && o <= 128) ? a.in[I_RELB][t5_bucket((o - 64) * dil) * 12 + 4 * g + hh] : -1e30f; }
    for (int c = gtid; c < 512; c += nthr) {
        float mx = -3.0e38f; for (int l = 0; l < DEPTH; ++l) mx = fmaxf(mx, a.in[I_HLB][l * 512 + c]);
        float den = 0.f; for (int l = 0; l < DEPTH; ++l) den += expf(a.in[I_HLB][l * 512 + c] - mx);
        float cum = 0.f, first = 0.f;
        for (int l = 0; l < DEPTH; ++l) { cum += expf(a.in[I_HLB][l * 512 + c] - mx) / den; if (l == 0) first = cum; lbs[l * 512 + c] = cum - first; }
    }
}
DEVFN int rowmap(int mode, int nl) {
    if (mode == 1) return (nl >> 7) * 256 + (nl & 127);
    if (mode == 2) return (nl >> 7) * 256 + 128 + (nl & 127);
    if (mode == 3) { const int dl = nl & 127, nn = dl >> 6, rem = dl & 63; return (nl & ~127) + 8 * (rem >> 2) + 4 * nn + (rem & 3); }
    return nl;
}
struct CvtDesc { const float* W; int K, ldw, col0, ncols; bf16_t* dst; int ldd, koff, mode, row_off; const float* gain; float cscale; };
DEVFN void cvt_item(const CvtDesc& d, int item, LAS float* scr, int lane) {
    const int nblk = d.ncols / 32, kb = item / nblk, nb = item % nblk, k0 = 64 * kb, n0 = 32 * nb;
#pragma unroll
    for (int i = 0; i < 8; ++i) { const int kk = 8 * i + (lane >> 3), n4 = 4 * (lane & 7); const float gsc = (d.gain ? d.gain[k0 + kk] : 1.0f) * d.cscale;
        const f32x4 w = *(const f32x4*)(d.W + (size_t)(k0 + kk) * d.ldw + d.col0 + n0 + n4) * gsc;
        LAS float* p = scr + kk * 33 + n4; p[0] = w[0]; p[1] = w[1]; p[2] = w[2]; p[3] = w[3]; }
    __builtin_amdgcn_wave_barrier();
    const int c = lane & 7;
#pragma unroll
    for (int j = 0; j < 4; ++j) { const int n = (lane >> 3) + 8 * j; const LAS float* s = scr + (8 * c) * 33 + n;
        u32x4 o; o.x = pk2(s[0 * 33], s[1 * 33]); o.y = pk2(s[2 * 33], s[3 * 33]); o.z = pk2(s[4 * 33], s[5 * 33]); o.w = pk2(s[6 * 33], s[7 * 33]);
        *(u32x4*)(d.dst + (size_t)(d.row_off + rowmap(d.mode, n0 + n)) * d.ldd + d.koff + k0 + 8 * c) = o; }
    __builtin_amdgcn_wave_barrier();
}
constexpr int N_CVT = 18;
DEVFN CvtDesc cvt_desc(const Args& a, int l, bf16_t* WB, int i) {
    CvtDesc d; d.col0 = 0; d.koff = 0; d.mode = 0; d.row_off = 0; d.gain = nullptr; d.cscale = 1.0f;
    const float* win = a.in[I_WIN] + (size_t)l * D * N_IN;
    switch (i) {
    case 0: d.W = a.in[I_F1G] + (size_t)l * D * FF; d.K = D; d.ldw = FF; d.ncols = FF; d.dst = WB + WE_GU1; d.ldd = D; d.mode = 1; d.gain = a.in[I_F1N] + l * D; break;
    case 1: d.W = a.in[I_F1U] + (size_t)l * D * FF; d.K = D; d.ldw = FF; d.ncols = FF; d.dst = WB + WE_GU1; d.ldd = D; d.mode = 2; d.gain = a.in[I_F1N] + l * D; break;
    case 2: d.W = a.in[I_F1D] + (size_t)l * FF * D; d.K = FF; d.ldw = D; d.ncols = D; d.dst = WB + WE_D1; d.ldd = FF; break;
    case 3: d.W = win; d.K = D; d.ldw = N_IN; d.col0 = 0; d.ncols = 768; d.dst = WB + WE_IN; d.ldd = D; d.gain = a.in[I_MIXN] + l * D; d.cscale = 0.125f; break;
    case 4: d.W = win; d.K = D; d.ldw = N_IN; d.col0 = 768; d.ncols = 1536; d.dst = WB + WE_IN; d.ldd = D; d.row_off = 768; d.gain = a.in[I_MIXN] + l * D; break;
    case 5: d.W = win; d.K = D; d.ldw = N_IN; d.col0 = OFF_QB; d.ncols = 512; d.dst = WB + WE_IN; d.ldd = D; d.row_off = OFF_QB; d.mode = 3; d.gain = a.in[I_MIXN] + l * D; break;
    case 6: d.W = win; d.K = D; d.ldw = N_IN; d.col0 = OFF_KB; d.ncols = 512; d.dst = WB + WE_IN; d.ldd = D; d.row_off = OFF_KB; d.mode = 3; d.gain = a.in[I_MIXN] + l * D; d.cscale = 0.08838834764831845f; break;
    case 7: d.W = win; d.K = D; d.ldw = N_IN; d.col0 = OFF_VB; d.ncols = N_IN - OFF_VB; d.dst = WB + WE_IN; d.ldd = D; d.row_off = OFF_VB; d.gain = a.in[I_MIXN] + l * D; break;
    case 8: d.W = a.in[I_WMG] + (size_t)l * D * 3 * D; d.K = D; d.ldw = 3 * D; d.ncols = 3 * D; d.dst = WB + WE_IN; d.ldd = D; d.row_off = OFF_MG; d.gain = a.in[I_MIXN] + l * D; break;
    case 9: d.W = a.in[I_WBA] + (size_t)l * 256 * D; d.K = 256; d.ldw = D; d.ncols = D; d.dst = WB + WE_BR; d.ldd = MIXW; d.koff = 0; break;
    case 10: d.W = a.in[I_WBB] + (size_t)l * 512 * D; d.K = 512; d.ldw = D; d.ncols = D; d.dst = WB + WE_BR; d.ldd = MIXW; d.koff = 256; break;
    case 11: d.W = a.in[I_WBC] + (size_t)l * 512 * D; d.K = 512; d.ldw = D; d.ncols = D; d.dst = WB + WE_BR; d.ldd = MIXW; d.koff = 768; break;
    case 12: d.W = a.in[I_WOUT] + (size_t)l * D * D; d.K = D; d.ldw = D; d.ncols = D; d.dst = WB + WE_OUT; d.ldd = D; break;
    case 13: d.W = a.in[I_F2G] + (size_t)l * D * FF; d.K = D; d.ldw = FF; d.ncols = FF; d.dst = WB + WE_GU2; d.ldd = D; d.mode = 1; d.gain = a.in[I_F2N] + l * D; break;
    case 14: d.W = a.in[I_F2U] + (size_t)l * D * FF; d.K = D; d.ldw = FF; d.ncols = FF; d.dst = WB + WE_GU2; d.ldd = D; d.mode = 2; d.gain = a.in[I_F2N] + l * D; break;
    case 15: d.W = a.in[I_F2D] + (size_t)l * FF * D; d.K = FF; d.ldw = D; d.ncols = D; d.dst = WB + WE_D2; d.ldd = FF; break;
    case 16: d.W = a.in[I_WPG] + (size_t)l * D * D; d.K = D; d.ldw = D; d.ncols = D; d.dst = WB + WE_PG; d.ldd = D; d.gain = a.in[I_PLEN] + l * D; break;
    default: d.W = a.in[I_WPP] + (size_t)l * D_PLE * D; d.K = D_PLE; d.ldw = D; d.ncols = D; d.dst = WB + WE_PP; d.ldd = D_PLE; break;
    }
    return d;
}
DEVFN void convert_weights(const Args& a, int l, bf16_t* WB, LAS unsigned char* lds, int gw, int ngw, int wave, int lane) {
    LAS float* scr = (LAS float*)(lds + wave * 8704);
    for (int i = 0; i < N_CVT; ++i) {
        const CvtDesc d = cvt_desc(a, l, WB, i);
        const int nitems = (d.K / 64) * (d.ncols / 32);
        for (int it = gw; it < nitems; it += ngw) cvt_item(d, it, scr, lane);
    }
}

#ifndef CPU_EMU
DEVFN s16x4 lds_tr(const LAS bf16_t* p) { return __builtin_amdgcn_ds_read_tr16_b64_v4i16((LAS s16x4*)p); }
#else
s16x4 lds_tr(const bf16_t* p);
#endif
DEVFN bf16x8 tr8(const LAS bf16_t* X, int stride, int r0, int col0, int c16, int g4) {
    const LAS bf16_t* p = X + (r0 + 8 * g4 + (c16 >> 2)) * stride + col0 + 4 * (c16 & 3);
    return cat8(lds_tr(p), lds_tr(p + 4 * stride));
}
DEVFN bf16x8 tr8p(const LAS bf16_t* X, int stride, int r0, int col0, int c16, int g4) {
    const LAS bf16_t* p = X + (r0 + 4 * g4 + (c16 >> 2)) * stride + col0 + 4 * (c16 & 3);
    return cat8(lds_tr(p), lds_tr(p + 16 * stride));
}
DEVFN u32x4 scale8(u32x4 v, float s) {
    u32x4 o; o.x = pk2(bflo(v.x) * s, bfhi(v.x) * s); o.y = pk2(bflo(v.y) * s, bfhi(v.y) * s); o.z = pk2(bflo(v.z) * s, bfhi(v.z) * s); o.w = pk2(bflo(v.w) * s, bfhi(v.w) * s); return o;
}
template <class U> DEVFN void run_units(LAS unsigned char* lds, const U& ctx, int u0, int u1) {
    if (u0 >= u1) return;
    typename U::Regs L = ctx.load(u0);
    for (int u = u0; u < u1; ++u) {
        __syncthreads();
        ctx.stage(lds, L);
        const typename U::Regs N = ctx.load(u + 1 < u1 ? u + 1 : u);
        __syncthreads();
        ctx.compute(lds, L, u);
        L = N;
    }
}

template <class U, class F> DEVFN void run_units_k(LAS unsigned char* lds, const U& ctx, int u0, int u1, typename U::Regs L, F tail) {
    if (u0 >= u1) { tail(); return; }
    for (int u = u0; u + 1 < u1; ++u) {
        __syncthreads();
        ctx.stage(lds, L);
        const typename U::Regs N = ctx.load(u + 1);
        __syncthreads();
        ctx.compute(lds, L, u);
        L = N;
    }
    __syncthreads();
    ctx.stage(lds, L);
    tail();
    __syncthreads();
    int ul = u1 - 1; OPAQUE_SI(ul);
    ctx.compute(lds, L, ul);
}
template <class U> DEVFN void run_units2(LAS unsigned char* lds, const U& ctx, int u0, int u1) {
    if (u0 >= u1) return;
    typename U::Regs L; ctx.load1(L, u0); ctx.load2(L, u0);
    for (int u = u0; u < u1; ++u) {
        __syncthreads();
        ctx.stage(lds, L);
        typename U::Regs N; const int nu = u + 1 < u1 ? u + 1 : u;
        ctx.load1(N, nu);
        __syncthreads();
        ctx.compute(lds, L, u, N, nu);
        L = N;
    }
}
template <class U> DEVFN void run_units2_k(LAS unsigned char* lds, const U& ctx, int u0, int u1, typename U::Regs L) {
    if (u0 >= u1) return;
    ctx.load2(L, u0);
    for (int u = u0; u < u1; ++u) {
        __syncthreads();
        ctx.stage(lds, L);
        typename U::Regs N; const int nu = u + 1 < u1 ? u + 1 : u;
        ctx.load1(N, nu);
        __syncthreads();
        ctx.compute(lds, L, u, N, nu);
        L = N;
    }
}
struct AUnit {
    const bf16_t* Z; bf16_t* AO; float* LSE; const float* biasT; int S; int w0;
    struct Regs { u32x4 kv[4], vv[4]; bf16x8 bq[2]; f32x4 b; };
    struct Idx { int hh, g, dil, L, cb, head, rowbase, k0; };
    DEVFN Idx decode(int unit) const {
        Idx x; const int upb = S / 128; const int ub = unit % upb; int t = unit / upb; x.hh = t & 3; t >>= 2; x.g = t % 3; const int seq = t / 3;
        x.dil = x.g == 0 ? 1 : (x.g == 1 ? 4 : 16); x.L = S / x.dil; const int bpr = x.L / 128; const int r = ub / bpr; x.cb = ub % bpr;
        x.head = 4 * x.g + x.hh; x.rowbase = seq * S + r; x.k0 = 128 * x.cb - 64; return x;
    }
    DEVFN Regs load(int unit) const {
        const int tid = opaque_tid(w0), lane = tid & 63, w = tid >> 6, c16 = lane & 15, g4 = lane >> 4; const Idx x = decode(unit); Regs R;
#pragma unroll
        for (int i = 0; i < 4; ++i) {
            const int id = tid + 512 * i, key = id >> 3, ch = id & 7, ik = x.k0 + key;
            const int ikc = ik < 0 ? 0 : (ik < x.L ? ik : x.L - 1); const int zr = x.rowbase + ikc * x.dil;
            R.kv[i] = *(const u32x4*)(Z + zoff(OFF_KA, 64, x.head, zr, 8 * ch)); R.vv[i] = *(const u32x4*)(Z + zoff(OFF_VA, 64, x.head, zr, 8 * ch));
        }
        R.b = (f32x4){tid < 160 ? biasT[(x.g * 4 + x.hh) * 160 + tid] : 0.f, 0.f, 0.f, 0.f};
        const size_t qrow = (size_t)(x.rowbase + (128 * x.cb + 16 * w + c16) * x.dil);
#pragma unroll
        for (int ks = 0; ks < 2; ++ks) R.bq[ks] = *(const bf16x8*)(Z + zoff(OFF_QA, 64, x.head, (int)qrow, 32 * ks + 8 * g4));
        return R;
    }
    DEVFN void stage(LAS unsigned char* lds, const Regs& R) const {
        const int tid = opaque_tid(w0);
        LAS bf16_t* Ks = (LAS bf16_t*)lds; LAS bf16_t* Vs = (LAS bf16_t*)(lds + 256 * 72 * 2); LAS float* bs = (LAS float*)(lds + 2 * 256 * 72 * 2);
#pragma unroll
        for (int i = 0; i < 4; ++i) { const int id = tid + 512 * i, key = id >> 3, ch = id & 7; *(LAS u32x4*)(Ks + key * 72 + 8 * ch) = R.kv[i]; *(LAS u32x4*)(Vs + key * 72 + 8 * ch) = R.vv[i]; }
        if (tid < 160) bs[tid] = R.b[0];
    }
    DEVFN void compute(LAS unsigned char* lds, const Regs& R, int unit) const {
        const int tid = opaque_tid(w0), lane = tid & 63, w = tid >> 6, c16 = lane & 15, g4 = lane >> 4; const Idx x = decode(unit);
        const LAS bf16_t* Ks = (const LAS bf16_t*)lds; const LAS bf16_t* Vs = (const LAS bf16_t*)(lds + 256 * 72 * 2); const LAS float* bs = (const LAS float*)(lds + 2 * 256 * 72 * 2);
        const size_t qrow = (size_t)(x.rowbase + (128 * x.cb + 16 * w + c16) * x.dil);
        f32x4 sc[9]; float mx = -3.0e38f;
#pragma unroll
        for (int kt = 0; kt < 9; ++kt) {
            f32x4 acc = {0.f, 0.f, 0.f, 0.f};
#pragma unroll
            for (int ks = 0; ks < 2; ++ks) acc = mfma16(*(const LAS bf16x8*)(Ks + (16 * (w + kt) + c16) * 72 + 32 * ks + 8 * g4), R.bq[ks], acc);
            f32x4 bv;
#pragma unroll
            for (int rr = 0; rr < 4; ++rr) bv[rr] = bs[16 * kt + 4 * g4 + rr - c16 + 16];
            OPAQUE_V4(bv);
#pragma unroll
            for (int rr = 0; rr < 4; ++rr) {
                const int ik = x.k0 + 16 * (w + kt) + 4 * g4 + rr;
                const float s = (unsigned)ik < (unsigned)x.L ? acc[rr] + bv[rr] : -1e30f;
                acc[rr] = s; mx = fmaxf(mx, s);
            }
            sc[kt] = acc;
        }
        mx = fmaxf(mx, __shfl_xor(mx, 16)); mx = fmaxf(mx, __shfl_xor(mx, 32));
        float sum = 0.f;
#pragma unroll
        for (int kt = 0; kt < 9; ++kt)
#pragma unroll
            for (int rr = 0; rr < 4; ++rr) { const float p = fexp(sc[kt][rr] - mx); sc[kt][rr] = p; sum += p; }
        sum += __shfl_xor(sum, 16); sum += __shfl_xor(sum, 32);
        bf16x8 bp[5];
        const f32x4 zero4 = {0.f, 0.f, 0.f, 0.f};
#pragma unroll
        for (int pp = 0; pp < 5; ++pp) bp[pp] = pack8(sc[2 * pp], pp < 4 ? sc[2 * pp + 1] : zero4);
        const float inv = 1.0f / sum;
#pragma unroll
        for (int dt = 0; dt < 4; ++dt) {
            f32x4 acc = {0.f, 0.f, 0.f, 0.f};
#pragma unroll
            for (int pp = 0; pp < 5; ++pp) {
                const LAS bf16_t* p = Vs + (16 * (w + 2 * pp) + 4 * g4 + (c16 >> 2)) * 72 + 16 * dt + 4 * (c16 & 3);
                acc = mfma16(cat8(lds_tr(p), lds_tr(p + (pp < 4 ? 16 * 72 : 0))), bp[pp], acc);
            }
            *(u32x2*)(AO + qrow * AOW + x.head * 64 + 16 * dt + 4 * g4) = pk4(acc * inv);
        }
        if (g4 == 0) LSE[qrow * 12 + x.head] = mx + logf(sum);
    }
};
DEVFN void mixer_a_merge(const bf16_t* AO, const float* LSE, bf16_t* MIX, int gtid, int nthr) {
    for (int it = gtid; it < SLAB * 32; it += nthr) {
        const int row = it >> 5, hh = (it >> 3) & 3, c = it & 7;
        const float l0 = LSE[(size_t)row * 12 + hh], l1 = LSE[(size_t)row * 12 + 4 + hh], l2 = LSE[(size_t)row * 12 + 8 + hh];
        const float m = fmaxf(l0, fmaxf(l1, l2)); float w0 = fexp(l0 - m), w1 = fexp(l1 - m), w2 = fexp(l2 - m); const float inv = 1.0f / (w0 + w1 + w2); w0 *= inv; w1 *= inv; w2 *= inv;
        const u32x4 a0 = *(const u32x4*)(AO + (size_t)row * AOW + hh * 64 + 8 * c), a1 = *(const u32x4*)(AO + (size_t)row * AOW + (4 + hh) * 64 + 8 * c), a2 = *(const u32x4*)(AO + (size_t)row * AOW + (8 + hh) * 64 + 8 * c);
        u32x4 o;
        o.x = pk2(w0 * bflo(a0.x) + w1 * bflo(a1.x) + w2 * bflo(a2.x), w0 * bfhi(a0.x) + w1 * bfhi(a1.x) + w2 * bfhi(a2.x));
        o.y = pk2(w0 * bflo(a0.y) + w1 * bflo(a1.y) + w2 * bflo(a2.y), w0 * bfhi(a0.y) + w1 * bfhi(a1.y) + w2 * bfhi(a2.y));
        o.z = pk2(w0 * bflo(a0.z) + w1 * bflo(a1.z) + w2 * bflo(a2.z), w0 * bfhi(a0.z) + w1 * bfhi(a1.z) + w2 * bfhi(a2.z));
        o.w = pk2(w0 * bflo(a0.w) + w1 * bflo(a1.w) + w2 * bflo(a2.w), w0 * bfhi(a0.w) + w1 * bfhi(a1.w) + w2 * bfhi(a2.w));
        *(u32x4*)(MIX + (size_t)row * MIXW + hh * 64 + 8 * c) = o;
    }
}

struct BKvUnit {
    const bf16_t* Z; bf16_t* SB; int w0;
    struct Regs { u32x4 kv[4], vv[4]; };
    DEVFN Regs load(int unit) const {
        const int tid = opaque_tid(w0); const int h = unit & 3, row0 = (unit >> 2) * 128; Regs R;
#pragma unroll
        for (int i = 0; i < 4; ++i) { const int id = tid + 512 * i, j = id >> 4, ch = id & 15; R.kv[i] = *(const u32x4*)(Z + zoff(OFF_KB, 128, h, row0 + j, 8 * ch)); R.vv[i] = *(const u32x4*)(Z + zoff(OFF_VB, 128, h, row0 + j, 8 * ch)); }
        return R;
    }
    DEVFN void stage(LAS unsigned char* lds, const Regs& R) const { (void)lds; (void)R; }
    DEVFN void compute(LAS unsigned char* lds, const Regs& R, int unit) const {
        const int tid = opaque_tid(w0), lane = tid & 63, w = tid >> 6, c16 = lane & 15, g4 = lane >> 4;
        const int h = unit & 3;
        LAS bf16_t* Ks = (LAS bf16_t*)lds;
        LAS bf16_t* Vf = (LAS bf16_t*)(lds + 128 * 136 * 2);
        LAS bf16_t* Vb = (LAS bf16_t*)(lds + 2 * 128 * 136 * 2);
        const float l2f = ret_l2(0, h), l2b = ret_l2(1, h);
#pragma unroll
        for (int i = 0; i < 4; ++i) {
            const int id = tid + 512 * i, j = id >> 4, ch = id & 15;
            *(LAS u32x4*)(Ks + j * 136 + 8 * ch) = R.kv[i];
            *(LAS u32x4*)(Vf + j * 136 + 8 * ch) = scale8(R.vv[i], exp2f((float)(127 - j) * l2f));
            *(LAS u32x4*)(Vb + j * 136 + 8 * ch) = scale8(R.vv[i], exp2f((float)j * l2b));
        }
        __syncthreads();
        bf16x8 af[4];
#pragma unroll
        for (int ks = 0; ks < 4; ++ks) af[ks] = tr8(Ks, 136, 32 * ks, 16 * w, c16, g4);
#pragma unroll
        for (int dir = 0; dir < 2; ++dir) {
            const LAS bf16_t* V = dir ? Vb : Vf;
            bf16_t* dst = SB + ((size_t)unit * 2 + dir) * 16384;
#pragma unroll
            for (int b = 0; b < 8; ++b) {
                f32x4 acc = {0.f, 0.f, 0.f, 0.f};
#pragma unroll
                for (int ks = 0; ks < 4; ++ks) acc = mfma16(af[ks], tr8(V, 136, 32 * ks, 16 * b, c16, g4), acc);
                *(u32x2*)(dst + (16 * b + c16) * 128 + 16 * w + 4 * g4) = pk4(acc);
            }
        }
    }
};
DEVFN void mixer_scan(bf16_t* SB, bf16_t* SC, const float* GC, int nseq, int S, int gtid, int nthr) {
    const int nb = S / 128, nc = S / 64;
    for (int it = gtid; it < nseq * 8 * 2048; it += nthr) {
        const int e8 = it & 2047; int t = it >> 11; const int dir = t & 1, h = (t >> 1) & 3, seq = t >> 3;
        const float G = exp2f(128.0f * ret_l2(dir, h));
        float carry[8];
#pragma unroll
        for (int j = 0; j < 8; ++j) carry[j] = 0.f;
        for (int cc = 0; cc < nb; ++cc) {
            const int c = dir ? nb - 1 - cc : cc;
            bf16_t* p = SB + ((size_t)((seq * nb + c) * 4 + h) * 2 + dir) * 16384 + e8 * 8;
            const u32x4 v = *(const u32x4*)p;
            u32x4 o; o.x = pk2(carry[0], carry[1]); o.y = pk2(carry[2], carry[3]); o.z = pk2(carry[4], carry[5]); o.w = pk2(carry[6], carry[7]);
            *(u32x4*)p = o;
            carry[0] = carry[0] * G + bflo(v.x); carry[1] = carry[1] * G + bfhi(v.x); carry[2] = carry[2] * G + bflo(v.y); carry[3] = carry[3] * G + bfhi(v.y);
            carry[4] = carry[4] * G + bflo(v.z); carry[5] = carry[5] * G + bfhi(v.z); carry[6] = carry[6] * G + bflo(v.w); carry[7] = carry[7] * G + bfhi(v.w);
        }
    }
    for (int it = gtid; it < nseq * 8 * 2048; it += nthr) {
        const int e8 = it & 2047; int t = it >> 11; const int dir = t & 1, h = (t >> 1) & 3, seq = t >> 3;
        const int dk0 = (e8 & 15) * 8;
        float carry[8];
#pragma unroll
        for (int j = 0; j < 8; ++j) carry[j] = 0.f;
        for (int cc = 0; cc < nc; ++cc) {
            const int c = dir ? nc - 1 - cc : cc;
            const size_t ui = (size_t)((seq * nc + c) * 4 + h) * 2 + dir;
            bf16_t* p = SC + ui * 16384 + e8 * 8;
            const f32x4 g0 = *(const f32x4*)(GC + ui * 128 + dk0), g1 = *(const f32x4*)(GC + ui * 128 + dk0 + 4);
            const u32x4 v = *(const u32x4*)p;
            u32x4 o; o.x = pk2(carry[0], carry[1]); o.y = pk2(carry[2], carry[3]); o.z = pk2(carry[4], carry[5]); o.w = pk2(carry[6], carry[7]);
            *(u32x4*)p = o;
            carry[0] = carry[0] * g0[0] + bflo(v.x); carry[1] = carry[1] * g0[1] + bfhi(v.x); carry[2] = carry[2] * g0[2] + bflo(v.y); carry[3] = carry[3] * g0[3] + bfhi(v.y);
            carry[4] = carry[4] * g1[0] + bflo(v.z); carry[5] = carry[5] * g1[1] + bfhi(v.z); carry[6] = carry[6] * g1[2] + bflo(v.w); carry[7] = carry[7] * g1[3] + bfhi(v.w);
        }
    }
}
struct BOutUnit {
    const bf16_t* Z; const bf16_t* SB; bf16_t* MIX; const float* gain; int w0;
    struct Regs { u32x4 kv[4], vv[4], sf[4], sb[4]; bf16x8 bq[4]; f32x4 gn; };
    DEVFN Regs load(int unit) const {
        const int tid = opaque_tid(w0), lane = tid & 63, w = tid >> 6, c16 = lane & 15, g4 = lane >> 4; const int h = unit & 3, row0 = (unit >> 2) * 128; Regs R;
        const bf16_t* gSf = SB + ((size_t)unit * 2 + 0) * 16384; const bf16_t* gSb = SB + ((size_t)unit * 2 + 1) * 16384;
#pragma unroll
        for (int i = 0; i < 4; ++i) {
            const int id = tid + 512 * i, j = id >> 4, ch = id & 15;
            R.kv[i] = *(const u32x4*)(Z + zoff(OFF_KB, 128, h, row0 + j, 8 * ch)); R.vv[i] = *(const u32x4*)(Z + zoff(OFF_VB, 128, h, row0 + j, 8 * ch)); R.sf[i] = *(const u32x4*)(gSf + j * 128 + 8 * ch); R.sb[i] = *(const u32x4*)(gSb + j * 128 + 8 * ch);
        }
        const size_t row = (size_t)(row0 + 16 * w + c16);
#pragma unroll
        for (int ks = 0; ks < 4; ++ks) R.bq[ks] = *(const bf16x8*)(Z + zoff(OFF_QB, 128, h, (int)row, 32 * ks + 8 * g4));
        R.gn = (f32x4){gain[h * 128 + (tid & 127)], 0.f, 0.f, 0.f};
        return R;
    }
    DEVFN void stage(LAS unsigned char* lds, const Regs& R) const {
        const int tid = opaque_tid(w0);
        LAS bf16_t* Ks = (LAS bf16_t*)lds; LAS bf16_t* Vs = (LAS bf16_t*)(lds + 128 * 136 * 2); LAS bf16_t* Sf = (LAS bf16_t*)(lds + 2 * 128 * 136 * 2); LAS bf16_t* Sb = (LAS bf16_t*)(lds + 3 * 128 * 136 * 2);
#pragma unroll
        for (int i = 0; i < 4; ++i) { const int id = tid + 512 * i, j = id >> 4, ch = id & 15; const int o = j * 136 + 8 * ch;
            *(LAS u32x4*)(Ks + o) = R.kv[i]; *(LAS u32x4*)(Vs + o) = R.vv[i]; *(LAS u32x4*)(Sf + o) = R.sf[i]; *(LAS u32x4*)(Sb + o) = R.sb[i]; }
        if (tid < 128) ((LAS float*)(lds + 4 * 128 * 136 * 2))[tid] = R.gn[0];
    }
    DEVFN void compute(LAS unsigned char* lds, const Regs& R, int unit) const {
        const int tid = opaque_tid(w0), lane = tid & 63, w = tid >> 6, c16 = lane & 15, g4 = lane >> 4;
        const int h = unit & 3, row0 = (unit >> 2) * 128;
        const LAS bf16_t* Ks = (const LAS bf16_t*)lds;
        const LAS bf16_t* Vs = (const LAS bf16_t*)(lds + 128 * 136 * 2);
        const LAS bf16_t* Sf = (const LAS bf16_t*)(lds + 2 * 128 * 136 * 2);
        const LAS bf16_t* Sb = (const LAS bf16_t*)(lds + 3 * 128 * 136 * 2);
        const LAS float* gtab = (const LAS float*)(lds + 4 * 128 * 136 * 2);
        const float l2f = ret_l2(0, h), l2b = ret_l2(1, h);
        const int i = 16 * w + c16; const size_t row = (size_t)(row0 + i);
        u32x2 gwv[8];
#pragma unroll
        for (int dvt = 0; dvt < 8; ++dvt) gwv[dvt] = *(const u32x2*)(Z + zoff(OFF_GB, 128, h, (int)row, 16 * dvt + 4 * g4));
        f32x4 P[8];
#pragma unroll
        for (int jt = 0; jt < 8; ++jt) {
            f32x4 acc = {0.f, 0.f, 0.f, 0.f};
#pragma unroll
            for (int ks = 0; ks < 4; ++ks) acc = mfma16(*(const LAS bf16x8*)(Ks + (16 * jt + c16) * 136 + 32 * ks + 8 * g4), R.bq[ks], acc);
#pragma unroll
            for (int rr = 0; rr < 4; ++rr) { const int d = i - (16 * jt + 4 * g4 + rr); const float wgt = d > 0 ? exp2f((float)d * l2f) : (d < 0 ? exp2f((float)(-d) * l2b) : 2.0f); acc[rr] *= wgt; }
            P[jt] = acc;
        }
        bf16x8 bp[4];
#pragma unroll
        for (int k2 = 0; k2 < 4; ++k2) bp[k2] = pack8(P[2 * k2], P[2 * k2 + 1]);
        const float cf = exp2f((float)(i + 1) * l2f), cb = exp2f((float)(128 - i) * l2b);
        f32x4 o[8]; float s1 = 0.f;
#pragma unroll
        for (int dvt = 0; dvt < 8; ++dvt) {
            f32x4 aO = {0.f, 0.f, 0.f, 0.f}, aF = {0.f, 0.f, 0.f, 0.f}, aB = {0.f, 0.f, 0.f, 0.f};
#pragma unroll
            for (int k2 = 0; k2 < 4; ++k2) aO = mfma16(tr8p(Vs, 136, 32 * k2, 16 * dvt, c16, g4), bp[k2], aO);
#pragma unroll
            for (int ks = 0; ks < 4; ++ks) {
                aF = mfma16(*(const LAS bf16x8*)(Sf + (16 * dvt + c16) * 136 + 32 * ks + 8 * g4), R.bq[ks], aF);
                aB = mfma16(*(const LAS bf16x8*)(Sb + (16 * dvt + c16) * 136 + 32 * ks + 8 * g4), R.bq[ks], aB);
            }
            o[dvt] = aO + aF * cf + aB * cb;
            s1 += (o[dvt][0] + o[dvt][1]) + (o[dvt][2] + o[dvt][3]);
            EPI_FENCE();
        }
        s1 += __shfl_xor(s1, 16); s1 += __shfl_xor(s1, 32);
        const float mu = s1 * (1.0f / 128.0f); float s2 = 0.f;
#pragma unroll
        for (int dvt = 0; dvt < 8; ++dvt) { o[dvt] = o[dvt] - mu; s2 += (o[dvt][0] * o[dvt][0] + o[dvt][1] * o[dvt][1]) + (o[dvt][2] * o[dvt][2] + o[dvt][3] * o[dvt][3]); }
        s2 += __shfl_xor(s2, 16); s2 += __shfl_xor(s2, 32);
        const float rstd = 1.0f / sqrtf(s2 * (1.0f / 128.0f) + EPS);
#pragma unroll
        for (int dvt = 0; dvt < 8; ++dvt) {
            const int col = h * 128 + 16 * dvt + 4 * g4;
            const f32x4 gn = *(const LAS f32x4*)(gtab + 16 * dvt + 4 * g4); const u32x2 gw = gwv[dvt];
            f32x4 v = o[dvt] * rstd * gn; v[0] *= bflo(gw.x); v[1] *= bfhi(gw.x); v[2] *= bflo(gw.y); v[3] *= bfhi(gw.y);
            *(u32x2*)(MIX + row * MIXW + 256 + col) = pk4(v);
        }
    }
};

struct CRegs { u32x4 lf[4], v[2]; };
DEVFN CRegs c_load_common(const bf16_t* Z, int row0, int h, int tid) {
    CRegs R;
#pragma unroll
    for (int i = 0; i < 4; ++i) { const int id = tid + 512 * i, dir = id >> 10, j = (id >> 4) & 63, ch = id & 15; R.lf[i] = *(const u32x4*)(Z + zoff(OFF_FCF + dir * 512, 128, h, row0 + j, 8 * ch)); }
#pragma unroll
    for (int i = 0; i < 2; ++i) { const int id = tid + 512 * i, j = id >> 4, ch = id & 15; R.v[i] = *(const u32x4*)(Z + zoff(OFF_IC, 128, h, row0 + j, 8 * ch)); }
    return R;
}
DEVFN void c_stage_common(LAS float* LF, LAS bf16_t* Vs, const CRegs& R, int tid) {
#pragma unroll
    for (int i = 0; i < 4; ++i) {
        const int id = tid + 512 * i, dir = id >> 10, j = (id >> 4) & 63, ch = id & 15; const u32x4 v = R.lf[i];
        LAS float* d = LF + (dir * 64 + j) * 128 + 8 * ch;
        f32x4 a, b; a[0] = h2f(v.x & 0xffffu); a[1] = h2f(v.x >> 16); a[2] = h2f(v.y & 0xffffu); a[3] = h2f(v.y >> 16); b[0] = h2f(v.z & 0xffffu); b[1] = h2f(v.z >> 16); b[2] = h2f(v.w & 0xffffu); b[3] = h2f(v.w >> 16);
        *(LAS f32x4*)d = a; *(LAS f32x4*)(d + 4) = b;
    }
#pragma unroll
    for (int i = 0; i < 2; ++i) { const int id = tid + 512 * i, j = id >> 4, ch = id & 15; *(LAS u32x4*)(Vs + j * 136 + 8 * ch) = R.v[i]; }
}
struct CKvUnit {
    const bf16_t* Z; bf16_t* SC; float* GC; int w0;
    struct Regs { CRegs c; };
    DEVFN Regs load(int unit) const { Regs R; R.c = c_load_common(Z, (unit >> 2) * 64, unit & 3, opaque_tid(w0)); return R; }
    DEVFN void stage(LAS unsigned char* lds, const Regs& R) const { c_stage_common((LAS float*)lds, (LAS bf16_t*)(lds + 65536 + 2 * 64 * 136 * 2), R.c, opaque_tid(w0)); }
    DEVFN void compute(LAS unsigned char* lds, const Regs& R, int unit) const {
        (void)R; const int tid = opaque_tid(w0), lane = tid & 63, w = tid >> 6, c16 = lane & 15, g4 = lane >> 4;
        LAS float* LF = (LAS float*)lds;
        LAS bf16_t* Kx = (LAS bf16_t*)(lds + 65536);
        LAS bf16_t* Vs = (LAS bf16_t*)(lds + 65536 + 2 * 64 * 136 * 2);
        LAS float* tot = (LAS float*)(lds + 65536 + 3 * 64 * 136 * 2);
        {
            const int dir = tid >> 8, half = (tid >> 7) & 1, dk = tid & 127;
            LAS float* lf = LF + (dir * 64 + half * 32) * 128 + dk;
            float run = 0.f;
            if (dir == 0) { for (int j = 31; j >= 0; --j) { const float x = lf[j * 128]; lf[j * 128] = (1.0f - fexp2(x)) * fexp2(run); run += x; } }
            else { for (int j = 0; j < 32; ++j) { const float x = lf[j * 128]; lf[j * 128] = (1.0f - fexp2(x)) * fexp2(run); run += x; } }
            tot[(dir * 2 + half) * 128 + dk] = fexp2(run);
        }
        __syncthreads();
#pragma unroll
        for (int i = 0; i < 4; ++i) {
            const int id = tid + 512 * i, dir = id >> 10, j = (id >> 4) & 63, ch = id & 15, half = j >> 5;
            const LAS float* s = LF + (dir * 64 + j) * 128 + 8 * ch; f32x4 a = *(const LAS f32x4*)s, b = *(const LAS f32x4*)(s + 4);
            if (half == dir) {
                const LAS float* tp = tot + (dir * 2 + (1 - half)) * 128 + 8 * ch; const f32x4 t0 = *(const LAS f32x4*)tp, t1 = *(const LAS f32x4*)(tp + 4);
#pragma unroll
                for (int e = 0; e < 4; ++e) { a[e] *= t0[e]; b[e] *= t1[e]; }
            }
            *(LAS bf16x8*)(Kx + (dir * 64 + j) * 136 + 8 * ch) = pack8(a, b);
        }
        if (tid < 256) { const int dir = tid >> 7, dk = tid & 127; GC[((size_t)unit * 2 + dir) * 128 + dk] = tot[(dir * 2) * 128 + dk] * tot[(dir * 2 + 1) * 128 + dk]; }
        __syncthreads();
#pragma unroll
        for (int dir = 0; dir < 2; ++dir) {
            bf16x8 af[2];
#pragma unroll
            for (int ks = 0; ks < 2; ++ks) af[ks] = tr8(Kx + dir * 64 * 136, 136, 32 * ks, 16 * w, c16, g4);
            bf16_t* dst = SC + ((size_t)unit * 2 + dir) * 16384;
#pragma unroll
            for (int b = 0; b < 8; ++b) {
                f32x4 acc = {0.f, 0.f, 0.f, 0.f};
#pragma unroll
                for (int ks = 0; ks < 2; ++ks) acc = mfma16(af[ks], tr8(Vs, 136, 32 * ks, 16 * b, c16, g4), acc);
                *(u32x2*)(dst + (16 * b + c16) * 128 + 16 * w + 4 * g4) = pk4(acc);
            }
        }
    }
};
struct COutUnit {
    const bf16_t* Z; const bf16_t* SC; bf16_t* MIX; const float* gain; int w0;
    struct Regs { CRegs c; u32x4 qv[4], sf[4], sb[4]; u32x2 gw[4]; f32x4 gn; };
    DEVFN void load1(Regs& R, int unit) const {
        const int tid = opaque_tid(w0), lane = tid & 63, w = tid >> 6, c16 = lane & 15, g4 = lane >> 4; const int h = unit & 3, row0 = (unit >> 2) * 64; R.c = c_load_common(Z, row0, h, tid);
        const size_t row = (size_t)(row0 + 16 * (w & 3) + c16);
#pragma unroll
        for (int ks = 0; ks < 4; ++ks) R.qv[ks] = *(const u32x4*)(Z + zoff(OFF_QC, 128, h, (int)row, 32 * ks + 8 * g4));
    }
    DEVFN void load2(Regs& R, int unit) const {
        const int tid = opaque_tid(w0), lane = tid & 63, w = tid >> 6, c16 = lane & 15, g4 = lane >> 4; const int h = unit & 3, row0 = (unit >> 2) * 64;
        const size_t row = (size_t)(row0 + 16 * (w & 3) + c16);
        const bf16_t* gSf = SC + ((size_t)unit * 2 + 0) * 16384; const bf16_t* gSb = SC + ((size_t)unit * 2 + 1) * 16384;
#pragma unroll
        for (int i = 0; i < 4; ++i) { const int id = tid + 512 * i; R.sf[i] = *(const u32x4*)(gSf + id * 8); R.sb[i] = *(const u32x4*)(gSb + id * 8); }
#pragma unroll
        for (int dd = 0; dd < 4; ++dd) R.gw[dd] = *(const u32x2*)(Z + zoff(OFF_GC, 128, h, (int)row, 16 * (4 * (w >> 2) + dd) + 4 * g4));
        R.gn = (f32x4){gain[h * 128 + (tid & 127)], 0.f, 0.f, 0.f};
    }
    DEVFN void stage(LAS unsigned char* lds, const Regs& R) const { const int tid = opaque_tid(w0); c_stage_common((LAS float*)lds, (LAS bf16_t*)(lds + 65536 + 2 * 64 * 136 * 2), R.c, tid);
        }
    DEVFN void compute(LAS unsigned char* lds, const Regs& R, int unit, Regs& N, int next) const {
        const int tid = opaque_tid(w0), lane = tid & 63, w = tid >> 6, c16 = lane & 15, g4 = lane >> 4;
        const int h = unit & 3, row0 = (unit >> 2) * 64;
        const LAS float* gtab = (const LAS float*)(lds + 65536 + 3 * 64 * 136 * 2 + 2048);
        LAS float* LF = (LAS float*)lds;
        LAS bf16_t* Kx = (LAS bf16_t*)(lds + 65536);
        LAS bf16_t* Vs = (LAS bf16_t*)(lds + 65536 + 2 * 64 * 136 * 2);
        LAS float* bref = (LAS float*)(lds + 65536 + 3 * 64 * 136 * 2);
        LAS float* ssq = bref + 256;
        {
            const int dir = tid >> 8, half = (tid >> 7) & 1, dk = tid & 127;
            LAS float* lf = LF + dir * 64 * 128 + dk; LAS bf16_t* kx = Kx + dir * 64 * 136 + dk;
            float run = 0.f;
            if (dir == 0) {
                if (half == 1) { for (int i = 32; i < 64; ++i) { const float x = lf[i * 128]; run += x; lf[i * 128] = run; kx[i * 136] = (bf16_t)pk2((1.0f - fexp2(x)) * fexp2(-run), 0.f); } }
                else { for (int i = 31; i >= 0; --i) { const float x = lf[i * 128]; lf[i * 128] = run; kx[i * 136] = (bf16_t)pk2((1.0f - fexp2(x)) * fexp2(-run), 0.f); run -= x; } bref[dk] = fexp2(-run); }
            } else {
                if (half == 0) { for (int i = 31; i >= 0; --i) { const float x = lf[i * 128]; run += x; lf[i * 128] = run; kx[i * 136] = (bf16_t)pk2((1.0f - fexp2(x)) * fexp2(-run), 0.f); } }
                else { for (int i = 32; i < 64; ++i) { const float x = lf[i * 128]; lf[i * 128] = run; kx[i * 136] = (bf16_t)pk2((1.0f - fexp2(x)) * fexp2(-run), 0.f); run -= x; } bref[128 + dk] = fexp2(-run); }
            }
        }
        const int it = w & 3, dvh = w >> 2, i = 16 * it + c16; const size_t row = (size_t)(row0 + i);
        __syncthreads();
        bf16x8 Qpf[4], Qpb[4];
#pragma unroll
        for (int ks = 0; ks < 4; ++ks) {
            const int dk0 = 32 * ks + 8 * g4; const u32x4 qv = R.qv[ks];
            f32x4 q0, q1; q0[0] = bflo(qv.x); q0[1] = bfhi(qv.x); q0[2] = bflo(qv.y); q0[3] = bfhi(qv.y); q1[0] = bflo(qv.z); q1[1] = bfhi(qv.z); q1[2] = bflo(qv.w); q1[3] = bfhi(qv.w);
            const f32x4 df0 = *(const LAS f32x4*)(LF + i * 128 + dk0), df1 = *(const LAS f32x4*)(LF + i * 128 + dk0 + 4);
            const f32x4 db0 = *(const LAS f32x4*)(LF + (64 + i) * 128 + dk0), db1 = *(const LAS f32x4*)(LF + (64 + i) * 128 + dk0 + 4);
            f32x4 a0, a1, e0, e1;
#pragma unroll
            for (int j = 0; j < 4; ++j) { a0[j] = q0[j] * fexp2(df0[j]); a1[j] = q1[j] * fexp2(df1[j]); e0[j] = q0[j] * fexp2(db0[j]); e1[j] = q1[j] * fexp2(db1[j]); }
            Qpf[ks] = pack8(a0, a1); Qpb[ks] = pack8(e0, e1);
            EPI_FENCE();
        }
        f32x4 P[4];
#pragma unroll
        for (int jt = 0; jt < 4; ++jt) {
            f32x4 af = {0.f, 0.f, 0.f, 0.f}, ab = {0.f, 0.f, 0.f, 0.f};
#pragma unroll
            for (int ks = 0; ks < 4; ++ks) {
                af = mfma16(*(const LAS bf16x8*)(Kx + (16 * jt + c16) * 136 + 32 * ks + 8 * g4), Qpf[ks], af);
                ab = mfma16(*(const LAS bf16x8*)(Kx + (64 + 16 * jt + c16) * 136 + 32 * ks + 8 * g4), Qpb[ks], ab);
            }
#pragma unroll
            for (int rr = 0; rr < 4; ++rr) { const int j = 16 * jt + 4 * g4 + rr; P[jt][rr] = (j <= i ? af[rr] : 0.f) + (j >= i ? ab[rr] : 0.f); }
        }
        bf16x8 bp[2];
#pragma unroll
        for (int k2 = 0; k2 < 2; ++k2) bp[k2] = pack8(P[2 * k2], P[2 * k2 + 1]);
        LAS bf16_t* Sl = (LAS bf16_t*)lds;
        __syncthreads();
#pragma unroll
        for (int q = 0; q < 4; ++q) { const int id = tid + 512 * q, r = id >> 4, ch = id & 15; const int o = r * 128 + ((ch ^ (r & 15)) * 8);
            *(LAS u32x4*)(Sl + o) = R.sf[q]; *(LAS u32x4*)(Sl + 16384 + o) = R.sb[q]; }
        if (tid < 128) ((LAS float*)(lds + 65536 + 3 * 64 * 136 * 2 + 2048))[tid] = R.gn[0];
        const u32x2 gw0 = R.gw[0], gw1 = R.gw[1], gw2 = R.gw[2], gw3 = R.gw[3];
        load2(N, next);
        __syncthreads();
        bf16x8 Qqf[4], Qqb[4];
#pragma unroll
        for (int ks = 0; ks < 4; ++ks) {
            const int dk0 = 32 * ks + 8 * g4;
            const f32x4 rf0 = *(const LAS f32x4*)(bref + dk0), rf1 = *(const LAS f32x4*)(bref + dk0 + 4), rb0 = *(const LAS f32x4*)(bref + 128 + dk0), rb1 = *(const LAS f32x4*)(bref + 128 + dk0 + 4);
            const u32x4 pf = __builtin_bit_cast(u32x4, Qpf[ks]), pb = __builtin_bit_cast(u32x4, Qpb[ks]);
            f32x4 c0, c1, f0, f1;
            c0[0] = bflo(pf.x) * rf0[0]; c0[1] = bfhi(pf.x) * rf0[1]; c0[2] = bflo(pf.y) * rf0[2]; c0[3] = bfhi(pf.y) * rf0[3];
            c1[0] = bflo(pf.z) * rf1[0]; c1[1] = bfhi(pf.z) * rf1[1]; c1[2] = bflo(pf.w) * rf1[2]; c1[3] = bfhi(pf.w) * rf1[3];
            f0[0] = bflo(pb.x) * rb0[0]; f0[1] = bfhi(pb.x) * rb0[1]; f0[2] = bflo(pb.y) * rb0[2]; f0[3] = bfhi(pb.y) * rb0[3];
            f1[0] = bflo(pb.z) * rb1[0]; f1[1] = bfhi(pb.z) * rb1[1]; f1[2] = bflo(pb.w) * rb1[2]; f1[3] = bfhi(pb.w) * rb1[3];
            Qqf[ks] = pack8(c0, c1); Qqb[ks] = pack8(f0, f1);
        }
        f32x4 o[4]; float s2 = 0.f;
#pragma unroll
        for (int dd = 0; dd < 4; ++dd) {
            const int dvt = 4 * dvh + dd;
            f32x4 acc = {0.f, 0.f, 0.f, 0.f};
#pragma unroll
            for (int k2 = 0; k2 < 2; ++k2) acc = mfma16(tr8p(Vs, 136, 32 * k2, 16 * dvt, c16, g4), bp[k2], acc);
#pragma unroll
            for (int ks = 0; ks < 4; ++ks) {
                const int so = (16 * dvt + c16) * 128 + (((4 * ks + g4) ^ c16) * 8);
                acc = mfma16(*(const LAS bf16x8*)(Sl + so), Qqf[ks], acc);
                acc = mfma16(*(const LAS bf16x8*)(Sl + 16384 + so), Qqb[ks], acc);
            }
            o[dd] = acc; s2 += (acc[0] * acc[0] + acc[1] * acc[1]) + (acc[2] * acc[2] + acc[3] * acc[3]);
            EPI_FENCE();
        }
        s2 += __shfl_xor(s2, 16); s2 += __shfl_xor(s2, 32);
        if (g4 == 0) ssq[w * 16 + c16] = s2;
        __syncthreads();
        const float rinv = 1.0f / sqrtf((ssq[w * 16 + c16] + ssq[(w ^ 4) * 16 + c16]) * (1.0f / 128.0f) + EPS);
#pragma unroll
        for (int dd = 0; dd < 4; ++dd) {
            const int col = h * 128 + 16 * (4 * dvh + dd) + 4 * g4;
            const f32x4 gn = *(const LAS f32x4*)(gtab + 16 * (4 * dvh + dd) + 4 * g4); const u32x2 gw = dd == 0 ? gw0 : (dd == 1 ? gw1 : (dd == 2 ? gw2 : gw3));
            f32x4 v = o[dd] * rinv * gn; v[0] *= bflo(gw.x); v[1] *= bfhi(gw.x); v[2] *= bflo(gw.y); v[3] *= bfhi(gw.y);
            *(u32x2*)(MIX + row * MIXW + 768 + col) = pk4(v);
        }
    }
};

#ifndef CPU_EMU
#define KERNEL_LDS extern __shared__ __attribute__((aligned(16))) unsigned char lds_raw[]; LAS unsigned char* lds = (LAS unsigned char*)lds_raw;
#ifdef VGPR_LIMIT
__attribute__((amdgpu_num_vgpr(VGPR_LIMIT)))
#endif
__global__ void __launch_bounds__(512, 2) fwd_kernel(Args args)
#else
#define KERNEL_LDS unsigned char* lds = emu_lds();
void fwd_kernel(Args args)
#endif
{
    KERNEL_LDS
    const int G = gridDim.x, bx = blockIdx.x;
#ifndef CPU_EMU
    const int w0 = __builtin_amdgcn_readfirstlane((int)threadIdx.x >> 6);
#else
    const int w0 = 0;
#endif
#ifndef CPU_EMU
#define PH_IDS const int tid = opaque_tid(w0), lane = tid & 63, wave = __builtin_amdgcn_readfirstlane(tid >> 6), gw = bx * 8 + wave, gtid = bx * 512 + tid; int Gs_ = G; asm volatile("" : "+s"(Gs_)); const int ngw = Gs_ * 8, nthr = Gs_ * 512; (void)lane; (void)gw; (void)gtid; (void)ngw; (void)nthr;
#else
#define PH_IDS const int tid = opaque_tid(w0), lane = tid & 63, wave = tid >> 6, gw = bx * 8 + wave, gtid = bx * 512 + tid; const int ngw = G * 8, nthr = G * 512; (void)lane; (void)gw; (void)gtid; (void)ngw; (void)nthr;
#endif
#ifndef CPU_EMU
#define OPAQUE_S(p) asm volatile("" : "+s"(p))
#else
#define OPAQUE_S(p)
#endif
#define GAS_ __attribute__((address_space(1)))
#ifndef CPU_EMU
#define PH_PTRS GAS_ unsigned char* ws_g = (GAS_ unsigned char*)args.ws; OPAQUE_S(ws_g); unsigned char* ws = (unsigned char*)ws_g; GAS_ float* h_g = (GAS_ float*)args.out; OPAQUE_S(h_g); float* h = (float*)h_g; PH_PTRS2
#else
#define PH_PTRS unsigned char* ws = args.ws; float* h = args.out; PH_PTRS2
#endif
#define PH_PTRS2 \
    float* rope = (float*)(ws + WS_ROPE); float* biasT = (float*)(ws + WS_BIAS); float* lbs = (float*)(ws + WS_LBS); \
    bf16_t* WB = (bf16_t*)(ws + WS_WB); bf16_t* XN = (bf16_t*)(ws + WS_XN); unsigned char* R = ws + WS_R; bf16_t* ACT = (bf16_t*)(R + R_ACT); \
    bf16_t* Zs = (bf16_t*)(R + R_Z); bf16_t* AO = (bf16_t*)(R + R_AO); float* LSE = (float*)(R + R_LSE); bf16_t* MIX = (bf16_t*)(R + R_MIX); \
    bf16_t* MH = (bf16_t*)(R + R_MH); bf16_t* SB = (bf16_t*)(R + R_SB); bf16_t* SC = (bf16_t*)(R + R_SC); float* GC = (float*)(R + R_GC); \
    bf16_t* PB = (bf16_t*)(ws + WS_PB); bf16_t* SG = (bf16_t*)(R + R_SG); bf16_t* XN2 = (bf16_t*)(ws + WS_XN2); float* SSQ = (float*)(ws + WS_SSQ); \
    (void)h; (void)rope; (void)biasT; (void)lbs; (void)WB; (void)XN; (void)ACT; (void)Zs; (void)AO; (void)LSE; (void)MIX; (void)MH; (void)SB; (void)SC; (void)GC; (void)PB; (void)SG; (void)XN2; (void)SSQ;
    const int lo = args.lo, hi = args.hi;
#ifndef CPU_EMU
    LAS unsigned* misc = (LAS unsigned*)(lds + LDS_BYTES - 64);
    if (threadIdx.x < 4) misc[threadIdx.x] = 0u;
    __syncthreads();
    XcdBarrier bar = xcd_barrier_post((unsigned*)(args.ws + WS_CTL) + 1024, (volatile LAS unsigned*)misc);
#define GRID_BAR() xcd_barrier(bar, w0)
#else
#define GRID_BAR() emu_grid_barrier()
#endif
    int ph = 0;
#ifdef PROBE_PROF
    int cls_ = 0;
    if (bx == 0 && threadIdx.x == 0) { unsigned long long* P = (unsigned long long*)(args.ws + WS_CTL + 65536); P[0] = __builtin_amdgcn_s_memrealtime(); }
#define PH_CLS(k) cls_ = (k);
#define PROF_END() if (bx == 0 && w0 == 0 && lane_id_v() == 0) { unsigned long long* P = (unsigned long long*)(args.ws + WS_CTL + 65536); const unsigned long long now = __builtin_amdgcn_s_memrealtime(); P[2 + cls_] += now - P[0]; P[0] = now; }
#else
#define PH_CLS(k)
#define PROF_END()
#endif
#define PH_OPEN if (ph >= lo && ph < hi) { PH_IDS PH_PTRS
#define PH_CLOSE PROF_END() if (ph + 1 < hi) GRID_BAR(); } ++ph;

    PH_CLS(0)
    PH_OPEN
        prologue_tables(args, rope, biasT, lbs, gtid, nthr);
    PH_CLOSE

    for (int l = 0; l < DEPTH; ++l) {
        PH_CLS(0)
        PH_OPEN
            convert_weights(args, l, WB, lds, gw, ngw, wave, lane);
            cvt_ple(args, l, PB, gtid, nthr);
            if (l == 0) init_rows(args, XN2, SSQ, gw, ngw, lane);
        PH_CLOSE
        for (int half = 0; half < 2; ++half) {
            const int nA = 4 * l + 2 * half;
            for (int q = 0; q <= NFP; ++q) {
            PH_CLS(q == 0 ? 1 : (q == NFP ? 3 : 2))
            PH_OPEN
                for (int step = 0; step < 2; ++step) {
                    if ((step ^ (bx & 1)) == 0) {
                        if (q > 0) {
                            const size_t r0 = (size_t)(q - 1) * TP;
                            pg8::Gemm g{ACT + r0 * FF, WB + (half ? WE_D2 : WE_D1), TP, D, FF, FF, FF}; pg8::StaticOrder S; S.init(TP, D, G, bx);
                            pg8::EpiResAdd E{(half ? XN : XN2) + r0 * D, XN + r0 * D, SSQ + ((size_t)((nA + 1) % 3) * T + r0) * 4, D, 1, lds};
                            pg8::gemm_phase<pg8::EpiResAdd, pg8::StaticOrder>(w0, lds, g, S, E);
                        }
                    } else if (q < NFP) {
                        const size_t r0 = (size_t)q * TP;
                        pg8::Gemm g{(half ? XN : XN2) + r0 * D, WB + (half ? WE_GU2 : WE_GU1), TP, 2 * FF, D, D, D}; pg8::StaticOrder S; S.init(TP, 2 * FF, G, bx);
                        pg8::EpiSwiglu E{ACT + r0 * FF, FF, SSQ + ((size_t)(nA % 3) * T + r0) * 4, lds};
                        pg8::gemm_phase<pg8::EpiSwiglu, pg8::StaticOrder>(w0, lds, g, S, E);
                    }
                }
            PH_CLOSE
            }
            if (half == 0) {
                for (int s = 0; s <= NSLAB; ++s) {
                    const int srow0 = (s < NSLAB ? s : NSLAB - 1) * SLAB; const int S_len = srow0 < NP ? SEQ : DEC_SEQ; const int nseq = SLAB / S_len;
                    PH_CLS(s == 0 ? 4 : (s == NSLAB ? 6 : 5))
                    PH_OPEN
                        for (int step = 0; step < 2; ++step) {
                            if ((step ^ (bx & 1)) == 0) {
                                if (s > 0) {
                                    const int prow0 = (s - 1) * SLAB;
                                    pg8::Gemm g{MH, WB + WE_OUT, SLAB, D, D, D, D}; pg8::StaticOrder S; S.init(SLAB, D, G, bx);
                                    pg8::EpiResAdd E{XN + (size_t)prow0 * D, XN + (size_t)prow0 * D, SSQ + ((size_t)((nA + 2) % 3) * T + prow0) * 4, D, 0, lds};
                                    pg8::gemm_phase<pg8::EpiResAdd, pg8::StaticOrder>(w0, lds, g, S, E);
                                }
                            } else if (s < NSLAB) {
                                pg8::Gemm g{XN + (size_t)srow0 * D, WB + WE_IN, SLAB, ZW, D, D, D}; pg8::StaticOrder S; S.init(SLAB, ZW, G, bx);
                                pg8::EpiInProj E{Zs, rope, rope + 4096 * 64, lbs + l * 512, srow0, SSQ + ((size_t)((nA + 1) % 3) * T + srow0) * 4, lds};
                                pg8::gemm_phase<pg8::EpiInProj, pg8::StaticOrder>(w0, lds, g, S, E);
                            }
                        }
                    PH_CLOSE
                    if (s == NSLAB) break;
                    for (int mrep = 0; mrep < MIXREP; ++mrep) {
                    PH_CLS(7)
                    PH_OPEN
                        {
                            const int nuA = (SLAB / 128) * 12, perA = (nuA + G - 1) / G, a0 = bx * perA, a1 = (bx + 1) * perA < nuA ? (bx + 1) * perA : nuA;
                            const int nuB = (SLAB / 128) * 4, perB = (nuB + G - 1) / G, b0 = bx * perB, b1 = (bx + 1) * perB < nuB ? (bx + 1) * perB : nuB;
                            const int nuC = (SLAB / 64) * 4, perC = (nuC + G - 1) / G, c0 = bx * perC, c1 = (bx + 1) * perC < nuC ? (bx + 1) * perC : nuC;
                            const AUnit UA{Zs, AO, LSE, biasT, S_len, w0}; const BKvUnit UB{Zs, SB, w0}; const CKvUnit UC{Zs, SC, GC, w0};
                            BKvUnit::Regs LB; CKvUnit::Regs LC;
                            run_units_k(lds, UA, a0, a1, UA.load(a0 < nuA ? a0 : nuA - 1), [&] { LB = UB.load(b0 < nuB ? b0 : nuB - 1); });
                            run_units_k(lds, UB, b0, b1, LB, [&] { LC = UC.load(c0 < nuC ? c0 : nuC - 1); });
                            run_units_k(lds, UC, c0, c1, LC, [] {});
                        }
                    PH_CLOSE
                    PH_CLS(8)
                    PH_OPEN
                        mixer_scan(SB, SC, GC, nseq, S_len, gtid, nthr);
                    PH_CLOSE
                    PH_CLS(9)
                    PH_OPEN
                        {
                            const int nuB = (SLAB / 128) * 4, perB = (nuB + G - 1) / G, b0 = bx * perB, b1 = (bx + 1) * perB < nuB ? (bx + 1) * perB : nuB;
                            const int nuC = (SLAB / 64) * 4, perC = (nuC + G - 1) / G, c0 = bx * perC, c1 = (bx + 1) * perC < nuC ? (bx + 1) * perC : nuC;
                            const BOutUnit UB{Zs, SB, MIX, args.in[I_RETN] + l * 512, w0}; const COutUnit UC{Zs, SC, MIX, args.in[I_HGN] + l * 512, w0};
                            const BOutUnit::Regs LB = UB.load(b0 < nuB ? b0 : nuB - 1);
                            mixer_a_merge(AO, LSE, MIX, gtid, nthr);
                            COutUnit::Regs LC;
                            run_units_k(lds, UB, b0, b1, LB, [&] { UC.load1(LC, c0 < nuC ? c0 : nuC - 1); });
                            run_units2_k(lds, UC, c0, c1, LC);
                        }
                    PH_CLOSE
                    }
                    PH_CLS(10)
                    PH_OPEN
                        pg8::Gemm g{MIX, WB + WE_BR, SLAB, D, MIXW, MIXW, MIXW}; pg8::StaticOrder S; S.init(SLAB, D, G, bx);
                        pg8::EpiMerge E{MH, Zs + (size_t)SLAB * OFF_MG, D};
                        pg8::gemm_phase<pg8::EpiMerge, pg8::StaticOrder>(w0, lds, g, S, E);
                    PH_CLOSE
                }
            } else {
                PH_CLS(11)
                PH_OPEN
                    { pg8::Gemm g{XN, WB + WE_PG, T, D, D, D, D}; pg8::StaticOrder S; S.init(T, D, G, bx);
                      pg8::EpiGateBf16 E{SG, D, SSQ + (size_t)((nA + 1) % 3) * T * 4, lds};
                      pg8::gemm_phase<pg8::EpiGateBf16, pg8::StaticOrder>(w0, lds, g, S, E); }
                    { pg8::Gemm g{PB, WB + WE_PP, T, D, D_PLE, D_PLE, D_PLE}; pg8::StaticOrder S; S.init(T, D, G, bx);
                      pg8::EpiPle E{XN, SG, D, XN2, SSQ + (size_t)((nA + 2) % 3) * T * 4, lds};
                      pg8::gemm_phase<pg8::EpiPle, pg8::StaticOrder>(w0, lds, g, S, E); }
                PH_CLOSE
            }
        }
    }
    PH_CLS(12)
    PH_OPEN
#ifdef PROBE_PROF
        { const unsigned long long* P = (const unsigned long long*)(args.ws + WS_CTL + 65536); unsigned long long tot = 0; for (int k = 0; k < 12; ++k) tot += P[2 + k];
          final_norm_rows(XN2, h, args.in[I_FINN], gw, ngw, lane, 1.0f + (float)PROBE_K * (floorf((float)((double)P[2 + PROBE_PROF] / (double)tot) * (float)PROBE_Q + PROBE_OFS) * (1.0f / (float)PROBE_Q))); }
#else
        final_norm_rows(XN2, h, args.in[I_FINN], gw, ngw, lane, 1.0f);
#endif
    PH_CLOSE
#undef PH_OPEN
#undef PH_CLOSE
}

extern "C" void kernel_launch(void* const* d_in, const int* in_sizes, int n_in, void* d_out, int out_size, void* d_ws, size_t ws_size, hipStream_t stream) {
    static int grid = 0;
    if (grid == 0) {
        if (n_in != N_INPUTS || out_size != T * D || ws_size < WS_END) { fprintf(stderr, "kernel_launch: unexpected sizes (n_in %d, out %d, ws %zu, need %zu)\n", n_in, out_size, ws_size, (size_t)WS_END); grid = -1; return; }
        int dev = 0, cus = 0;
        if (hipGetDevice(&dev) != hipSuccess || hipDeviceGetAttribute(&cus, hipDeviceAttributeMultiprocessorCount, dev) != hipSuccess) { grid = -1; return; }
        if (hipFuncSetAttribute((const void*)fwd_kernel, hipFuncAttributeMaxDynamicSharedMemorySize, LDS_BYTES) != hipSuccess) { fprintf(stderr, "kernel_launch: hipFuncSetAttribute failed\n"); grid = -1; return; }
        int per_cu = 0;
        if (hipOccupancyMaxActiveBlocksPerMultiprocessor(&per_cu, (const void*)fwd_kernel, 512, LDS_BYTES) != hipSuccess || per_cu < 1) fprintf(stderr, "kernel_launch: occupancy query reports %d\n", per_cu);
        (void)hipGetLastError();
        grid = cus;
    }
    if (grid < 0) return;
    (void)in_sizes;
    hipMemsetAsync((char*)d_ws + WS_CTL, 0, CTL_BYTES, stream);
    Args a{};
    for (int i = 0; i < N_INPUTS; ++i) a.in[i] = (const float*)d_in[i];
    a.out = (float*)d_out; a.ws = (unsigned char*)d_ws;
#if ONE_LAUNCH
    a.lo = 0; a.hi = NPH;
    hipLaunchKernelGGL(fwd_kernel, dim3(grid), dim3(512), LDS_BYTES, stream, a);
#else
    for (int p = 0; p < NPH; ++p) { a.lo = p; a.hi = p + 1; hipLaunchKernelGGL(fwd_kernel, dim3(grid), dim3(512), LDS_BYTES, stream, a); }
#endif
}
```

```cpp
#ifndef CPU_EMU
#include <hip/hip_runtime.h>
#include <cstdio>
#include <cstdint>
#define LAS __attribute__((address_space(3)))
#define DEVFN __device__ __forceinline__
#define HDFN __host__ __device__ __forceinline__
#define EPI_FENCE() asm volatile("" ::: "memory")
#define OPAQUE_V(x) asm volatile("" : "+v"(x))
#define OPAQUE_V4(x) asm volatile("" : "+v"(x))
#define OPAQUE_SI(x) asm volatile("" : "+s"(x))
#else
#define OPAQUE_SI(x)
#define EPI_FENCE()
#define OPAQUE_V(x)
#define OPAQUE_V4(x)
#endif

#ifdef SMALL_CFG
constexpr int D = 256, FF = 256, BATCH = 2, SEQ = 2048, DEC_BATCH = 1, DEC_SEQ = 4096, DEPTH = 2, SLAB = 4096;
#else
constexpr int D = 1024, FF = 2816, BATCH = 32, SEQ = 2048, DEC_BATCH = 8, DEC_SEQ = 4096, DEPTH = 4, SLAB = 16384;
#endif
#ifndef ONE_LAUNCH
#define ONE_LAUNCH 1
#endif
constexpr int NP = BATCH * SEQ, NS = DEC_BATCH * DEC_SEQ, T = NP + NS, NSLAB = T / SLAB;
constexpr int D_PLE = 256, N_IN = 6912, ZW = N_IN + 3 * D, MIXW = 1280, AOW = 768;
constexpr int OFF_QA = 0, OFF_KA = 768, OFF_VA = 1536, OFF_QB = 2304, OFF_KB = 2816, OFF_VB = 3328, OFF_GB = 3840, OFF_QC = 4352, OFF_FCF = 4864, OFF_IC = 5888, OFF_GC = 6400, OFF_MG = 6912;
constexpr float EPS = 1e-6f;
static_assert((SEQ & (SEQ - 1)) == 0 && (DEC_SEQ & (DEC_SEQ - 1)) == 0 && SEQ >= 128 && DEC_SEQ >= 128, "sequence lengths: powers of two (mixer A decodes its unit index with shifts)");
static_assert(NP % SLAB == 0 && NS % SLAB == 0 && SLAB % SEQ == 0 && SLAB % DEC_SEQ == 0 && T % 256 == 0 && (2 * FF) % 256 == 0 && FF % 128 == 0 && D % 256 == 0, "shape");

constexpr size_t MiB = 1u << 20;
constexpr size_t al(size_t x) { return (x + 255) & ~(size_t)255; }
constexpr size_t WS_CTL = 0, CTL_BYTES = 1 * MiB;
constexpr size_t WS_ROPE = WS_CTL + CTL_BYTES;
constexpr size_t WS_BIAS = WS_ROPE + 2 * MiB;
constexpr size_t WS_LBS = WS_BIAS + 16384;
constexpr size_t WS_WB = WS_LBS + 16384;
constexpr size_t WE_GU1 = 0, WE_D1 = WE_GU1 + (size_t)2 * FF * D, WE_IN = WE_D1 + (size_t)D * FF, WE_BR = WE_IN + (size_t)ZW * D, WE_OUT = WE_BR + (size_t)D * MIXW,
                 WE_GU2 = WE_OUT + (size_t)D * D, WE_D2 = WE_GU2 + (size_t)2 * FF * D, WE_PG = WE_D2 + (size_t)D * FF, WE_PP = WE_PG + (size_t)D * D, WE_END = WE_PP + (size_t)D * D_PLE;
constexpr size_t WS_XN = al(WS_WB + WE_END * 2);
constexpr size_t WS_XN2 = al(WS_XN + (size_t)T * D * 2);
constexpr size_t WS_SSQ = al(WS_XN2 + (size_t)T * D * 2);
constexpr size_t WS_PB = al(WS_SSQ + (size_t)3 * T * 16);
constexpr size_t WS_R = al(WS_PB + (size_t)T * D_PLE * 2);
constexpr size_t R_ACT = 0, R_ACT_END = (size_t)T * FF * 2;
constexpr size_t R_Z = 0, R_AO = al(R_Z + (size_t)SLAB * ZW * 2), R_LSE = al(R_AO + (size_t)SLAB * AOW * 2), R_MIX = al(R_LSE + (size_t)SLAB * 12 * 4),
                 R_MH = al(R_MIX + (size_t)SLAB * MIXW * 2), R_SB = al(R_MH + (size_t)SLAB * D * 2),
                 R_SC = al(R_SB + (size_t)(SLAB / 128) * 4 * 2 * 16384 * 2), R_GC = al(R_SC + (size_t)(SLAB / 64) * 4 * 2 * 16384 * 2), R_MIX_END = al(R_GC + (size_t)(SLAB / 64) * 4 * 2 * 128 * 4);
constexpr size_t R_SG = 0, R_PLE_END = al(R_SG + (size_t)T * D * 2);
constexpr size_t cmax(size_t a, size_t b) { return a > b ? a : b; }
constexpr size_t WS_END = WS_R + cmax(cmax(R_ACT_END, R_MIX_END), R_PLE_END);
constexpr int LDS_BYTES = 147456;
#ifndef MIXREP
#define MIXREP 1
#endif
#ifndef REP_A
#define REP_A 1
#endif
#ifndef REP_KV
#define REP_KV 1
#endif
#ifndef REP_OUT
#define REP_OUT 1
#endif
constexpr int NFP = (T % 768 == 0) ? 3 : 2, TP = T / NFP;
static_assert(TP % 256 == 0, "FFN parts");
constexpr int NPH = 2 + DEPTH * (2 + 2 * (NFP + 1) + (NSLAB + 1) + NSLAB * (1 + 3 * MIXREP));

typedef unsigned short bf16_t;
typedef short bf16x8 __attribute__((ext_vector_type(8)));
typedef short s16x4 __attribute__((ext_vector_type(4)));
typedef float f32x4 __attribute__((ext_vector_type(4)));
typedef unsigned u32x4 __attribute__((ext_vector_type(4)));
typedef unsigned u32x2 __attribute__((ext_vector_type(2)));

#ifndef CPU_EMU
DEVFN int lane_id_v() { int l; asm volatile("v_mbcnt_lo_u32_b32 %0, -1, 0\n\tv_mbcnt_hi_u32_b32 %0, -1, %0" : "=v"(l)); return l; }
DEVFN int opaque_tid(int w0) { return w0 * 64 + lane_id_v(); }
#else
DEVFN int opaque_tid(int) { return threadIdx.x; }
#endif
DEVFN unsigned f2bf(float f) { unsigned u = __builtin_bit_cast(unsigned, f); return (u + 0x7fffu + ((u >> 16) & 1u)) >> 16; }
#ifndef CPU_EMU
typedef float f32x2_t __attribute__((ext_vector_type(2)));
typedef __bf16 bf16x2_t __attribute__((ext_vector_type(2)));
DEVFN unsigned pk2(float lo, float hi) { const f32x2_t v = {lo, hi}; return __builtin_bit_cast(unsigned, __builtin_convertvector(v, bf16x2_t)); }
#else
DEVFN unsigned pk2(float lo, float hi) { return f2bf(lo) | (f2bf(hi) << 16); }
#endif
DEVFN float bf2f(unsigned b) { return __builtin_bit_cast(float, b << 16); }
DEVFN float bflo(unsigned w) { return __builtin_bit_cast(float, w << 16); }
DEVFN float bfhi(unsigned w) { return __builtin_bit_cast(float, w & 0xffff0000u); }
DEVFN unsigned f2h(float f) { _Float16 h = (_Float16)f; return (unsigned)__builtin_bit_cast(unsigned short, h); }
DEVFN float h2f(unsigned b) { return (float)__builtin_bit_cast(_Float16, (unsigned short)b); }
DEVFN u32x2 pk4(f32x4 v) { u32x2 r; r.x = pk2(v[0], v[1]); r.y = pk2(v[2], v[3]); return r; }
#ifndef CPU_EMU
DEVFN f32x4 mfma16(bf16x8 a, bf16x8 b, f32x4 c) { return __builtin_amdgcn_mfma_f32_16x16x32_bf16(a, b, c, 0, 0, 0); }
DEVFN float fexp(float x) { return __expf(x); }
DEVFN float fexp2(float x) { return __builtin_amdgcn_exp2f(x); }
DEVFN float flog2(float x) { return __builtin_amdgcn_logf(x); }
DEVFN float frsq(float x) { return __builtin_amdgcn_rsqf(x); }
DEVFN float flog(float x) { return __logf(x); }
DEVFN float frcp(float x) { return __builtin_amdgcn_rcpf(x); }
#else
f32x4 mfma16(bf16x8 a, bf16x8 b, f32x4 c);
DEVFN float fexp(float x) { return expf(x); }
DEVFN float fexp2(float x) { return exp2f(x); }
DEVFN float flog2(float x) { return log2f(x); }
DEVFN float frsq(float x) { return 1.0f / sqrtf(x); }
DEVFN float flog(float x) { return logf(x); }
DEVFN float frcp(float x) { return 1.0f / x; }
#endif
#ifndef CPU_EMU
DEVFN float rms_rinv(float ssq) { return __builtin_amdgcn_rsqf(ssq * (1.0f / D) + EPS); }
#else
DEVFN float rms_rinv(float ssq) { return 1.0f / sqrtf(ssq * (1.0f / D) + EPS); }
#endif
DEVFN float row_rinv(const float* ssqp, unsigned row) { const f32x4 q = *(const f32x4*)(ssqp + 4 * row); float t = q[0]; if (D >= 512) t += q[1]; if (D >= 768) t += q[2]; if (D >= 1024) t += q[3]; return rms_rinv(t); }
#ifndef CPU_EMU
#define EPI_BARRIER() do { asm volatile("s_waitcnt lgkmcnt(0)" ::: "memory"); __builtin_amdgcn_s_barrier(); asm volatile("" ::: "memory"); } while (0)
#else
#define EPI_BARRIER() __syncthreads()
#endif
constexpr int EPI_RED_OFF = 131072;
constexpr int EPI_RINV_OFF = EPI_RED_OFF + 4096;
DEVFN void rinv_pre(const float* ssqp, LAS unsigned char* lds, int pm, int par, int tid) {
#ifndef CPU_EMU
    asm volatile("" : "+v"(tid));
    const int wv = __builtin_amdgcn_readfirstlane(tid >> 6);
    if (wv < 4) __builtin_amdgcn_global_load_lds((const unsigned*)(ssqp + 4 * (unsigned)(pm * 256 + tid)), (LAS unsigned*)(lds + EPI_RINV_OFF + par * 4096 + wv * 1024), 16, 0, 0);
#else
    if (tid < 256) *(f32x4*)(lds + EPI_RINV_OFF + par * 4096 + tid * 16) = *(const f32x4*)(ssqp + 4 * (unsigned)(pm * 256 + tid));
#endif
}
DEVFN float rinv_get(const LAS unsigned char* lds, int par, int r) { const f32x4 q = *(const LAS f32x4*)(lds + EPI_RINV_OFF + par * 4096 + r * 16); float t = q[0]; if (D >= 512) t += q[1]; if (D >= 768) t += q[2]; if (D >= 1024) t += q[3]; return rms_rinv(t); }
#ifndef CPU_EMU
DEVFN f32x4 swiglu4(f32x4 g, f32x4 u, float ri2, float nl) {
    const f32x4 t = g * nl; f32x4 e; e[0] = __builtin_amdgcn_exp2f(t[0]); e[1] = __builtin_amdgcn_exp2f(t[1]); e[2] = __builtin_amdgcn_exp2f(t[2]); e[3] = __builtin_amdgcn_exp2f(t[3]);
    const f32x4 d = e + 1.0f; f32x4 r; r[0] = __builtin_amdgcn_rcpf(d[0]); r[1] = __builtin_amdgcn_rcpf(d[1]); r[2] = __builtin_amdgcn_rcpf(d[2]); r[3] = __builtin_amdgcn_rcpf(d[3]);
    return (g * u) * (r * ri2);
}
#else
DEVFN f32x4 swiglu4(f32x4 g, f32x4 u, float ri2, float nl) { f32x4 o; for (int j = 0; j < 4; ++j) o[j] = (g[j] * u[j]) * ri2 / (1.0f + exp2f(g[j] * nl)); return o; }
#endif
DEVFN float fsigmoid(float x) { return frcp(1.0f + fexp(-x)); }
DEVFN float fsilu(float x) { return x * fsigmoid(x); }
DEVFN bf16x8 cat8(s16x4 lo, s16x4 hi) { return __builtin_shufflevector(lo, hi, 0, 1, 2, 3, 4, 5, 6, 7); }
DEVFN bf16x8 pack8(f32x4 a, f32x4 b) { u32x4 w; w.x = pk2(a[0], a[1]); w.y = pk2(a[2], a[3]); w.z = pk2(b[0], b[1]); w.w = pk2(b[2], b[3]); return __builtin_bit_cast(bf16x8, w); }
DEVFN unsigned zoff(int sec, int hd, int head, int row, int d) { return (unsigned)SLAB * (unsigned)sec + ((unsigned)head * (unsigned)SLAB + (unsigned)row) * (unsigned)hd + (unsigned)d; }
DEVFN int pos_of(int row) { return row < NP ? (row & (SEQ - 1)) : ((row - NP) & (DEC_SEQ - 1)); }
DEVFN float ret_l2(int dir, int h) {
    return dir ? (h == 0 ? -0.03223685441264423f : h == 1 ? -0.01602838797991282f : h == 2 ? -0.007991934616642016f : -0.003990433313311714f)
               : (h == 0 ? -0.04580368961312479f : h == 1 ? -0.02272007650008353f : h == 2 ? -0.011315313227834146f : -0.005646563141142063f);
}

namespace pg8 {
constexpr int BM = 256, BK = 64, HALF = 128, HTB = HALF * BK * 2, STAGE_BYTES = 8 * HTB, NXCD = 8, WGM = 8;
HDFN int lds_byte(int r, int c) { const int st = (r >> 4) * 2 + (c >> 5), rr = r & 15, cc = c & 31, ob = rr * 64 + cc * 2; return st * 1024 + (ob ^ (((ob >> 9) & 1) << 5)); }
HDFN void stage_rc(int b, int& R, int& C) { const int st = b / 1024, sb = b % 1024, swz = sb ^ (((sb >> 9) & 1) << 5); R = (st >> 1) * 16 + swz / 64; C = (st & 1) * 32 + (swz % 64) / 2; }
HDFN int perm32(int rho) { const int n = rho >> 4, i = rho & 15; return 8 * (i >> 2) + 4 * n + (i & 3); }
struct Unit { int pm, pn; };
struct Gemm { const bf16_t* A; const bf16_t* Bt; int M, N, K, lda, ldb; };
struct StaticOrder {
    int nM, nN, nwg, G, c;
    HDFN void init(int M, int N, int G_, int c_) { nM = M / BM; nN = N / BM; nwg = nM * nN; G = G_; c = c_; }
    HDFN bool next(int i, Unit& u) const {
        const long L = (long)i * G + c; if (L >= nwg) return false;
        int wgid = (int)L; { const int q = nwg / NXCD, r = nwg % NXCD, xcd = wgid % NXCD, off = wgid / NXCD; wgid = (xcd < r ? xcd * (q + 1) : r * (q + 1) + (xcd - r) * q) + off; }
        const int nig = WGM * nN, gid = wgid / nig, fm = gid * WGM, gsz = (nM - fm) < WGM ? (nM - fm) : WGM;
        u.pm = fm + ((wgid % nig) % gsz); u.pn = (wgid % nig) / gsz; return true;
    }
    DEVFN void a_ready(const Unit&) const {}
    DEVFN void done(const Unit&) const {}
};

struct EpiSwiglu {
    static constexpr bool PERM = true, MIDK = false;
    bf16_t* O; int ldc; const float* ssq; LAS unsigned char* lds;
    DEVFN void pre(const Unit& u, int par, int tid) const { rinv_pre(ssq, lds, u.pm, par, tid); }
    DEVFN void operator()(const f32x4 (&acc)[2][2][4][2], const Unit& u, int wr, int wc, int fr, int fq, int par) const {
        const int row0 = u.pm * BM + wr * 64 + fr, col0 = u.pn * HALF + wc * 32 + 8 * fq;
#pragma unroll
        for (int ai = 0; ai < 2; ++ai)
#pragma unroll
            for (int m = 0; m < 4; ++m) {
                bf16_t* rowp = O + (size_t)(row0 + ai * HALF + m * 16) * ldc + col0;
                const float ri = rinv_get(lds, par, ai * HALF + wr * 64 + m * 16 + fr);
                const float ri2 = ri * ri, nl = ri * -1.4426950408889634f;
                f32x4 a = swiglu4(acc[ai][0][m][0], acc[ai][1][m][0], ri2, nl), b = swiglu4(acc[ai][0][m][1], acc[ai][1][m][1], ri2, nl);
                u32x4 w; w.x = pk2(a[0], a[1]); w.y = pk2(a[2], a[3]); w.z = pk2(b[0], b[1]); w.w = pk2(b[2], b[3]);
                *(u32x4*)rowp = w; EPI_FENCE();
            }
    }
};
struct EpiResAdd {
    static constexpr bool PERM = false, MIDK = false;
    const bf16_t* Hs; bf16_t* Hd; float* ssq; int ldc; int halve; LAS unsigned char* lds;
    DEVFN void pre(const Unit&, int, int) const {}
    DEVFN void operator()(const f32x4 (&acc)[2][2][4][2], const Unit& u, int wr, int wc, int fr, int fq, int) const {
        const int row0 = u.pm * BM + wr * 64 + fr, col0 = u.pn * BM + wc * 32 + 4 * fq;
        int frq = fr; OPAQUE_V(frq);
        const float scale = halve ? 0.5f : 1.0f; const f32x4 sc4 = {scale, scale, scale, scale};
        u32x2 res[2][4][2][2];
#pragma unroll
        for (int ai = 0; ai < 2; ++ai) {
            u32x2 hv[4][2][2];
#pragma unroll
            for (int m = 0; m < 4; ++m) { const unsigned off = (unsigned)(row0 + ai * HALF + m * 16) * (unsigned)ldc + (unsigned)col0;
#pragma unroll
                for (int bj = 0; bj < 2; ++bj)
#pragma unroll
                    for (int n = 0; n < 2; ++n) hv[m][bj][n] = *(const u32x2*)(Hs + (off + bj * HALF + n * 16)); }
            EPI_FENCE();
#pragma unroll
            for (int m = 0; m < 4; ++m) { float part = 0.f;
#pragma unroll
                for (int bj = 0; bj < 2; ++bj)
#pragma unroll
                    for (int n = 0; n < 2; ++n) { const u32x2 hw = hv[m][bj][n]; f32x4 v = acc[ai][bj][m][n] * sc4; v[0] += bflo(hw.x); v[1] += bfhi(hw.x); v[2] += bflo(hw.y); v[3] += bfhi(hw.y);
                        const u32x2 o = pk4(v); res[ai][m][bj][n] = o;
                        const float r0 = bflo(o.x), r1 = bfhi(o.x), r2 = bflo(o.y), r3 = bfhi(o.y); part += (r0 * r0 + r1 * r1) + (r2 * r2 + r3 * r3); }
                part += __shfl_xor(part, 16); part += __shfl_xor(part, 32);
                if (fq == 0) ((LAS float*)(lds + EPI_RED_OFF))[(ai * HALF + wr * 64 + m * 16 + frq) * 4 + wc] = part; }
            EPI_FENCE();
        }
#pragma unroll
        for (int ai = 0; ai < 2; ++ai)
#pragma unroll
            for (int m = 0; m < 4; ++m) { const unsigned off = (unsigned)(row0 + ai * HALF + m * 16) * (unsigned)ldc + (unsigned)col0;
#pragma unroll
                for (int bj = 0; bj < 2; ++bj)
#pragma unroll
                    for (int n = 0; n < 2; ++n) *(u32x2*)(Hd + (off + bj * HALF + n * 16)) = res[ai][m][bj][n]; }
        EPI_BARRIER();
        { int t = wr * 256 + wc * 64 + fq * 16 + fr; OPAQUE_V(t); if (t < 256) { const f32x4 q = *(const LAS f32x4*)(lds + EPI_RED_OFF + t * 16); ssq[(size_t)(u.pm * BM + t) * 4 + u.pn] = (q[0] + q[1]) + (q[2] + q[3]); } }
    }
};
struct EpiGateBf16 {
    static constexpr bool PERM = false, MIDK = false;
    bf16_t* SG; int ldc; const float* ssq; LAS unsigned char* lds;
    DEVFN void pre(const Unit& u, int par, int tid) const { rinv_pre(ssq, lds, u.pm, par, tid); }
    DEVFN void operator()(const f32x4 (&acc)[2][2][4][2], const Unit& u, int wr, int wc, int fr, int fq, int par) const {
        const int row0 = u.pm * BM + wr * 64 + fr, col0 = u.pn * BM + wc * 32 + 4 * fq;
#pragma unroll
        for (int ai = 0; ai < 2; ++ai)
#pragma unroll
            for (int m = 0; m < 4; ++m) { const unsigned off = (unsigned)(row0 + ai * HALF + m * 16) * (unsigned)ldc + (unsigned)col0; const float ri = rinv_get(lds, par, ai * HALF + wr * 64 + m * 16 + fr);
#pragma unroll
                for (int bj = 0; bj < 2; ++bj)
#pragma unroll
                    for (int n = 0; n < 2; ++n) { f32x4 v = acc[ai][bj][m][n];
#pragma unroll
                        for (int j = 0; j < 4; ++j) v[j] = fsigmoid(v[j] * ri);
                        *(u32x2*)(SG + (off + bj * HALF + n * 16)) = pk4(v); }
                EPI_FENCE(); }
    }
};
struct EpiPle {
    static constexpr bool PERM = false, MIDK = false;
    const bf16_t* Hs; const bf16_t* SG; int ldc; bf16_t* Hd; float* ssq_out; LAS unsigned char* lds;
    DEVFN void pre(const Unit&, int, int) const {}
    DEVFN void operator()(const f32x4 (&acc)[2][2][4][2], const Unit& u, int wr, int wc, int fr, int fq, int) const {
        const int row0 = u.pm * BM + wr * 64 + fr, col0 = u.pn * BM + wc * 32 + 4 * fq;
        int frq = fr; OPAQUE_V(frq);
        u32x2 res[2][4][2][2];
#pragma unroll
        for (int ai = 0; ai < 2; ++ai)
#pragma unroll
            for (int mp = 0; mp < 2; ++mp) {
                u32x2 hv[2][2][2], gv[2][2][2];
#pragma unroll
                for (int m2 = 0; m2 < 2; ++m2) { const unsigned ro = (unsigned)(row0 + ai * HALF + (2 * mp + m2) * 16) * (unsigned)ldc + (unsigned)col0;
#pragma unroll
                    for (int bj = 0; bj < 2; ++bj)
#pragma unroll
                        for (int n = 0; n < 2; ++n) { hv[m2][bj][n] = *(const u32x2*)(Hs + (ro + bj * HALF + n * 16)); gv[m2][bj][n] = *(const u32x2*)(SG + (ro + bj * HALF + n * 16)); } }
                EPI_FENCE();
#pragma unroll
                for (int m2 = 0; m2 < 2; ++m2) { const int m = 2 * mp + m2; float part = 0.f;
#pragma unroll
                    for (int bj = 0; bj < 2; ++bj)
#pragma unroll
                        for (int n = 0; n < 2; ++n) { const f32x4 a = acc[ai][bj][m][n]; const u32x2 gw = gv[m2][bj][n], hw = hv[m2][bj][n]; f32x4 v;
                            v[0] = bflo(hw.x) + bflo(gw.x) * a[0]; v[1] = bfhi(hw.x) + bfhi(gw.x) * a[1]; v[2] = bflo(hw.y) + bflo(gw.y) * a[2]; v[3] = bfhi(hw.y) + bfhi(gw.y) * a[3];
                            const u32x2 o = pk4(v); res[ai][m][bj][n] = o;
                            const float r0 = bflo(o.x), r1 = bfhi(o.x), r2 = bflo(o.y), r3 = bfhi(o.y); part += (r0 * r0 + r1 * r1) + (r2 * r2 + r3 * r3); }
                    part += __shfl_xor(part, 16); part += __shfl_xor(part, 32);
                    if (fq == 0) ((LAS float*)(lds + EPI_RED_OFF))[(ai * HALF + wr * 64 + m * 16 + frq) * 4 + wc] = part; }
                EPI_FENCE();
            }
#pragma unroll
        for (int ai = 0; ai < 2; ++ai)
#pragma unroll
            for (int m = 0; m < 4; ++m) { const unsigned ro = (unsigned)(row0 + ai * HALF + m * 16) * (unsigned)ldc + (unsigned)col0;
#pragma unroll
                for (int bj = 0; bj < 2; ++bj)
#pragma unroll
                    for (int n = 0; n < 2; ++n) *(u32x2*)(Hd + (ro + bj * HALF + n * 16)) = res[ai][m][bj][n]; }
        EPI_BARRIER();
        { int t = wr * 256 + wc * 64 + fq * 16 + fr; OPAQUE_V(t); if (t < 256) { const f32x4 q = *(const LAS f32x4*)(lds + EPI_RED_OFF + t * 16); ssq_out[(size_t)(u.pm * BM + t) * 4 + u.pn] = (q[0] + q[1]) + (q[2] + q[3]); } }
    }
};
struct EpiMerge {
    static constexpr bool PERM = true, MIDK = true;
    bf16_t* MH; const bf16_t* G; int ldg;
    DEVFN void pre(const Unit&, int, int) const {}
    DEVFN void gate8(unsigned off, f32x4& g0, f32x4& g1) const { unpack8(*(const u32x4*)(G + off), g0, g1); }
    DEVFN void unpack8(u32x4 w, f32x4& g0, f32x4& g1) const {
        g0[0] = fmaxf(bflo(w.x), 1e-30f); g0[1] = fmaxf(bfhi(w.x), 1e-30f); g0[2] = fmaxf(bflo(w.y), 1e-30f); g0[3] = fmaxf(bfhi(w.y), 1e-30f);
        g1[0] = fmaxf(bflo(w.z), 1e-30f); g1[1] = fmaxf(bfhi(w.z), 1e-30f); g1[2] = fmaxf(bflo(w.w), 1e-30f); g1[3] = fmaxf(bfhi(w.w), 1e-30f); }
    DEVFN void mid(f32x4 (&acc)[2][2][4][2], const Unit& u, int wr, int wc, int fr, int fq, int x) const {
        OPAQUE_V(fr); OPAQUE_V(fq);
        const int row0 = u.pm * BM + wr * 64 + fr; const unsigned col0 = (unsigned)(u.pn * BM + wc * 32 + 8 * fq) + (unsigned)x * (unsigned)(SLAB * D);
#pragma unroll
        for (int ai = 0; ai < 2; ++ai) {
            u32x4 gn[4][2], gd[4][2];
#pragma unroll
            for (int m = 0; m < 4; ++m) { const unsigned off = (unsigned)(row0 + ai * HALF + m * 16) * (unsigned)ldg + col0;
#pragma unroll
                for (int bj = 0; bj < 2; ++bj) { gn[m][bj] = *(const u32x4*)(G + (off + bj * HALF)); gd[m][bj] = *(const u32x4*)(G + (off + (unsigned)(SLAB * D) + bj * HALF)); } }
            EPI_FENCE();
#pragma unroll
            for (int m = 0; m < 4; ++m)
#pragma unroll
                for (int bj = 0; bj < 2; ++bj) { f32x4 n0, n1, d0, d1; unpack8(gn[m][bj], n0, n1); unpack8(gd[m][bj], d0, d1);
#pragma unroll
                    for (int j = 0; j < 4; ++j) { acc[ai][bj][m][0][j] *= n0[j] * frcp(d0[j]); acc[ai][bj][m][1][j] *= n1[j] * frcp(d1[j]); } }
            EPI_FENCE();
        }
    }
    DEVFN void operator()(const f32x4 (&acc)[2][2][4][2], const Unit& u, int wr, int wc, int fr, int fq, int) const {
        OPAQUE_V(fr); OPAQUE_V(fq);
        const int row0 = u.pm * BM + wr * 64 + fr, col0 = u.pn * BM + wc * 32 + 8 * fq;
        u32x4 res[2][4][2];
#pragma unroll
        for (int ai = 0; ai < 2; ++ai) {
            u32x4 gc[4][2];
#pragma unroll
            for (int m = 0; m < 4; ++m)
#pragma unroll
                for (int bj = 0; bj < 2; ++bj) gc[m][bj] = *(const u32x4*)(G + ((unsigned)(row0 + ai * HALF + m * 16) * (unsigned)ldg + 2u * (unsigned)(SLAB * D) + col0 + bj * HALF));
            EPI_FENCE();
#pragma unroll
            for (int m = 0; m < 4; ++m)
#pragma unroll
                for (int bj = 0; bj < 2; ++bj) { f32x4 g0, g1; unpack8(gc[m][bj], g0, g1);
                    const f32x4 v0 = acc[ai][bj][m][0] * g0, v1 = acc[ai][bj][m][1] * g1;
                    u32x4 w; w.x = pk2(v0[0], v0[1]); w.y = pk2(v0[2], v0[3]); w.z = pk2(v1[0], v1[1]); w.w = pk2(v1[2], v1[3]); res[ai][m][bj] = w; }
            EPI_FENCE();
        }
#pragma unroll
        for (int ai = 0; ai < 2; ++ai)
#pragma unroll
            for (int m = 0; m < 4; ++m) { const unsigned row = (unsigned)(row0 + ai * HALF + m * 16);
#pragma unroll
                for (int bj = 0; bj < 2; ++bj) *(u32x4*)(MH + row * (unsigned)D + col0 + bj * HALF) = res[ai][m][bj]; }
    }
};
struct EpiInProj {
    static constexpr bool PERM = true, MIDK = false;
    bf16_t* O; const float* cosT; const float* sinT; const float* lb; int row_base; const float* ssq; LAS unsigned char* lds;
    DEVFN void pre(const Unit& u, int par, int tid) const { rinv_pre(ssq, lds, u.pm, par, tid); }
    DEVFN unsigned zdst(int cb, int cw, int row) const {
        if (cb < OFF_QB) { const int sec = (cb / 768) * 768; return zoff(sec, 64, (cb - sec) / 64 + (cw >> 6), row, cw & 63); }
        if (cb < OFF_MG) { const int sec = OFF_QB + ((cb - OFF_QB) / 512) * 512; return zoff(sec, 128, (cb - sec) / 128, row, cw); }
        const int x = (cb - OFF_MG) / D, c = (cb - OFF_MG) % D; return (unsigned)SLAB * (unsigned)OFF_MG + (unsigned)x * (unsigned)(SLAB * D) + (unsigned)row * (unsigned)D + (unsigned)(c + cw);
    }
    DEVFN void store8(int cb, int cw, int row, f32x4 v0, f32x4 v1) const { u32x4 w; w.x = pk2(v0[0], v0[1]); w.y = pk2(v0[2], v0[3]); w.z = pk2(v1[0], v1[1]); w.w = pk2(v1[2], v1[3]); *(u32x4*)(O + zdst(cb, cw, row)) = w; }
    DEVFN void operator()(const f32x4 (&acc)[2][2][4][2], const Unit& u, int wr, int wc, int fr, int fq, int par) const {
        const int pn = u.pn;
        const int mode = pn < 9 ? 0 : pn < 13 ? 1 : pn < 15 ? 0 : pn < 19 ? 2 : pn < 23 ? 3 : pn < 25 ? 0 : pn < 27 ? 2 : 4;
        int cw = wc * 32 + 8 * fq; OPAQUE_V(cw);
        const int row0 = u.pm * BM + wr * 64 + fr, col0 = pn * BM + cw;
        if (mode == 1) {
#pragma unroll
            for (int ai = 0; ai < 2; ++ai) {
                f32x4 cq[4], sq[4];
#pragma unroll
                for (int m = 0; m < 4; ++m) { const int pos = pos_of(row_base + row0 + ai * HALF + m * 16); cq[m] = *(const f32x4*)(cosT + pos * 64 + 4 * (4 * wc + fq)); sq[m] = *(const f32x4*)(sinT + pos * 64 + 4 * (4 * wc + fq)); }
                EPI_FENCE();
#pragma unroll
                for (int m = 0; m < 4; ++m) { const int row = row0 + ai * HALF + m * 16; const float ri = rinv_get(lds, par, ai * HALF + wr * 64 + m * 16 + fr); const f32x4 c4 = cq[m], s4 = sq[m];
#pragma unroll
                    for (int bj = 0; bj < 2; ++bj) { const f32x4 v0 = acc[ai][bj][m][0] * ri, v1 = acc[ai][bj][m][1] * ri; store8(pn * BM + bj * HALF, cw, row, v0 * c4 - v1 * s4, v0 * s4 + v1 * c4); } }
                EPI_FENCE();
            }
        } else if (mode == 3) {
            f32x4 lbv[2][2];
#pragma unroll
            for (int bj = 0; bj < 2; ++bj) { const int lc = (col0 + bj * HALF - OFF_FCF) & 511; lbv[bj][0] = *(const f32x4*)(lb + lc); lbv[bj][1] = *(const f32x4*)(lb + lc + 4); }
            EPI_FENCE();
#pragma unroll
            for (int ai = 0; ai < 2; ++ai)
#pragma unroll
                for (int m = 0; m < 4; ++m) { const int row = row0 + ai * HALF + m * 16; const float ri = rinv_get(lds, par, ai * HALF + wr * 64 + m * 16 + fr);
#pragma unroll
                    for (int bj = 0; bj < 2; ++bj) { f32x4 v0 = acc[ai][bj][m][0] * ri, v1 = acc[ai][bj][m][1] * ri; const f32x4 l0 = lbv[bj][0], l1 = lbv[bj][1];
#pragma unroll
                        for (int j = 0; j < 4; ++j) { v0[j] = fmaxf(flog2(l0[j] + (1.f - l0[j]) * fsigmoid(v0[j])), -43.28f); v1[j] = fmaxf(flog2(l1[j] + (1.f - l1[j]) * fsigmoid(v1[j])), -43.28f); }
                        u32x4 w; w.x = f2h(v0[0]) | (f2h(v0[1]) << 16); w.y = f2h(v0[2]) | (f2h(v0[3]) << 16); w.z = f2h(v1[0]) | (f2h(v1[1]) << 16); w.w = f2h(v1[2]) | (f2h(v1[3]) << 16);
                        *(u32x4*)(O + zdst(pn * BM + bj * HALF, cw, row)) = w; } }
        } else {
#pragma unroll
            for (int ai = 0; ai < 2; ++ai)
#pragma unroll
                for (int m = 0; m < 4; ++m) { const int row = row0 + ai * HALF + m * 16; const float ri = rinv_get(lds, par, ai * HALF + wr * 64 + m * 16 + fr);
#pragma unroll
                    for (int bj = 0; bj < 2; ++bj) { f32x4 v0 = acc[ai][bj][m][0] * ri, v1 = acc[ai][bj][m][1] * ri;
                        if (mode == 2) {
#pragma unroll
                            for (int j = 0; j < 4; ++j) { v0[j] = fsilu(v0[j]); v1[j] = fsilu(v1[j]); } }
                        else if (mode == 4) {
#pragma unroll
                            for (int j = 0; j < 4; ++j) { v0[j] = fsigmoid(v0[j]); v1[j] = fsigmoid(v1[j]); } }
                        store8(pn * BM + bj * HALF, cw, row, v0, v1); } }
        }
    }
};

#ifndef CPU_EMU
#define PG8_LAS __attribute__((address_space(3)))
template <class Epi, class Sched, bool ALIGN_EPI = true, bool SP2 = true>
__device__ __forceinline__ void gemm_phase(int w0, PG8_LAS unsigned char* lds, const Gemm g, const Sched S, const Epi E) {
    const int tid = opaque_tid(w0), wid = __builtin_amdgcn_readfirstlane(tid >> 6), lane = tid & 63, wr = wid >> 2, wc = wid & 3, fr = lane & 15, fq = lane >> 4;
    const int K = g.K, nt = K / BK;
    unsigned voffA[2], voffB[2];
#pragma unroll
    for (int i = 0; i < 2; ++i) { int R, C; stage_rc(tid * 16 + i * 8192, R, C); const int Rb = Epi::PERM ? ((R & ~31) + perm32(R & 31)) : R;
        voffA[i] = (unsigned)(R * g.lda + C) * 2u; voffB[i] = (unsigned)(Rb * g.ldb + C) * 2u; }
    const size_t kstep = (size_t)(BK * 2);
    const size_t hstepA = (size_t)HALF * g.lda * 2, hstepB = (size_t)HALF * g.ldb * 2;
    const size_t tstepA = 2 * hstepA, tstepB = 2 * hstepB;
    const unsigned ldsw = (unsigned)wid * 1024u;
    const int aoff = lds_byte(wr * 64 + fr, fq * 8), boff = lds_byte(wc * 32 + fr, fq * 8);
#define PG8_SA(b, h) (((b) * 2 + (h)) * HTB)
#define PG8_SB(b, h) ((4 + (b) * 2 + (h)) * HTB)
#define PG8_STAGE(bufoff, gbase, voff) do { _Pragma("unroll") for (int _i = 0; _i < 2; ++_i) \
        __builtin_amdgcn_global_load_lds((const unsigned*)((const char*)(gbase) + (voff)[_i]), (PG8_LAS unsigned*)(lds + (bufoff) + ldsw + _i * 8192), 16, 0, 0); } while (0)
#define PG8_LDA(dst, b, h) do { _Pragma("unroll") for (int m = 0; m < 4; ++m) _Pragma("unroll") for (int k = 0; k < 2; ++k) dst[m][k] = *(const PG8_LAS bf16x8*)(lds + PG8_SA(b, h) + aoff + m * 2048 + k * 1024); } while (0)
#define PG8_LDB(dst, b, h) do { _Pragma("unroll") for (int n = 0; n < 2; ++n) _Pragma("unroll") for (int k = 0; k < 2; ++k) dst[n][k] = *(const PG8_LAS bf16x8*)(lds + PG8_SB(b, h) + boff + n * 2048 + k * 1024); } while (0)
#define PG8_MMA(ai, bj, At, Bt) do { __builtin_amdgcn_s_setprio(1); _Pragma("unroll") for (int m = 0; m < 4; ++m) _Pragma("unroll") for (int n = 0; n < 2; ++n) _Pragma("unroll") for (int k = 0; k < 2; ++k) \
        acc[ai][bj][m][n] = __builtin_amdgcn_mfma_f32_16x16x32_bf16(Bt[n][k], At[m][k], acc[ai][bj][m][n], 0, 0, 0); __builtin_amdgcn_s_setprio(0); } while (0)
#define PG8_WAIT_V(n) asm volatile("s_waitcnt vmcnt(" #n ")" ::: "memory")
#define PG8_WAIT_L(n) asm volatile("s_waitcnt lgkmcnt(" #n ")" ::: "memory")
#define PG8_BAR __builtin_amdgcn_s_barrier()
#define PG8_SCHED __builtin_amdgcn_sched_barrier(0)
    Unit cur, nxt; int ui = 0;
    if (!S.next(0, cur)) return;
    f32x4 acc[2][2][4][2];
#pragma unroll
    for (int a = 0; a < 2; ++a)
#pragma unroll
        for (int b = 0; b < 2; ++b)
#pragma unroll
            for (int m = 0; m < 4; ++m)
#pragma unroll
                for (int n = 0; n < 2; ++n) acc[a][b][m][n] = (f32x4){0.f, 0.f, 0.f, 0.f};
    bf16x8 At[4][2], B0[2][2], B1[2][2];
    const char* cA = (const char*)g.A + (size_t)cur.pm * tstepA; const char* cB = (const char*)g.Bt + (size_t)cur.pn * tstepB;
    S.a_ready(cur);
    E.pre(cur, 0, wid * 64 + lane_id_v());
    if constexpr (SP2) {
        PG8_STAGE(PG8_SB(0, 0), cB, voffB); PG8_STAGE(PG8_SB(0, 1), cB + hstepB, voffB); PG8_STAGE(PG8_SA(0, 0), cA, voffA); PG8_STAGE(PG8_SA(0, 1), cA + hstepA, voffA);
        if (wr == 1) PG8_BAR;
        PG8_WAIT_V(2); PG8_BAR;
        PG8_STAGE(PG8_SB(1, 0), cB + kstep, voffB); PG8_STAGE(PG8_SA(1, 0), cA + kstep, voffA); PG8_STAGE(PG8_SB(1, 1), cB + hstepB + kstep, voffB);
        PG8_WAIT_V(6); PG8_BAR;
    } else {
        PG8_STAGE(PG8_SB(0, 0), cB, voffB); PG8_STAGE(PG8_SA(0, 0), cA, voffA); PG8_STAGE(PG8_SB(0, 1), cB + hstepB, voffB); PG8_STAGE(PG8_SA(0, 1), cA + hstepA, voffA);
        if (wr == 1) PG8_BAR;
        PG8_WAIT_V(4); PG8_BAR;
        PG8_STAGE(PG8_SB(1, 0), cB + kstep, voffB); PG8_STAGE(PG8_SA(1, 0), cA + kstep, voffA); PG8_STAGE(PG8_SB(1, 1), cB + hstepB + kstep, voffB);
        PG8_WAIT_V(6); PG8_BAR;
    }
    for (;;) {
        const bool has_next = S.next(ui + 1, nxt);
        const char* nA = has_next ? (const char*)g.A + (size_t)nxt.pm * tstepA : cA; const char* nB = has_next ? (const char*)g.Bt + (size_t)nxt.pn * tstepB : cB;
        constexpr int NSEG = Epi::MIDK ? 3 : 1;
#pragma nounroll
        for (int seg = 0; seg < NSEG; ++seg) {
        const int tb = Epi::MIDK ? (seg == 0 ? 0 : (seg == 1 ? 4 : 12)) : 0, te = Epi::MIDK ? (seg == 0 ? 4 : (seg == 1 ? 12 : nt)) : nt;
#pragma nounroll
        for (int t = tb; t < te; t += 2) {
            const bool last = (t == nt - 2);
            const char* a1 = cA + (size_t)(t + 1) * kstep;
            const char* a2 = last ? nA : cA + (size_t)(t + 2) * kstep; const char* b2 = last ? nB : cB + (size_t)(t + 2) * kstep;
            const char* a3 = a2 + kstep; const char* b3 = b2 + kstep;
            if (last && has_next) S.a_ready(nxt);
            if constexpr (SP2) {
            PG8_LDB(B0, 0, 0); PG8_LDB(B1, 0, 1); PG8_SCHED; PG8_LDA(At, 0, 0); PG8_STAGE(PG8_SA(1, 1), a1 + hstepA, voffA);
            PG8_WAIT_V(8); PG8_WAIT_L(0); PG8_BAR; PG8_MMA(0, 0, At, B0); PG8_MMA(0, 1, At, B1); PG8_BAR; PG8_SCHED;
            PG8_LDA(At, 0, 1); PG8_STAGE(PG8_SB(0, 0), b2, voffB); PG8_STAGE(PG8_SB(0, 1), b2 + hstepB, voffB); PG8_STAGE(PG8_SA(0, 0), a2, voffA);
            PG8_WAIT_V(8); PG8_WAIT_L(0); PG8_BAR; PG8_MMA(1, 0, At, B0); PG8_MMA(1, 1, At, B1); PG8_BAR; PG8_SCHED;
            PG8_LDB(B0, 1, 0); PG8_LDB(B1, 1, 1); PG8_SCHED; PG8_LDA(At, 1, 0); PG8_STAGE(PG8_SA(0, 1), a2 + hstepA, voffA);
            PG8_WAIT_V(8); PG8_WAIT_L(0); PG8_BAR; PG8_MMA(0, 0, At, B0); PG8_MMA(0, 1, At, B1); PG8_BAR; PG8_SCHED;
            PG8_LDA(At, 1, 1); PG8_STAGE(PG8_SB(1, 0), b3, voffB); PG8_STAGE(PG8_SB(1, 1), b3 + hstepB, voffB); PG8_STAGE(PG8_SA(1, 0), a3, voffA);
            PG8_WAIT_V(8); PG8_WAIT_L(0); PG8_BAR; PG8_MMA(1, 0, At, B0); PG8_MMA(1, 1, At, B1); PG8_BAR; PG8_SCHED;
            } else {
            PG8_LDB(B0, 0, 0); PG8_SCHED; PG8_LDA(At, 0, 0); PG8_STAGE(PG8_SA(1, 1), a1 + hstepA, voffA);
            PG8_WAIT_L(8); PG8_BAR; PG8_WAIT_L(0); PG8_MMA(0, 0, At, B0); PG8_BAR; PG8_SCHED;
            PG8_LDB(B1, 0, 1); PG8_STAGE(PG8_SB(0, 0), b2, voffB);
            PG8_BAR; PG8_WAIT_L(0); PG8_MMA(0, 1, At, B1); PG8_BAR;
            PG8_LDA(At, 0, 1); PG8_STAGE(PG8_SA(0, 0), a2, voffA);
            PG8_BAR; PG8_WAIT_L(0); PG8_MMA(1, 0, At, B0); PG8_BAR; PG8_SCHED;
            PG8_STAGE(PG8_SB(0, 1), b2 + hstepB, voffB);
            PG8_WAIT_V(6); PG8_BAR; PG8_MMA(1, 1, At, B1); PG8_BAR;
            PG8_LDB(B0, 1, 0); PG8_SCHED; PG8_LDA(At, 1, 0); PG8_STAGE(PG8_SA(0, 1), a2 + hstepA, voffA);
            PG8_WAIT_L(8); PG8_BAR; PG8_WAIT_L(0); PG8_MMA(0, 0, At, B0); PG8_BAR; PG8_SCHED;
            PG8_LDB(B1, 1, 1); PG8_STAGE(PG8_SB(1, 0), b3, voffB);
            PG8_BAR; PG8_WAIT_L(0); PG8_MMA(0, 1, At, B1); PG8_BAR;
            PG8_LDA(At, 1, 1); PG8_STAGE(PG8_SA(1, 0), a3, voffA);
            PG8_BAR; PG8_WAIT_L(0); PG8_MMA(1, 0, At, B0); PG8_BAR; PG8_SCHED;
            PG8_STAGE(PG8_SB(1, 1), b3 + hstepB, voffB);
            PG8_WAIT_V(6); PG8_BAR; PG8_MMA(1, 1, At, B1); PG8_BAR;
            }
        }
        if constexpr (Epi::MIDK) { if (seg < 2) E.mid(acc, cur, wr, wc, fr, fq, seg); }
        }
        if constexpr (ALIGN_EPI) { if (wr == 0) PG8_BAR; }
        E(acc, cur, wr, wc, fr, fq, ui & 1); S.done(cur);
        if (!has_next) break;
        E.pre(nxt, (ui + 1) & 1, wid * 64 + lane_id_v());
#pragma unroll
        for (int a = 0; a < 2; ++a)
#pragma unroll
            for (int b = 0; b < 2; ++b)
#pragma unroll
                for (int m = 0; m < 4; ++m)
#pragma unroll
                    for (int n = 0; n < 2; ++n) acc[a][b][m][n] = (f32x4){0.f, 0.f, 0.f, 0.f};
        cur = nxt; cA = nA; cB = nB; ++ui;
        if constexpr (ALIGN_EPI) { if (wr == 1) PG8_BAR; }
    }
    PG8_WAIT_V(0);
    if constexpr (!ALIGN_EPI) { if (wr == 0) PG8_BAR; }
    PG8_BAR;
#undef PG8_SA
#undef PG8_SB
#undef PG8_STAGE
#undef PG8_LDA
#undef PG8_LDB
#undef PG8_MMA
#undef PG8_WAIT_V
#undef PG8_WAIT_L
#undef PG8_BAR
#undef PG8_SCHED
}
#else
template <class Epi, class Sched, bool ALIGN_EPI = true, bool SP2 = true>
void gemm_phase(int w0, unsigned char* lds, const Gemm g, const Sched& S, const Epi& E) {
    (void)lds; const int tid = opaque_tid(w0), wid = tid >> 6, lane = tid & 63, wr = wid >> 2, wc = wid & 3, fr = lane & 15, fq = lane >> 4;
    Unit cur;
    for (int ui = 0; S.next(ui, cur); ++ui) {
        E.pre(cur, ui & 1, tid); __syncthreads();
        f32x4 acc[2][2][4][2];
        for (int ai = 0; ai < 2; ++ai) for (int bj = 0; bj < 2; ++bj) for (int m = 0; m < 4; ++m) for (int n = 0; n < 2; ++n) for (int j = 0; j < 4; ++j) {
            const int row = 256 * cur.pm + 128 * ai + 64 * wr + 16 * m + fr;
            const int col = Epi::PERM ? 256 * cur.pn + 128 * bj + 32 * wc + 8 * fq + 4 * n + j : 256 * cur.pn + 128 * bj + 32 * wc + 16 * n + 4 * fq + j;
            acc[ai][bj][m][n][j] = 0.f; }
        const int nseg = Epi::MIDK ? 3 : 1; const int kb[4] = {0, Epi::MIDK ? 256 : g.K, 768, g.K};
        for (int sg = 0; sg < nseg; ++sg) {
            for (int ai = 0; ai < 2; ++ai) for (int bj = 0; bj < 2; ++bj) for (int m = 0; m < 4; ++m) for (int n = 0; n < 2; ++n) for (int j = 0; j < 4; ++j) {
                const int row = 256 * cur.pm + 128 * ai + 64 * wr + 16 * m + fr;
                const int col = Epi::PERM ? 256 * cur.pn + 128 * bj + 32 * wc + 8 * fq + 4 * n + j : 256 * cur.pn + 128 * bj + 32 * wc + 16 * n + 4 * fq + j;
                const bf16_t* a = g.A + (size_t)row * g.lda; const bf16_t* b = g.Bt + (size_t)col * g.ldb; float s = 0.f;
                for (int k = kb[sg]; k < kb[sg + 1]; ++k) s += bf2f(a[k]) * bf2f(b[k]);
                acc[ai][bj][m][n][j] += s; }
            if constexpr (Epi::MIDK) { if (sg < 2) E.mid(acc, cur, wr, wc, fr, fq, sg); }
        }
        E(acc, cur, wr, wc, fr, fq, ui & 1);
    }
}
#endif
}

#ifndef CPU_EMU
#define XB_TMO      128
#define XB_XCNT(j)  (256  + 64 * (j))
#define XB_XSUB(j)  (1280 + 64 * (j))
#define XB_XGEN(j)  (2304 + 64 * (j))
#define XB_TOP      3328
#define XB_TOPGEN   3392
#define XCD_BAR_WORDS 3456
#define XB_SPIN_CAP (1u << 22)
__device__ __forceinline__ unsigned xb_ld(unsigned* p)              { return __hip_atomic_load(p, __ATOMIC_RELAXED, __HIP_MEMORY_SCOPE_AGENT); }
__device__ __forceinline__ unsigned xb_add(unsigned* p, unsigned v) { return __hip_atomic_fetch_add(p, v, __ATOMIC_RELAXED, __HIP_MEMORY_SCOPE_AGENT); }
__device__ __forceinline__ unsigned xb_xcc_id() { return (unsigned)__builtin_amdgcn_s_getreg((3 << 11) | 20) & 0xFu; }
#define XB_SPIN(cond, bar) do { unsigned _sp = 0; while (cond) { __builtin_amdgcn_s_sleep(1); \
    if ((++_sp & 255u) == 0u) { if (xb_ld(&(bar)[XB_TMO])) break; if (_sp > XB_SPIN_CAP) { atomicAdd(&(bar)[XB_TMO], 1u); break; } } } } while (0)
struct XcdBarrier { unsigned* bar; unsigned x; volatile LAS unsigned* st; };
__device__ __forceinline__ XcdBarrier xcd_barrier_post(unsigned* bar, volatile LAS unsigned* st) {
    XcdBarrier b; b.bar = bar; b.x = xb_xcc_id(); b.st = st;
    if (threadIdx.x == 0) (void)xb_add(&bar[XB_XCNT(b.x)], 1u);
    return b;
}
__device__ __forceinline__ void xcd_barrier_complete(unsigned* bar, unsigned x, unsigned& nloc, unsigned& nx) {
    const unsigned G = gridDim.x * gridDim.y * gridDim.z;
    unsigned sum, cnt, mine, sp = 0u;
    for (;;) {
        sum = 0u; cnt = 0u; mine = 0u;
#pragma unroll
        for (unsigned j = 0; j < 16; ++j) { const unsigned c = xb_ld(&bar[XB_XCNT(j)]); sum += c; cnt += (c > 0u) ? 1u : 0u; mine = (j == x) ? c : mine; }
        if (sum == G) break;
        __builtin_amdgcn_s_sleep(1);
        if ((++sp & 255u) == 0u) { if (xb_ld(&bar[XB_TMO])) break; if (sp > XB_SPIN_CAP) { atomicAdd(&bar[XB_TMO], 1u); break; } }
    }
    nloc = mine > 0u ? mine : 1u; nx = cnt > 0u ? cnt : 1u;
}
__device__ __forceinline__ void xcd_barrier(const XcdBarrier& b, int w0) {
    asm volatile("s_waitcnt vmcnt(0)" ::: "memory");
    __syncthreads();
    if (w0 == 0 && lane_id_v() == 0) {
        unsigned* bar = b.bar;
        __builtin_amdgcn_s_waitcnt(0);
        unsigned nloc = b.st[0], nx = b.st[1];
        if (nloc == 0u) { xcd_barrier_complete(bar, b.x, nloc, nx); b.st[0] = nloc; b.st[1] = nx; }
        const unsigned old = xb_add(&bar[XB_XSUB(b.x)], 1u);
        const unsigned gen = old / nloc;
        if (old + 1u == (gen + 1u) * nloc) {
            __builtin_amdgcn_fence(__ATOMIC_RELEASE, "agent");
            asm volatile("s_waitcnt vmcnt(0)" ::: "memory");
            const unsigned og = xb_add(&bar[XB_TOP], 1u);
            const unsigned tg = og / nx;
            if (og + 1u == (tg + 1u) * nx) xb_add(&bar[XB_TOPGEN], 1u);
            else XB_SPIN(xb_ld(&bar[XB_TOPGEN]) == tg, bar);
            __builtin_amdgcn_fence(__ATOMIC_ACQUIRE, "agent");
            xb_add(&bar[XB_XGEN(b.x)], 1u);
            asm volatile("s_waitcnt vmcnt(0)" ::: "memory");
        } else {
            XB_SPIN(xb_ld(&bar[XB_XGEN(b.x)]) == gen, bar);
            __builtin_amdgcn_fence(__ATOMIC_ACQUIRE, "agent");
            asm volatile("s_waitcnt vmcnt(0)" ::: "memory");
        }
    }
    __syncthreads();
}
#endif

enum { I_XP = 0, I_XS, I_PP, I_PS, I_F1N, I_F1G, I_F1U, I_F1D, I_MIXN, I_WIN, I_RELB, I_RETN, I_HLB, I_HGN, I_WBA, I_WBB, I_WBC, I_WMG, I_WOUT, I_F2N, I_F2G, I_F2U, I_F2D, I_PLEN, I_WPG, I_WPP, I_FINN, N_INPUTS };
struct Args { const float* in[N_INPUTS]; float* out; unsigned char* ws; int lo, hi; };

DEVFN float wave_sum(float v) {
#pragma unroll
    for (int o = 1; o < 64; o <<= 1) v += __shfl_xor(v, o);
    return v;
}
DEVFN void init_rows(const Args& a, bf16_t* H, float* ssq0, int gw, int ngw, int lane) {
    constexpr int NC = D / 256, RB = 4;
    for (int row0 = gw; row0 < T; row0 += RB * ngw) {
        f32x4 x[RB][NC];
#pragma unroll
        for (int r = 0; r < RB; ++r) { const int row = row0 + r * ngw < T ? row0 + r * ngw : row0;
            const float* src = row < NP ? a.in[I_XP] + (size_t)row * D : a.in[I_XS] + (size_t)(row - NP) * D;
#pragma unroll
            for (int j = 0; j < NC; ++j) x[r][j] = *(const f32x4*)(src + 4 * (lane + 64 * j)); }
#pragma unroll
        for (int r = 0; r < RB; ++r) { const int row = row0 + r * ngw; if (row >= T) break;
            float s = 0.f;
#pragma unroll
            for (int j = 0; j < NC; ++j) { const int c = 4 * (lane + 64 * j); const u32x2 o = pk4(x[r][j]); *(u32x2*)(H + (size_t)row * D + c) = o;
                const float r0 = bflo(o.x), r1 = bfhi(o.x), r2 = bflo(o.y), r3 = bfhi(o.y); s += (r0 * r0 + r1 * r1) + (r2 * r2 + r3 * r3); }
            s = wave_sum(s);
            if (lane == 0) *(f32x4*)(ssq0 + 4 * (size_t)row) = (f32x4){s, 0.f, 0.f, 0.f}; }
    }
}
DEVFN void final_norm_rows(const bf16_t* H, float* out, const float* gfin, int gw, int ngw, int lane, float oscale) {
    constexpr int NC = D / 256, RB = 4;
    f32x4 gq[NC];
#pragma unroll
    for (int j = 0; j < NC; ++j) gq[j] = *(const f32x4*)(gfin + 4 * (lane + 64 * j));
    for (int row0 = gw; row0 < T; row0 += RB * ngw) {
        u32x2 w[RB][NC];
#pragma unroll
        for (int r = 0; r < RB; ++r) { const int row = row0 + r * ngw < T ? row0 + r * ngw : row0;
#pragma unroll
            for (int j = 0; j < NC; ++j) w[r][j] = *(const u32x2*)(H + (size_t)row * D + 4 * (lane + 64 * j)); }
#pragma unroll
        for (int r = 0; r < RB; ++r) { const int row = row0 + r * ngw; if (row >= T) break;
            f32x4 v[NC]; float s = 0.f;
#pragma unroll
            for (int j = 0; j < NC; ++j) { const u32x2 x = w[r][j]; v[j] = (f32x4){bflo(x.x), bfhi(x.x), bflo(x.y), bfhi(x.y)}; s += (v[j][0] * v[j][0] + v[j][1] * v[j][1]) + (v[j][2] * v[j][2] + v[j][3] * v[j][3]); }
            const float rinv = rms_rinv(wave_sum(s)) * oscale;
#pragma unroll
            for (int j = 0; j < NC; ++j) *(f32x4*)(out + (size_t)row * D + 4 * (lane + 64 * j)) = v[j] * rinv * gq[j]; }
    }
}
DEVFN void cvt_ple(const Args& a, int l, bf16_t* PB, int gtid, int nthr) {
    for (size_t it = gtid; it < (size_t)T * D_PLE / 8; it += nthr) {
        const size_t e = it * 8; const int row = (int)(e / D_PLE), c = (int)(e % D_PLE);
        const float* src = row < NP ? a.in[I_PP] + ((size_t)l * NP + row) * D_PLE + c : a.in[I_PS] + ((size_t)l * NS + (row - NP)) * D_PLE + c;
        const f32x4 x = *(const f32x4*)src, y = *(const f32x4*)(src + 4);
        u32x4 w; w.x = pk2(x[0], x[1]); w.y = pk2(x[2], x[3]); w.z = pk2(y[0], y[1]); w.w = pk2(y[2], y[3]);
        *(u32x4*)(PB + e) = w;
    }
}
DEVFN int t5_bucket(int rel) {
    const int ret = rel > 0 ? 16 : 0; const int n = rel < 0 ? -rel : rel;
    if (n < 8) return ret + n;
    int large = 8 + (int)(logf((float)n / 8.0f) / logf(128.0f) * 8.0f);
    large = large < 15 ? large : 15;
    return ret + large;
}
DEVFN void prologue_tables(const Args& a, float* rope, float* biasT, float* lbs, int gtid, int nthr) {
    for (int it = gtid; it < 4096 * 64; it += nthr) { const int pos = it >> 6, i = it & 63;
        const float inv = powf(10000.0f, -(float)i / 64.0f); const float ang = (float)pos * inv;
        rope[it] = cosf(ang); rope[4096 * 64 + it] = sinf(ang); }
    for (int it = gtid; it < 3 * 4 * 160; it += nthr) { const int idx = it % 160, gh = it / 160, g = gh >> 2, hh = gh & 3; const int o = idx - 16; const int dil = g == 0 ? 1 : (g == 1 ? 4 : 16);
        biasT[it] = (o >= 0 && o <= 128) ? a.in[I_RELB][t5_bucket((o - 64) * dil) * 12 + 4 * g + hh] : -1e30f; }
    for (int c = gtid; c < 512; c += nthr) {
        float mx = -3.0e38f; for (int l = 0; l < DEPTH; ++l) mx = fmaxf(mx, a.in[I_HLB][l * 512 + c]);
        float den = 0.f; for (int l = 0; l < DEPTH; ++l) den += expf(a.in[I_HLB][l * 512 + c] - mx);
        float cum = 0.f, first = 0.f;
        for (int l = 0; l < DEPTH; ++l) { cum += expf(a.in[I_HLB][l * 512 + c] - mx) / den; if (l == 0) first = cum; lbs[l * 512 + c] = cum - first; }
    }
}
DEVFN int rowmap(int mode, int nl) {
    if (mode == 1) return (nl >> 7) * 256 + (nl & 127);
    if (mode == 2) return (nl >> 7) * 256 + 128 + (nl & 127);
    if (mode == 3) { const int dl = nl & 127, nn = dl >> 6, rem = dl & 63; return (nl & ~127) + 8 * (rem >> 2) + 4 * nn + (rem & 3); }
    return nl;
}
struct CvtDesc { const float* W; int K, ldw, col0, ncols; bf16_t* dst; int ldd, koff, mode, row_off; const float* gain; float cscale; };
DEVFN void cvt_item(const CvtDesc& d, int item, LAS float* scr, int lane) {
    const int nblk = d.ncols / 32, kb = item / nblk, nb = item % nblk, k0 = 64 * kb, n0 = 32 * nb;
#pragma unroll
    for (int i = 0; i < 8; ++i) { const int kk = 8 * i + (lane >> 3), n4 = 4 * (lane & 7); const float gsc = (d.gain ? d.gain[k0 + kk] : 1.0f) * d.cscale;
        const f32x4 w = *(const f32x4*)(d.W + (size_t)(k0 + kk) * d.ldw + d.col0 + n0 + n4) * gsc;
        LAS float* p = scr + kk * 33 + n4; p[0] = w[0]; p[1] = w[1]; p[2] = w[2]; p[3] = w[3]; }
    __builtin_amdgcn_wave_barrier();
    const int c = lane & 7;
#pragma unroll
    for (int j = 0; j < 4; ++j) { const int n = (lane >> 3) + 8 * j; const LAS float* s = scr + (8 * c) * 33 + n;
        u32x4 o; o.x = pk2(s[0 * 33], s[1 * 33]); o.y = pk2(s[2 * 33], s[3 * 33]); o.z = pk2(s[4 * 33], s[5 * 33]); o.w = pk2(s[6 * 33], s[7 * 33]);
        *(u32x4*)(d.dst + (size_t)(d.row_off + rowmap(d.mode, n0 + n)) * d.ldd + d.koff + k0 + 8 * c) = o; }
    __builtin_amdgcn_wave_barrier();
}
constexpr int N_CVT = 18;
DEVFN CvtDesc cvt_desc(const Args& a, int l, bf16_t* WB, int i) {
    CvtDesc d; d.col0 = 0; d.koff = 0; d.mode = 0; d.row_off = 0; d.gain = nullptr; d.cscale = 1.0f;
    const float* win = a.in[I_WIN] + (size_t)l * D * N_IN;
    switch (i) {
    case 0: d.W = a.in[I_F1G] + (size_t)l * D * FF; d.K = D; d.ldw = FF; d.ncols = FF; d.dst = WB + WE_GU1; d.ldd = D; d.mode = 1; d.gain = a.in[I_F1N] + l * D; break;
    case 1: d.W = a.in[I_F1U] + (size_t)l * D * FF; d.K = D; d.ldw = FF; d.ncols = FF; d.dst = WB + WE_GU1; d.ldd = D; d.mode = 2; d.gain = a.in[I_F1N] + l * D; break;
    case 2: d.W = a.in[I_F1D] + (size_t)l * FF * D; d.K = FF; d.ldw = D; d.ncols = D; d.dst = WB + WE_D1; d.ldd = FF; break;
    case 3: d.W = win; d.K = D; d.ldw = N_IN; d.col0 = 0; d.ncols = 768; d.dst = WB + WE_IN; d.ldd = D; d.gain = a.in[I_MIXN] + l * D; d.cscale = 0.125f; break;
    case 4: d.W = win; d.K = D; d.ldw = N_IN; d.col0 = 768; d.ncols = 1536; d.dst = WB + WE_IN; d.ldd = D; d.row_off = 768; d.gain = a.in[I_MIXN] + l * D; break;
    case 5: d.W = win; d.K = D; d.ldw = N_IN; d.col0 = OFF_QB; d.ncols = 512; d.dst = WB + WE_IN; d.ldd = D; d.row_off = OFF_QB; d.mode = 3; d.gain = a.in[I_MIXN] + l * D; break;
    case 6: d.W = win; d.K = D; d.ldw = N_IN; d.col0 = OFF_KB; d.ncols = 512; d.dst = WB + WE_IN; d.ldd = D; d.row_off = OFF_KB; d.mode = 3; d.gain = a.in[I_MIXN] + l * D; d.cscale = 0.08838834764831845f; break;
    case 7: d.W = win; d.K = D; d.ldw = N_IN; d.col0 = OFF_VB; d.ncols = N_IN - OFF_VB; d.dst = WB + WE_IN; d.ldd = D; d.row_off = OFF_VB; d.gain = a.in[I_MIXN] + l * D; break;
    case 8: d.W = a.in[I_WMG] + (size_t)l * D * 3 * D; d.K = D; d.ldw = 3 * D; d.ncols = 3 * D; d.dst = WB + WE_IN; d.ldd = D; d.row_off = OFF_MG; d.gain = a.in[I_MIXN] + l * D; break;
    case 9: d.W = a.in[I_WBA] + (size_t)l * 256 * D; d.K = 256; d.ldw = D; d.ncols = D; d.dst = WB + WE_BR; d.ldd = MIXW; d.koff = 0; break;
    case 10: d.W = a.in[I_WBB] + (size_t)l * 512 * D; d.K = 512; d.ldw = D; d.ncols = D; d.dst = WB + WE_BR; d.ldd = MIXW; d.koff = 256; break;
    case 11: d.W = a.in[I_WBC] + (size_t)l * 512 * D; d.K = 512; d.ldw = D; d.ncols = D; d.dst = WB + WE_BR; d.ldd = MIXW; d.koff = 768; break;
    case 12: d.W = a.in[I_WOUT] + (size_t)l * D * D; d.K = D; d.ldw = D; d.ncols = D; d.dst = WB + WE_OUT; d.ldd = D; break;
    case 13: d.W = a.in[I_F2G] + (size_t)l * D * FF; d.K = D; d.ldw = FF; d.ncols = FF; d.dst = WB + WE_GU2; d.ldd = D; d.mode = 1; d.gain = a.in[I_F2N] + l * D; break;
    case 14: d.W = a.in[I_F2U] + (size_t)l * D * FF; d.K = D; d.ldw = FF; d.ncols = FF; d.dst = WB + WE_GU2; d.ldd = D; d.mode = 2; d.gain = a.in[I_F2N] + l * D; break;
    case 15: d.W = a.in[I_F2D] + (size_t)l * FF * D; d.K = FF; d.ldw = D; d.ncols = D; d.dst = WB + WE_D2; d.ldd = FF; break;
    case 16: d.W = a.in[I_WPG] + (size_t)l * D * D; d.K = D; d.ldw = D; d.ncols = D; d.dst = WB + WE_PG; d.ldd = D; d.gain = a.in[I_PLEN] + l * D; break;
    default: d.W = a.in[I_WPP] + (size_t)l * D_PLE * D; d.K = D_PLE; d.ldw = D; d.ncols = D; d.dst = WB + WE_PP; d.ldd = D_PLE; break;
    }
    return d;
}
DEVFN void convert_weights(const Args& a, int l, bf16_t* WB, LAS unsigned char* lds, int gw, int ngw, int wave, int lane) {
    LAS float* scr = (LAS float*)(lds + wave * 8704);
    for (int i = 0; i < N_CVT; ++i) {
        const CvtDesc d = cvt_desc(a, l, WB, i);
        const int nitems = (d.K / 64) * (d.ncols / 32);
        for (int it = gw; it < nitems; it += ngw) cvt_item(d, it, scr, lane);
    }
}

#ifndef CPU_EMU
DEVFN s16x4 lds_tr(const LAS bf16_t* p) { return __builtin_amdgcn_ds_read_tr16_b64_v4i16((LAS s16x4*)p); }
#else
s16x4 lds_tr(const bf16_t* p);
#endif
DEVFN bf16x8 tr8(const LAS bf16_t* X, int stride, int r0, int col0, int c16, int g4) {
    const LAS bf16_t* p = X + (r0 + 8 * g4 + (c16 >> 2)) * stride + col0 + 4 * (c16 & 3);
    return cat8(lds_tr(p), lds_tr(p + 4 * stride));
}
DEVFN bf16x8 tr8p(const LAS bf16_t* X, int stride, int r0, int col0, int c16, int g4) {
    const LAS bf16_t* p = X + (r0 + 4 * g4 + (c16 >> 2)) * stride + col0 + 4 * (c16 & 3);
    return cat8(lds_tr(p), lds_tr(p + 16 * stride));
}
DEVFN u32x4 scale8(u32x4 v, float s) {
    u32x4 o; o.x = pk2(bflo(v.x) * s, bfhi(v.x) * s); o.y = pk2(bflo(v.y) * s, bfhi(v.y) * s); o.z = pk2(bflo(v.z) * s, bfhi(v.z) * s); o.w = pk2(bflo(v.w) * s, bfhi(v.w) * s); return o;
}
template <class U> DEVFN void run_units(LAS unsigned char* lds, const U& ctx, int u0, int u1) {
    if (u0 >= u1) return;
    typename U::Regs L = ctx.load(u0);
    for (int u = u0; u < u1; ++u) {
        __syncthreads();
        ctx.stage(lds, L);
        const typename U::Regs N = ctx.load(u + 1 < u1 ? u + 1 : u);
        __syncthreads();
        ctx.compute(lds, L, u);
        L = N;
    }
}

template <class U, class F> DEVFN void run_units_k(LAS unsigned char* lds, const U& ctx, int u0, int u1, typename U::Regs L, F tail) {
    if (u0 >= u1) { tail(); return; }
    for (int u = u0; u + 1 < u1; ++u) {
        __syncthreads();
        ctx.stage(lds, L);
        const typename U::Regs N = ctx.load(u + 1);
        __syncthreads();
        ctx.compute(lds, L, u);
        L = N;
    }
    __syncthreads();
    ctx.stage(lds, L);
    tail();
    __syncthreads();
    int ul = u1 - 1; OPAQUE_SI(ul);
    ctx.compute(lds, L, ul);
}
template <class U> DEVFN void run_units2(LAS unsigned char* lds, const U& ctx, int u0, int u1) {
    if (u0 >= u1) return;
    typename U::Regs L; ctx.load1(L, u0); ctx.load2(L, u0);
    for (int u = u0; u < u1; ++u) {
        __syncthreads();
        ctx.stage(lds, L);
        typename U::Regs N; const int nu = u + 1 < u1 ? u + 1 : u;
        ctx.load1(N, nu);
        __syncthreads();
        ctx.compute(lds, L, u, N, nu);
        L = N;
    }
}
template <class U> DEVFN void run_units2_k(LAS unsigned char* lds, const U& ctx, int u0, int u1, typename U::Regs L) {
    if (u0 >= u1) return;
    ctx.load2(L, u0);
    for (int u = u0; u < u1; ++u) {
        __syncthreads();
        ctx.stage(lds, L);
        typename U::Regs N; const int nu = u + 1 < u1 ? u + 1 : u;
        ctx.load1(N, nu);
        __syncthreads();
        ctx.compute(lds, L, u, N, nu);
        L = N;
    }
}
struct AUnit {
    const bf16_t* Z; bf16_t* AO; float* LSE; const float* biasT; int S; int w0;
    struct Regs { u32x4 kv[4], vv[4]; bf16x8 bq[2]; f32x4 b; };
    struct Idx { int hh, g, dil, L, cb, head, rowbase, k0; };
    DEVFN Idx decode(int unit) const {
        Idx x; const int lS = __builtin_ctz((unsigned)S), lupb = lS - 7;
        const int ub = unit & ((1 << lupb) - 1); int t = unit >> lupb; x.hh = t & 3; t >>= 2; x.g = t % 3; const int seq = t / 3;
        const int ldil = 2 * x.g, lbpr = lS - ldil - 7; x.dil = 1 << ldil; x.L = S >> ldil; const int r = ub >> lbpr; x.cb = ub & ((1 << lbpr) - 1);
        x.head = 4 * x.g + x.hh; x.rowbase = seq * S + r; x.k0 = 128 * x.cb - 64; return x;
    }
    DEVFN Regs load(int unit) const {
        const int tid = opaque_tid(w0), lane = tid & 63, w = tid >> 6, c16 = lane & 15, g4 = lane >> 4; const Idx x = decode(unit); Regs R;
#pragma unroll
        for (int i = 0; i < 4; ++i) {
            const int id = tid + 512 * i, key = id >> 3, ch = id & 7, ik = x.k0 + key;
            const int ikc = ik < 0 ? 0 : (ik < x.L ? ik : x.L - 1); const int zr = x.rowbase + ikc * x.dil;
            R.kv[i] = *(const u32x4*)(Z + zoff(OFF_KA, 64, x.head, zr, 8 * ch)); R.vv[i] = *(const u32x4*)(Z + zoff(OFF_VA, 64, x.head, zr, 8 * ch));
        }
        R.b = (f32x4){tid < 160 ? biasT[(x.g * 4 + x.hh) * 160 + tid] : 0.f, 0.f, 0.f, 0.f};
        const size_t qrow = (size_t)(x.rowbase + (128 * x.cb + 16 * w + c16) * x.dil);
#pragma unroll
        for (int ks = 0; ks < 2; ++ks) R.bq[ks] = *(const bf16x8*)(Z + zoff(OFF_QA, 64, x.head, (int)qrow, 32 * ks + 8 * g4));
        return R;
    }
    DEVFN void stage(LAS unsigned char* lds, const Regs& R) const {
        const int tid = opaque_tid(w0);
        LAS bf16_t* Ks = (LAS bf16_t*)lds; LAS bf16_t* Vs = (LAS bf16_t*)(lds + 256 * 72 * 2); LAS float* bs = (LAS float*)(lds + 2 * 256 * 72 * 2);
#pragma unroll
        for (int i = 0; i < 4; ++i) { const int id = tid + 512 * i, key = id >> 3, ch = id & 7; *(LAS u32x4*)(Ks + key * 72 + 8 * ch) = R.kv[i]; *(LAS u32x4*)(Vs + key * 72 + 8 * ch) = R.vv[i]; }
        if (tid < 160) bs[tid] = R.b[0];
    }
    DEVFN void compute(LAS unsigned char* lds, const Regs& R, int unit) const {
        const int tid = opaque_tid(w0), lane = tid & 63, w = tid >> 6, c16 = lane & 15, g4 = lane >> 4; const Idx x = decode(unit);
        const LAS bf16_t* Ks = (const LAS bf16_t*)lds; const LAS bf16_t* Vs = (const LAS bf16_t*)(lds + 256 * 72 * 2); const LAS float* bs = (const LAS float*)(lds + 2 * 256 * 72 * 2);
        const size_t qrow = (size_t)(x.rowbase + (128 * x.cb + 16 * w + c16) * x.dil);
        f32x4 sc[9]; float mx = -3.0e38f;
#pragma unroll
        for (int kt = 0; kt < 9; ++kt) {
            f32x4 acc = {0.f, 0.f, 0.f, 0.f};
#pragma unroll
            for (int ks = 0; ks < 2; ++ks) acc = mfma16(*(const LAS bf16x8*)(Ks + (16 * (w + kt) + c16) * 72 + 32 * ks + 8 * g4), R.bq[ks], acc);
            f32x4 bv;
#pragma unroll
            for (int rr = 0; rr < 4; ++rr) bv[rr] = bs[16 * kt + 4 * g4 + rr - c16 + 16];
            OPAQUE_V4(bv);
#pragma unroll
            for (int rr = 0; rr < 4; ++rr) {
                const int ik = x.k0 + 16 * (w + kt) + 4 * g4 + rr;
                const float s = (unsigned)ik < (unsigned)x.L ? acc[rr] + bv[rr] : -1e30f;
                acc[rr] = s; mx = fmaxf(mx, s);
            }
            sc[kt] = acc;
        }
        mx = fmaxf(mx, __shfl_xor(mx, 16)); mx = fmaxf(mx, __shfl_xor(mx, 32));
        float sum = 0.f;
#pragma unroll
        for (int kt = 0; kt < 9; ++kt)
#pragma unroll
            for (int rr = 0; rr < 4; ++rr) { const float p = fexp(sc[kt][rr] - mx); sc[kt][rr] = p; sum += p; }
        sum += __shfl_xor(sum, 16); sum += __shfl_xor(sum, 32);
        bf16x8 bp[5];
        const f32x4 zero4 = {0.f, 0.f, 0.f, 0.f};
#pragma unroll
        for (int pp = 0; pp < 5; ++pp) bp[pp] = pack8(sc[2 * pp], pp < 4 ? sc[2 * pp + 1] : zero4);
        const float inv = frcp(sum);
#pragma unroll
        for (int dt = 0; dt < 4; ++dt) {
            f32x4 acc = {0.f, 0.f, 0.f, 0.f};
#pragma unroll
            for (int pp = 0; pp < 5; ++pp) {
                const LAS bf16_t* p = Vs + (16 * (w + 2 * pp) + 4 * g4 + (c16 >> 2)) * 72 + 16 * dt + 4 * (c16 & 3);
                acc = mfma16(cat8(lds_tr(p), lds_tr(p + (pp < 4 ? 16 * 72 : 0))), bp[pp], acc);
            }
            *(u32x2*)(AO + qrow * AOW + x.head * 64 + 16 * dt + 4 * g4) = pk4(acc * inv);
        }
        if (g4 == 0) LSE[qrow * 12 + x.head] = mx + flog2(sum) * 0.6931471805599453f;
    }
};
DEVFN void mixer_a_merge(const bf16_t* AO, const float* LSE, bf16_t* MIX, int gtid, int nthr) {
    for (int it = gtid; it < SLAB * 32; it += nthr) {
        const int row = it >> 5, hh = (it >> 3) & 3, c = it & 7;
        const float l0 = LSE[(size_t)row * 12 + hh], l1 = LSE[(size_t)row * 12 + 4 + hh], l2 = LSE[(size_t)row * 12 + 8 + hh];
        const float m = fmaxf(l0, fmaxf(l1, l2)); float w0 = fexp(l0 - m), w1 = fexp(l1 - m), w2 = fexp(l2 - m); const float inv = frcp(w0 + w1 + w2); w0 *= inv; w1 *= inv; w2 *= inv;
        const u32x4 a0 = *(const u32x4*)(AO + (size_t)row * AOW + hh * 64 + 8 * c), a1 = *(const u32x4*)(AO + (size_t)row * AOW + (4 + hh) * 64 + 8 * c), a2 = *(const u32x4*)(AO + (size_t)row * AOW + (8 + hh) * 64 + 8 * c);
        u32x4 o;
        o.x = pk2(w0 * bflo(a0.x) + w1 * bflo(a1.x) + w2 * bflo(a2.x), w0 * bfhi(a0.x) + w1 * bfhi(a1.x) + w2 * bfhi(a2.x));
        o.y = pk2(w0 * bflo(a0.y) + w1 * bflo(a1.y) + w2 * bflo(a2.y), w0 * bfhi(a0.y) + w1 * bfhi(a1.y) + w2 * bfhi(a2.y));
        o.z = pk2(w0 * bflo(a0.z) + w1 * bflo(a1.z) + w2 * bflo(a2.z), w0 * bfhi(a0.z) + w1 * bfhi(a1.z) + w2 * bfhi(a2.z));
        o.w = pk2(w0 * bflo(a0.w) + w1 * bflo(a1.w) + w2 * bflo(a2.w), w0 * bfhi(a0.w) + w1 * bfhi(a1.w) + w2 * bfhi(a2.w));
        *(u32x4*)(MIX + (size_t)row * MIXW + hh * 64 + 8 * c) = o;
    }
}

struct BKvUnit {
    const bf16_t* Z; bf16_t* SB; int w0;
    struct Regs { u32x4 kv[4], vv[4]; };
    DEVFN Regs load(int unit) const {
        const int tid = opaque_tid(w0); const int h = unit & 3, row0 = (unit >> 2) * 128; Regs R;
#pragma unroll
        for (int i = 0; i < 4; ++i) { const int id = tid + 512 * i, j = id >> 4, ch = id & 15; R.kv[i] = *(const u32x4*)(Z + zoff(OFF_KB, 128, h, row0 + j, 8 * ch)); R.vv[i] = *(const u32x4*)(Z + zoff(OFF_VB, 128, h, row0 + j, 8 * ch)); }
        return R;
    }
    DEVFN void stage(LAS unsigned char* lds, const Regs& R) const { (void)lds; (void)R; }
    DEVFN void compute(LAS unsigned char* lds, const Regs& R, int unit) const {
        const int tid = opaque_tid(w0), lane = tid & 63, w = tid >> 6, c16 = lane & 15, g4 = lane >> 4;
        const int h = unit & 3;
        LAS bf16_t* Ks = (LAS bf16_t*)lds;
        LAS bf16_t* Vf = (LAS bf16_t*)(lds + 128 * 136 * 2);
        LAS bf16_t* Vb = (LAS bf16_t*)(lds + 2 * 128 * 136 * 2);
        const float l2f = ret_l2(0, h), l2b = ret_l2(1, h);
#pragma unroll
        for (int i = 0; i < 4; ++i) {
            const int id = tid + 512 * i, j = id >> 4, ch = id & 15;
            *(LAS u32x4*)(Ks + j * 136 + 8 * ch) = R.kv[i];
            *(LAS u32x4*)(Vf + j * 136 + 8 * ch) = scale8(R.vv[i], fexp2((float)(127 - j) * l2f));
            *(LAS u32x4*)(Vb + j * 136 + 8 * ch) = scale8(R.vv[i], fexp2((float)j * l2b));
        }
        __syncthreads();
        bf16x8 af[4];
#pragma unroll
        for (int ks = 0; ks < 4; ++ks) af[ks] = tr8(Ks, 136, 32 * ks, 16 * w, c16, g4);
#pragma unroll
        for (int dir = 0; dir < 2; ++dir) {
            const LAS bf16_t* V = dir ? Vb : Vf;
            bf16_t* dst = SB + ((size_t)unit * 2 + dir) * 16384;
#pragma unroll
            for (int b = 0; b < 8; ++b) {
                f32x4 acc = {0.f, 0.f, 0.f, 0.f};
#pragma unroll
                for (int ks = 0; ks < 4; ++ks) acc = mfma16(af[ks], tr8(V, 136, 32 * ks, 16 * b, c16, g4), acc);
                *(u32x2*)(dst + (16 * b + c16) * 128 + 16 * w + 4 * g4) = pk4(acc);
            }
        }
    }
};
DEVFN void mixer_scan(bf16_t* SB, bf16_t* SC, const float* GC, int nseq, int S, int gtid, int nthr) {
    const int nb = S / 128, nc = S / 64;
    for (int it = gtid; it < nseq * 8 * 2048; it += nthr) {
        const int e8 = it & 2047; int t = it >> 11; const int dir = t & 1, h = (t >> 1) & 3, seq = t >> 3;
        const float G = exp2f(128.0f * ret_l2(dir, h));
        float carry[8];
#pragma unroll
        for (int j = 0; j < 8; ++j) carry[j] = 0.f;
        for (int cc = 0; cc < nb; ++cc) {
            const int c = dir ? nb - 1 - cc : cc;
            bf16_t* p = SB + ((size_t)((seq * nb + c) * 4 + h) * 2 + dir) * 16384 + e8 * 8;
            const u32x4 v = *(const u32x4*)p;
            u32x4 o; o.x = pk2(carry[0], carry[1]); o.y = pk2(carry[2], carry[3]); o.z = pk2(carry[4], carry[5]); o.w = pk2(carry[6], carry[7]);
            *(u32x4*)p = o;
            carry[0] = carry[0] * G + bflo(v.x); carry[1] = carry[1] * G + bfhi(v.x); carry[2] = carry[2] * G + bflo(v.y); carry[3] = carry[3] * G + bfhi(v.y);
            carry[4] = carry[4] * G + bflo(v.z); carry[5] = carry[5] * G + bfhi(v.z); carry[6] = carry[6] * G + bflo(v.w); carry[7] = carry[7] * G + bfhi(v.w);
        }
    }
    for (int it = gtid; it < nseq * 8 * 2048; it += nthr) {
        const int e8 = it & 2047; int t = it >> 11; const int dir = t & 1, h = (t >> 1) & 3, seq = t >> 3;
        const int dk0 = (e8 & 15) * 8;
        float carry[8];
#pragma unroll
        for (int j = 0; j < 8; ++j) carry[j] = 0.f;
        for (int cc = 0; cc < nc; ++cc) {
            const int c = dir ? nc - 1 - cc : cc;
            const size_t ui = (size_t)((seq * nc + c) * 4 + h) * 2 + dir;
            bf16_t* p = SC + ui * 16384 + e8 * 8;
            const f32x4 g0 = *(const f32x4*)(GC + ui * 128 + dk0), g1 = *(const f32x4*)(GC + ui * 128 + dk0 + 4);
            const u32x4 v = *(const u32x4*)p;
            u32x4 o; o.x = pk2(carry[0], carry[1]); o.y = pk2(carry[2], carry[3]); o.z = pk2(carry[4], carry[5]); o.w = pk2(carry[6], carry[7]);
            *(u32x4*)p = o;
            carry[0] = carry[0] * g0[0] + bflo(v.x); carry[1] = carry[1] * g0[1] + bfhi(v.x); carry[2] = carry[2] * g0[2] + bflo(v.y); carry[3] = carry[3] * g0[3] + bfhi(v.y);
            carry[4] = carry[4] * g1[0] + bflo(v.z); carry[5] = carry[5] * g1[1] + bfhi(v.z); carry[6] = carry[6] * g1[2] + bflo(v.w); carry[7] = carry[7] * g1[3] + bfhi(v.w);
        }
    }
}
struct BOutUnit {
    const bf16_t* Z; const bf16_t* SB; bf16_t* MIX; const float* gain; int w0;
    struct Regs { u32x4 kv[4], vv[4], sf[4], sb[4]; bf16x8 bq[4]; f32x4 gn; };
    DEVFN Regs load(int unit) const {
        const int tid = opaque_tid(w0), lane = tid & 63, w = tid >> 6, c16 = lane & 15, g4 = lane >> 4; const int h = unit & 3, row0 = (unit >> 2) * 128; Regs R;
        const bf16_t* gSf = SB + ((size_t)unit * 2 + 0) * 16384; const bf16_t* gSb = SB + ((size_t)unit * 2 + 1) * 16384;
#pragma unroll
        for (int i = 0; i < 4; ++i) {
            const int id = tid + 512 * i, j = id >> 4, ch = id & 15;
            R.kv[i] = *(const u32x4*)(Z + zoff(OFF_KB, 128, h, row0 + j, 8 * ch)); R.vv[i] = *(const u32x4*)(Z + zoff(OFF_VB, 128, h, row0 + j, 8 * ch)); R.sf[i] = *(const u32x4*)(gSf + j * 128 + 8 * ch); R.sb[i] = *(const u32x4*)(gSb + j * 128 + 8 * ch);
        }
        const size_t row = (size_t)(row0 + 16 * w + c16);
#pragma unroll
        for (int ks = 0; ks < 4; ++ks) R.bq[ks] = *(const bf16x8*)(Z + zoff(OFF_QB, 128, h, (int)row, 32 * ks + 8 * g4));
        R.gn = (f32x4){gain[h * 128 + (tid & 127)], 0.f, 0.f, 0.f};
        return R;
    }
    DEVFN void stage(LAS unsigned char* lds, const Regs& R) const {
        const int tid = opaque_tid(w0);
        LAS bf16_t* Ks = (LAS bf16_t*)lds; LAS bf16_t* Vs = (LAS bf16_t*)(lds + 128 * 136 * 2); LAS bf16_t* Sf = (LAS bf16_t*)(lds + 2 * 128 * 136 * 2); LAS bf16_t* Sb = (LAS bf16_t*)(lds + 3 * 128 * 136 * 2);
#pragma unroll
        for (int i = 0; i < 4; ++i) { const int id = tid + 512 * i, j = id >> 4, ch = id & 15; const int o = j * 136 + 8 * ch;
            *(LAS u32x4*)(Ks + o) = R.kv[i]; *(LAS u32x4*)(Vs + o) = R.vv[i]; *(LAS u32x4*)(Sf + o) = R.sf[i]; *(LAS u32x4*)(Sb + o) = R.sb[i]; }
        if (tid < 128) ((LAS float*)(lds + 4 * 128 * 136 * 2))[tid] = R.gn[0];
    }
    DEVFN void compute(LAS unsigned char* lds, const Regs& R, int unit) const {
        const int tid = opaque_tid(w0), lane = tid & 63, w = tid >> 6, c16 = lane & 15, g4 = lane >> 4;
        const int h = unit & 3, row0 = (unit >> 2) * 128;
        const LAS bf16_t* Ks = (const LAS bf16_t*)lds;
        const LAS bf16_t* Vs = (const LAS bf16_t*)(lds + 128 * 136 * 2);
        const LAS bf16_t* Sf = (const LAS bf16_t*)(lds + 2 * 128 * 136 * 2);
        const LAS bf16_t* Sb = (const LAS bf16_t*)(lds + 3 * 128 * 136 * 2);
        const LAS float* gtab = (const LAS float*)(lds + 4 * 128 * 136 * 2);
        const float l2f = ret_l2(0, h), l2b = ret_l2(1, h);
        const int i = 16 * w + c16; const size_t row = (size_t)(row0 + i);
        u32x2 gwv[8];
#pragma unroll
        for (int dvt = 0; dvt < 8; ++dvt) gwv[dvt] = *(const u32x2*)(Z + zoff(OFF_GB, 128, h, (int)row, 16 * dvt + 4 * g4));
        f32x4 P[8];
#pragma unroll
        for (int jt = 0; jt < 8; ++jt) {
            f32x4 acc = {0.f, 0.f, 0.f, 0.f};
#pragma unroll
            for (int ks = 0; ks < 4; ++ks) acc = mfma16(*(const LAS bf16x8*)(Ks + (16 * jt + c16) * 136 + 32 * ks + 8 * g4), R.bq[ks], acc);
#pragma unroll
            for (int rr = 0; rr < 4; ++rr) { const int d = i - (16 * jt + 4 * g4 + rr); const int ad = d < 0 ? -d : d; float wgt = fexp2((float)ad * (d > 0 ? l2f : l2b)); if (d == 0) wgt = 2.0f; acc[rr] *= wgt; }
            P[jt] = acc;
        }
        bf16x8 bp[4];
#pragma unroll
        for (int k2 = 0; k2 < 4; ++k2) bp[k2] = pack8(P[2 * k2], P[2 * k2 + 1]);
        const float cf = fexp2((float)(i + 1) * l2f), cb = fexp2((float)(128 - i) * l2b);
        f32x4 o[8]; float s1 = 0.f;
#pragma unroll
        for (int dvt = 0; dvt < 8; ++dvt) {
            f32x4 aO = {0.f, 0.f, 0.f, 0.f}, aF = {0.f, 0.f, 0.f, 0.f}, aB = {0.f, 0.f, 0.f, 0.f};
#pragma unroll
            for (int k2 = 0; k2 < 4; ++k2) aO = mfma16(tr8p(Vs, 136, 32 * k2, 16 * dvt, c16, g4), bp[k2], aO);
#pragma unroll
            for (int ks = 0; ks < 4; ++ks) {
                aF = mfma16(*(const LAS bf16x8*)(Sf + (16 * dvt + c16) * 136 + 32 * ks + 8 * g4), R.bq[ks], aF);
                aB = mfma16(*(const LAS bf16x8*)(Sb + (16 * dvt + c16) * 136 + 32 * ks + 8 * g4), R.bq[ks], aB);
            }
            o[dvt] = aO + aF * cf + aB * cb;
            s1 += (o[dvt][0] + o[dvt][1]) + (o[dvt][2] + o[dvt][3]);
            EPI_FENCE();
        }
        s1 += __shfl_xor(s1, 16); s1 += __shfl_xor(s1, 32);
        const float mu = s1 * (1.0f / 128.0f); float s2 = 0.f;
#pragma unroll
        for (int dvt = 0; dvt < 8; ++dvt) { o[dvt] = o[dvt] - mu; s2 += (o[dvt][0] * o[dvt][0] + o[dvt][1] * o[dvt][1]) + (o[dvt][2] * o[dvt][2] + o[dvt][3] * o[dvt][3]); }
        s2 += __shfl_xor(s2, 16); s2 += __shfl_xor(s2, 32);
        const float rstd = frsq(s2 * (1.0f / 128.0f) + EPS);
#pragma unroll
        for (int dvt = 0; dvt < 8; ++dvt) {
            const int col = h * 128 + 16 * dvt + 4 * g4;
            const f32x4 gn = *(const LAS f32x4*)(gtab + 16 * dvt + 4 * g4); const u32x2 gw = gwv[dvt];
            f32x4 v = o[dvt] * rstd * gn; v[0] *= bflo(gw.x); v[1] *= bfhi(gw.x); v[2] *= bflo(gw.y); v[3] *= bfhi(gw.y);
            *(u32x2*)(MIX + row * MIXW + 256 + col) = pk4(v);
        }
    }
};

struct CRegs { u32x4 lf[4], v[2]; };
DEVFN CRegs c_load_common(const bf16_t* Z, int row0, int h, int tid) {
    CRegs R;
#pragma unroll
    for (int i = 0; i < 4; ++i) { const int id = tid + 512 * i, dir = id >> 10, j = (id >> 4) & 63, ch = id & 15; R.lf[i] = *(const u32x4*)(Z + zoff(OFF_FCF + dir * 512, 128, h, row0 + j, 8 * ch)); }
#pragma unroll
    for (int i = 0; i < 2; ++i) { const int id = tid + 512 * i, j = id >> 4, ch = id & 15; R.v[i] = *(const u32x4*)(Z + zoff(OFF_IC, 128, h, row0 + j, 8 * ch)); }
    return R;
}
DEVFN void c_stage_common(LAS float* LF, LAS bf16_t* Vs, const CRegs& R, int tid) {
#pragma unroll
    for (int i = 0; i < 4; ++i) {
        const int id = tid + 512 * i, dir = id >> 10, j = (id >> 4) & 63, ch = id & 15; const u32x4 v = R.lf[i];
        LAS float* d = LF + (dir * 64 + j) * 128 + 8 * ch;
        f32x4 a, b; a[0] = h2f(v.x & 0xffffu); a[1] = h2f(v.x >> 16); a[2] = h2f(v.y & 0xffffu); a[3] = h2f(v.y >> 16); b[0] = h2f(v.z & 0xffffu); b[1] = h2f(v.z >> 16); b[2] = h2f(v.w & 0xffffu); b[3] = h2f(v.w >> 16);
        *(LAS f32x4*)d = a; *(LAS f32x4*)(d + 4) = b;
    }
#pragma unroll
    for (int i = 0; i < 2; ++i) { const int id = tid + 512 * i, j = id >> 4, ch = id & 15; *(LAS u32x4*)(Vs + j * 136 + 8 * ch) = R.v[i]; }
}
struct CKvUnit {
    const bf16_t* Z; bf16_t* SC; float* GC; int w0;
    struct Regs { CRegs c; };
    DEVFN Regs load(int unit) const { Regs R; R.c = c_load_common(Z, (unit >> 2) * 64, unit & 3, opaque_tid(w0)); return R; }
    DEVFN void stage(LAS unsigned char* lds, const Regs& R) const { c_stage_common((LAS float*)lds, (LAS bf16_t*)(lds + 65536 + 2 * 64 * 136 * 2), R.c, opaque_tid(w0)); }
    DEVFN void compute(LAS unsigned char* lds, const Regs& R, int unit) const {
        (void)R; const int tid = opaque_tid(w0), lane = tid & 63, w = tid >> 6, c16 = lane & 15, g4 = lane >> 4;
        LAS float* LF = (LAS float*)lds;
        LAS bf16_t* Kx = (LAS bf16_t*)(lds + 65536);
        LAS bf16_t* Vs = (LAS bf16_t*)(lds + 65536 + 2 * 64 * 136 * 2);
        LAS float* tot = (LAS float*)(lds + 65536 + 3 * 64 * 136 * 2);
        {
            const int dir = tid >> 8, half = (tid >> 7) & 1, dk = tid & 127;
            LAS float* lf = LF + (dir * 64 + half * 32) * 128 + dk;
            float run = 0.f;
            if (dir == 0) { for (int j = 31; j >= 0; --j) { const float x = lf[j * 128]; lf[j * 128] = (1.0f - fexp2(x)) * fexp2(run); run += x; } }
            else { for (int j = 0; j < 32; ++j) { const float x = lf[j * 128]; lf[j * 128] = (1.0f - fexp2(x)) * fexp2(run); run += x; } }
            tot[(dir * 2 + half) * 128 + dk] = fexp2(run);
        }
        __syncthreads();
#pragma unroll
        for (int i = 0; i < 4; ++i) {
            const int id = tid + 512 * i, dir = id >> 10, j = (id >> 4) & 63, ch = id & 15, half = j >> 5;
            const LAS float* s = LF + (dir * 64 + j) * 128 + 8 * ch; f32x4 a = *(const LAS f32x4*)s, b = *(const LAS f32x4*)(s + 4);
            if (half == dir) {
                const LAS float* tp = tot + (dir * 2 + (1 - half)) * 128 + 8 * ch; const f32x4 t0 = *(const LAS f32x4*)tp, t1 = *(const LAS f32x4*)(tp + 4);
#pragma unroll
                for (int e = 0; e < 4; ++e) { a[e] *= t0[e]; b[e] *= t1[e]; }
            }
            *(LAS bf16x8*)(Kx + (dir * 64 + j) * 136 + 8 * ch) = pack8(a, b);
        }
        if (tid < 256) { const int dir = tid >> 7, dk = tid & 127; GC[((size_t)unit * 2 + dir) * 128 + dk] = tot[(dir * 2) * 128 + dk] * tot[(dir * 2 + 1) * 128 + dk]; }
        __syncthreads();
#pragma unroll
        for (int dir = 0; dir < 2; ++dir) {
            bf16x8 af[2];
#pragma unroll
            for (int ks = 0; ks < 2; ++ks) af[ks] = tr8(Kx + dir * 64 * 136, 136, 32 * ks, 16 * w, c16, g4);
            bf16_t* dst = SC + ((size_t)unit * 2 + dir) * 16384;
#pragma unroll
            for (int b = 0; b < 8; ++b) {
                f32x4 acc = {0.f, 0.f, 0.f, 0.f};
#pragma unroll
                for (int ks = 0; ks < 2; ++ks) acc = mfma16(af[ks], tr8(Vs, 136, 32 * ks, 16 * b, c16, g4), acc);
                *(u32x2*)(dst + (16 * b + c16) * 128 + 16 * w + 4 * g4) = pk4(acc);
            }
        }
    }
};
struct COutUnit {
    const bf16_t* Z; const bf16_t* SC; bf16_t* MIX; const float* gain; int w0;
    struct Regs { CRegs c; u32x4 qv[4], sf[4], sb[4]; u32x2 gw[4]; f32x4 gn; };
    DEVFN void load1(Regs& R, int unit) const {
        const int tid = opaque_tid(w0), lane = tid & 63, w = tid >> 6, c16 = lane & 15, g4 = lane >> 4; const int h = unit & 3, row0 = (unit >> 2) * 64; R.c = c_load_common(Z, row0, h, tid);
        const size_t row = (size_t)(row0 + 16 * (w & 3) + c16);
#pragma unroll
        for (int ks = 0; ks < 4; ++ks) R.qv[ks] = *(const u32x4*)(Z + zoff(OFF_QC, 128, h, (int)row, 32 * ks + 8 * g4));
    }
    DEVFN void load2(Regs& R, int unit) const {
        const int tid = opaque_tid(w0), lane = tid & 63, w = tid >> 6, c16 = lane & 15, g4 = lane >> 4; const int h = unit & 3, row0 = (unit >> 2) * 64;
        const size_t row = (size_t)(row0 + 16 * (w & 3) + c16);
        const bf16_t* gSf = SC + ((size_t)unit * 2 + 0) * 16384; const bf16_t* gSb = SC + ((size_t)unit * 2 + 1) * 16384;
#pragma unroll
        for (int i = 0; i < 4; ++i) { const int id = tid + 512 * i; R.sf[i] = *(const u32x4*)(gSf + id * 8); R.sb[i] = *(const u32x4*)(gSb + id * 8); }
#pragma unroll
        for (int dd = 0; dd < 4; ++dd) R.gw[dd] = *(const u32x2*)(Z + zoff(OFF_GC, 128, h, (int)row, 16 * (4 * (w >> 2) + dd) + 4 * g4));
        R.gn = (f32x4){gain[h * 128 + (tid & 127)], 0.f, 0.f, 0.f};
    }
    DEVFN void stage(LAS unsigned char* lds, const Regs& R) const { const int tid = opaque_tid(w0); c_stage_common((LAS float*)lds, (LAS bf16_t*)(lds + 65536 + 2 * 64 * 136 * 2), R.c, tid);
        }
    DEVFN void compute(LAS unsigned char* lds, const Regs& R, int unit, Regs& N, int next) const {
        const int tid = opaque_tid(w0), lane = tid & 63, w = tid >> 6, c16 = lane & 15, g4 = lane >> 4;
        const int h = unit & 3, row0 = (unit >> 2) * 64;
        const LAS float* gtab = (const LAS float*)(lds + 65536 + 3 * 64 * 136 * 2 + 2048);
        LAS float* LF = (LAS float*)lds;
        LAS bf16_t* Kx = (LAS bf16_t*)(lds + 65536);
        LAS bf16_t* Vs = (LAS bf16_t*)(lds + 65536 + 2 * 64 * 136 * 2);
        LAS float* bref = (LAS float*)(lds + 65536 + 3 * 64 * 136 * 2);
        LAS float* ssq = bref + 256;
        {
            const int dir = tid >> 8, half = (tid >> 7) & 1, dk = tid & 127;
            LAS float* lf = LF + dir * 64 * 128 + dk; LAS bf16_t* kx = Kx + dir * 64 * 136 + dk;
            float run = 0.f;
            if (dir == 0) {
                if (half == 1) { for (int i = 32; i < 64; ++i) { const float x = lf[i * 128]; run += x; lf[i * 128] = run; kx[i * 136] = (bf16_t)pk2((1.0f - fexp2(x)) * fexp2(-run), 0.f); } }
                else { for (int i = 31; i >= 0; --i) { const float x = lf[i * 128]; lf[i * 128] = run; kx[i * 136] = (bf16_t)pk2((1.0f - fexp2(x)) * fexp2(-run), 0.f); run -= x; } bref[dk] = fexp2(-run); }
            } else {
                if (half == 0) { for (int i = 31; i >= 0; --i) { const float x = lf[i * 128]; run += x; lf[i * 128] = run; kx[i * 136] = (bf16_t)pk2((1.0f - fexp2(x)) * fexp2(-run), 0.f); } }
                else { for (int i = 32; i < 64; ++i) { const float x = lf[i * 128]; lf[i * 128] = run; kx[i * 136] = (bf16_t)pk2((1.0f - fexp2(x)) * fexp2(-run), 0.f); run -= x; } bref[128 + dk] = fexp2(-run); }
            }
        }
        const int it = w & 3, dvh = w >> 2, i = 16 * it + c16; const size_t row = (size_t)(row0 + i);
        __syncthreads();
        bf16x8 Qpf[4], Qpb[4];
#pragma unroll
        for (int ks = 0; ks < 4; ++ks) {
            const int dk0 = 32 * ks + 8 * g4; const u32x4 qv = R.qv[ks];
            f32x4 q0, q1; q0[0] = bflo(qv.x); q0[1] = bfhi(qv.x); q0[2] = bflo(qv.y); q0[3] = bfhi(qv.y); q1[0] = bflo(qv.z); q1[1] = bfhi(qv.z); q1[2] = bflo(qv.w); q1[3] = bfhi(qv.w);
            const f32x4 df0 = *(const LAS f32x4*)(LF + i * 128 + dk0), df1 = *(const LAS f32x4*)(LF + i * 128 + dk0 + 4);
            const f32x4 db0 = *(const LAS f32x4*)(LF + (64 + i) * 128 + dk0), db1 = *(const LAS f32x4*)(LF + (64 + i) * 128 + dk0 + 4);
            f32x4 a0, a1, e0, e1;
#pragma unroll
            for (int j = 0; j < 4; ++j) { a0[j] = q0[j] * fexp2(df0[j]); a1[j] = q1[j] * fexp2(df1[j]); e0[j] = q0[j] * fexp2(db0[j]); e1[j] = q1[j] * fexp2(db1[j]); }
            Qpf[ks] = pack8(a0, a1); Qpb[ks] = pack8(e0, e1);
            EPI_FENCE();
        }
        f32x4 P[4];
#pragma unroll
        for (int jt = 0; jt < 4; ++jt) {
            f32x4 af = {0.f, 0.f, 0.f, 0.f}, ab = {0.f, 0.f, 0.f, 0.f};
#pragma unroll
            for (int ks = 0; ks < 4; ++ks) {
                af = mfma16(*(const LAS bf16x8*)(Kx + (16 * jt + c16) * 136 + 32 * ks + 8 * g4), Qpf[ks], af);
                ab = mfma16(*(const LAS bf16x8*)(Kx + (64 + 16 * jt + c16) * 136 + 32 * ks + 8 * g4), Qpb[ks], ab);
            }
#pragma unroll
            for (int rr = 0; rr < 4; ++rr) { const int j = 16 * jt + 4 * g4 + rr; P[jt][rr] = (j <= i ? af[rr] : 0.f) + (j >= i ? ab[rr] : 0.f); }
        }
        bf16x8 bp[2];
#pragma unroll
        for (int k2 = 0; k2 < 2; ++k2) bp[k2] = pack8(P[2 * k2], P[2 * k2 + 1]);
        LAS bf16_t* Sl = (LAS bf16_t*)lds;
        __syncthreads();
#pragma unroll
        for (int q = 0; q < 4; ++q) { const int id = tid + 512 * q, r = id >> 4, ch = id & 15; const int o = r * 128 + ((ch ^ (r & 15)) * 8);
            *(LAS u32x4*)(Sl + o) = R.sf[q]; *(LAS u32x4*)(Sl + 16384 + o) = R.sb[q]; }
        if (tid < 128) ((LAS float*)(lds + 65536 + 3 * 64 * 136 * 2 + 2048))[tid] = R.gn[0];
        const u32x2 gw0 = R.gw[0], gw1 = R.gw[1], gw2 = R.gw[2], gw3 = R.gw[3];
        load2(N, next);
        __syncthreads();
        bf16x8 Qqf[4], Qqb[4];
#pragma unroll
        for (int ks = 0; ks < 4; ++ks) {
            const int dk0 = 32 * ks + 8 * g4;
            const f32x4 rf0 = *(const LAS f32x4*)(bref + dk0), rf1 = *(const LAS f32x4*)(bref + dk0 + 4), rb0 = *(const LAS f32x4*)(bref + 128 + dk0), rb1 = *(const LAS f32x4*)(bref + 128 + dk0 + 4);
            const u32x4 pf = __builtin_bit_cast(u32x4, Qpf[ks]), pb = __builtin_bit_cast(u32x4, Qpb[ks]);
            f32x4 c0, c1, f0, f1;
            c0[0] = bflo(pf.x) * rf0[0]; c0[1] = bfhi(pf.x) * rf0[1]; c0[2] = bflo(pf.y) * rf0[2]; c0[3] = bfhi(pf.y) * rf0[3];
            c1[0] = bflo(pf.z) * rf1[0]; c1[1] = bfhi(pf.z) * rf1[1]; c1[2] = bflo(pf.w) * rf1[2]; c1[3] = bfhi(pf.w) * rf1[3];
            f0[0] = bflo(pb.x) * rb0[0]; f0[1] = bfhi(pb.x) * rb0[1]; f0[2] = bflo(pb.y) * rb0[2]; f0[3] = bfhi(pb.y) * rb0[3];
            f1[0] = bflo(pb.z) * rb1[0]; f1[1] = bfhi(pb.z) * rb1[1]; f1[2] = bflo(pb.w) * rb1[2]; f1[3] = bfhi(pb.w) * rb1[3];
            Qqf[ks] = pack8(c0, c1); Qqb[ks] = pack8(f0, f1);
        }
        f32x4 o[4]; float s2 = 0.f;
#pragma unroll
        for (int dd = 0; dd < 4; ++dd) {
            const int dvt = 4 * dvh + dd;
            f32x4 acc = {0.f, 0.f, 0.f, 0.f};
#pragma unroll
            for (int k2 = 0; k2 < 2; ++k2) acc = mfma16(tr8p(Vs, 136, 32 * k2, 16 * dvt, c16, g4), bp[k2], acc);
#pragma unroll
            for (int ks = 0; ks < 4; ++ks) {
                const int so = (16 * dvt + c16) * 128 + (((4 * ks + g4) ^ c16) * 8);
                acc = mfma16(*(const LAS bf16x8*)(Sl + so), Qqf[ks], acc);
                acc = mfma16(*(const LAS bf16x8*)(Sl + 16384 + so), Qqb[ks], acc);
            }
            o[dd] = acc; s2 += (acc[0] * acc[0] + acc[1] * acc[1]) + (acc[2] * acc[2] + acc[3] * acc[3]);
            EPI_FENCE();
        }
        s2 += __shfl_xor(s2, 16); s2 += __shfl_xor(s2, 32);
        if (g4 == 0) ssq[w * 16 + c16] = s2;
        __syncthreads();
        const float rinv = frsq((ssq[w * 16 + c16] + ssq[(w ^ 4) * 16 + c16]) * (1.0f / 128.0f) + EPS);
#pragma unroll
        for (int dd = 0; dd < 4; ++dd) {
            const int col = h * 128 + 16 * (4 * dvh + dd) + 4 * g4;
            const f32x4 gn = *(const LAS f32x4*)(gtab + 16 * (4 * dvh + dd) + 4 * g4); const u32x2 gw = dd == 0 ? gw0 : (dd == 1 ? gw1 : (dd == 2 ? gw2 : gw3));
            f32x4 v = o[dd] * rinv * gn; v[0] *= bflo(gw.x); v[1] *= bfhi(gw.x); v[2] *= bflo(gw.y); v[3] *= bfhi(gw.y);
            *(u32x2*)(MIX + row * MIXW + 768 + col) = pk4(v);
        }
    }
};

#ifndef CPU_EMU
#define KERNEL_LDS extern __shared__ __attribute__((aligned(16))) unsigned char lds_raw[]; LAS unsigned char* lds = (LAS unsigned char*)lds_raw;
#ifdef VGPR_LIMIT
__attribute__((amdgpu_num_vgpr(VGPR_LIMIT)))
#endif
__global__ void __launch_bounds__(512, 2) fwd_kernel(Args args)
#else
#define KERNEL_LDS unsigned char* lds = emu_lds();
void fwd_kernel(Args args)
#endif
{
    KERNEL_LDS
    const int G = gridDim.x, bx = blockIdx.x;
#ifndef CPU_EMU
    const int w0 = __builtin_amdgcn_readfirstlane((int)threadIdx.x >> 6);
#else
    const int w0 = 0;
#endif
#ifndef CPU_EMU
#define PH_IDS const int tid = opaque_tid(w0), lane = tid & 63, wave = __builtin_amdgcn_readfirstlane(tid >> 6), gw = bx * 8 + wave, gtid = bx * 512 + tid; int Gs_ = G; asm volatile("" : "+s"(Gs_)); const int ngw = Gs_ * 8, nthr = Gs_ * 512; (void)lane; (void)gw; (void)gtid; (void)ngw; (void)nthr;
#else
#define PH_IDS const int tid = opaque_tid(w0), lane = tid & 63, wave = tid >> 6, gw = bx * 8 + wave, gtid = bx * 512 + tid; const int ngw = G * 8, nthr = G * 512; (void)lane; (void)gw; (void)gtid; (void)ngw; (void)nthr;
#endif
#ifndef CPU_EMU
#define OPAQUE_S(p) asm volatile("" : "+s"(p))
#else
#define OPAQUE_S(p)
#endif
#define GAS_ __attribute__((address_space(1)))
#ifndef CPU_EMU
#define PH_PTRS GAS_ unsigned char* ws_g = (GAS_ unsigned char*)args.ws; OPAQUE_S(ws_g); unsigned char* ws = (unsigned char*)ws_g; GAS_ float* h_g = (GAS_ float*)args.out; OPAQUE_S(h_g); float* h = (float*)h_g; PH_PTRS2
#else
#define PH_PTRS unsigned char* ws = args.ws; float* h = args.out; PH_PTRS2
#endif
#define PH_PTRS2 \
    float* rope = (float*)(ws + WS_ROPE); float* biasT = (float*)(ws + WS_BIAS); float* lbs = (float*)(ws + WS_LBS); \
    bf16_t* WB = (bf16_t*)(ws + WS_WB); bf16_t* XN = (bf16_t*)(ws + WS_XN); unsigned char* R = ws + WS_R; bf16_t* ACT = (bf16_t*)(R + R_ACT); \
    bf16_t* Zs = (bf16_t*)(R + R_Z); bf16_t* AO = (bf16_t*)(R + R_AO); float* LSE = (float*)(R + R_LSE); bf16_t* MIX = (bf16_t*)(R + R_MIX); \
    bf16_t* MH = (bf16_t*)(R + R_MH); bf16_t* SB = (bf16_t*)(R + R_SB); bf16_t* SC = (bf16_t*)(R + R_SC); float* GC = (float*)(R + R_GC); \
    bf16_t* PB = (bf16_t*)(ws + WS_PB); bf16_t* SG = (bf16_t*)(R + R_SG); bf16_t* XN2 = (bf16_t*)(ws + WS_XN2); float* SSQ = (float*)(ws + WS_SSQ); \
    (void)h; (void)rope; (void)biasT; (void)lbs; (void)WB; (void)XN; (void)ACT; (void)Zs; (void)AO; (void)LSE; (void)MIX; (void)MH; (void)SB; (void)SC; (void)GC; (void)PB; (void)SG; (void)XN2; (void)SSQ;
    const int lo = args.lo, hi = args.hi;
#ifndef CPU_EMU
    LAS unsigned* misc = (LAS unsigned*)(lds + LDS_BYTES - 64);
    if (threadIdx.x < 4) misc[threadIdx.x] = 0u;
    __syncthreads();
    XcdBarrier bar = xcd_barrier_post((unsigned*)(args.ws + WS_CTL) + 1024, (volatile LAS unsigned*)misc);
#define GRID_BAR() xcd_barrier(bar, w0)
#else
#define GRID_BAR() emu_grid_barrier()
#endif
    int ph = 0;
#ifdef PROBE_PROF
    int cls_ = 0;
    if (bx == 0 && threadIdx.x == 0) { unsigned long long* P = (unsigned long long*)(args.ws + WS_CTL + 65536); P[0] = __builtin_amdgcn_s_memrealtime(); }
#define PH_CLS(k) cls_ = (k);
#define PROF_END() if (bx == 0 && w0 == 0 && lane_id_v() == 0) { unsigned long long* P = (unsigned long long*)(args.ws + WS_CTL + 65536); const unsigned long long now = __builtin_amdgcn_s_memrealtime(); P[2 + cls_] += now - P[0]; P[0] = now; }
#else
#define PH_CLS(k)
#define PROF_END()
#endif
#define PH_OPEN if (ph >= lo && ph < hi) { PH_IDS PH_PTRS
#define PH_CLOSE PROF_END() if (ph + 1 < hi) GRID_BAR(); } ++ph;

    PH_CLS(0)
    PH_OPEN
        prologue_tables(args, rope, biasT, lbs, gtid, nthr);
    PH_CLOSE

    for (int l = 0; l < DEPTH; ++l) {
        PH_CLS(0)
        PH_OPEN
            convert_weights(args, l, WB, lds, gw, ngw, wave, lane);
            cvt_ple(args, l, PB, gtid, nthr);
            if (l == 0) init_rows(args, XN2, SSQ, gw, ngw, lane);
        PH_CLOSE
        for (int half = 0; half < 2; ++half) {
            const int nA = 4 * l + 2 * half;
            for (int q = 0; q <= NFP; ++q) {
            PH_CLS(q == 0 ? 1 : (q == NFP ? 3 : 2))
            PH_OPEN
                for (int step = 0; step < 2; ++step) {
                    if ((step ^ (bx & 1)) == 0) {
                        if (q > 0) {
                            const size_t r0 = (size_t)(q - 1) * TP;
                            pg8::Gemm g{ACT + r0 * FF, WB + (half ? WE_D2 : WE_D1), TP, D, FF, FF, FF}; pg8::StaticOrder S; S.init(TP, D, G, bx);
                            pg8::EpiResAdd E{(half ? XN : XN2) + r0 * D, XN + r0 * D, SSQ + ((size_t)((nA + 1) % 3) * T + r0) * 4, D, 1, lds};
                            pg8::gemm_phase<pg8::EpiResAdd, pg8::StaticOrder>(w0, lds, g, S, E);
                        }
                    } else if (q < NFP) {
                        const size_t r0 = (size_t)q * TP;
                        pg8::Gemm g{(half ? XN : XN2) + r0 * D, WB + (half ? WE_GU2 : WE_GU1), TP, 2 * FF, D, D, D}; pg8::StaticOrder S; S.init(TP, 2 * FF, G, bx);
                        pg8::EpiSwiglu E{ACT + r0 * FF, FF, SSQ + ((size_t)(nA % 3) * T + r0) * 4, lds};
                        pg8::gemm_phase<pg8::EpiSwiglu, pg8::StaticOrder>(w0, lds, g, S, E);
                    }
                }
            PH_CLOSE
            }
            if (half == 0) {
                for (int s = 0; s <= NSLAB; ++s) {
                    const int srow0 = (s < NSLAB ? s : NSLAB - 1) * SLAB; const int S_len = srow0 < NP ? SEQ : DEC_SEQ; const int nseq = SLAB / S_len;
                    PH_CLS(s == 0 ? 4 : (s == NSLAB ? 6 : 5))
                    PH_OPEN
                        for (int step = 0; step < 2; ++step) {
                            if ((step ^ (bx & 1)) == 0) {
                                if (s > 0) {
                                    const int prow0 = (s - 1) * SLAB;
                                    pg8::Gemm g{MH, WB + WE_OUT, SLAB, D, D, D, D}; pg8::StaticOrder S; S.init(SLAB, D, G, bx);
                                    pg8::EpiResAdd E{XN + (size_t)prow0 * D, XN + (size_t)prow0 * D, SSQ + ((size_t)((nA + 2) % 3) * T + prow0) * 4, D, 0, lds};
                                    pg8::gemm_phase<pg8::EpiResAdd, pg8::StaticOrder>(w0, lds, g, S, E);
                                }
                            } else if (s < NSLAB) {
                                pg8::Gemm g{XN + (size_t)srow0 * D, WB + WE_IN, SLAB, ZW, D, D, D}; pg8::StaticOrder S; S.init(SLAB, ZW, G, bx);
                                pg8::EpiInProj E{Zs, rope, rope + 4096 * 64, lbs + l * 512, srow0, SSQ + ((size_t)((nA + 1) % 3) * T + srow0) * 4, lds};
                                pg8::gemm_phase<pg8::EpiInProj, pg8::StaticOrder>(w0, lds, g, S, E);
                            }
                        }
                    PH_CLOSE
                    if (s == NSLAB) break;
                    for (int mrep = 0; mrep < MIXREP; ++mrep) {
                    PH_CLS(7)
                    PH_OPEN
                        {
                            const int nuA = (SLAB / 128) * 12, perA = (nuA + G - 1) / G, a0 = bx * perA, a1 = (bx + 1) * perA < nuA ? (bx + 1) * perA : nuA;
                            const int nuB = (SLAB / 128) * 4, perB = (nuB + G - 1) / G, b0 = bx * perB, b1 = (bx + 1) * perB < nuB ? (bx + 1) * perB : nuB;
                            const int nuC = (SLAB / 64) * 4, perC = (nuC + G - 1) / G, c0 = bx * perC, c1 = (bx + 1) * perC < nuC ? (bx + 1) * perC : nuC;
                            const AUnit UA{Zs, AO, LSE, biasT, S_len, w0}; const BKvUnit UB{Zs, SB, w0}; const CKvUnit UC{Zs, SC, GC, w0};
                            BKvUnit::Regs LB; CKvUnit::Regs LC;
                            run_units_k(lds, UA, a0, a1, UA.load(a0 < nuA ? a0 : nuA - 1), [&] { LB = UB.load(b0 < nuB ? b0 : nuB - 1); });
                            run_units_k(lds, UB, b0, b1, LB, [&] { LC = UC.load(c0 < nuC ? c0 : nuC - 1); });
                            run_units_k(lds, UC, c0, c1, LC, [] {});
                        }
                    PH_CLOSE
                    PH_CLS(8)
                    PH_OPEN
                        mixer_scan(SB, SC, GC, nseq, S_len, gtid, nthr);
                    PH_CLOSE
                    PH_CLS(9)
                    PH_OPEN
                        {
                            const int nuB = (SLAB / 128) * 4, perB = (nuB + G - 1) / G, b0 = bx * perB, b1 = (bx + 1) * perB < nuB ? (bx + 1) * perB : nuB;
                            const int nuC = (SLAB / 64) * 4, perC = (nuC + G - 1) / G, c0 = bx * perC, c1 = (bx + 1) * perC < nuC ? (bx + 1) * perC : nuC;
                            const BOutUnit UB{Zs, SB, MIX, args.in[I_RETN] + l * 512, w0}; const COutUnit UC{Zs, SC, MIX, args.in[I_HGN] + l * 512, w0};
                            const BOutUnit::Regs LB = UB.load(b0 < nuB ? b0 : nuB - 1);
                            mixer_a_merge(AO, LSE, MIX, gtid, nthr);
                            COutUnit::Regs LC;
                            run_units_k(lds, UB, b0, b1, LB, [&] { UC.load1(LC, c0 < nuC ? c0 : nuC - 1); });
                            run_units2_k(lds, UC, c0, c1, LC);
                        }
                    PH_CLOSE
                    }
                    PH_CLS(10)
                    PH_OPEN
                        pg8::Gemm g{MIX, WB + WE_BR, SLAB, D, MIXW, MIXW, MIXW}; pg8::StaticOrder S; S.init(SLAB, D, G, bx);
                        pg8::EpiMerge E{MH, Zs + (size_t)SLAB * OFF_MG, D};
                        pg8::gemm_phase<pg8::EpiMerge, pg8::StaticOrder>(w0, lds, g, S, E);
                    PH_CLOSE
                }
            } else {
                PH_CLS(11)
                PH_OPEN
                    { pg8::Gemm g{XN, WB + WE_PG, T, D, D, D, D}; pg8::StaticOrder S; S.init(T, D, G, bx);
                      pg8::EpiGateBf16 E{SG, D, SSQ + (size_t)((nA + 1) % 3) * T * 4, lds};
                      pg8::gemm_phase<pg8::EpiGateBf16, pg8::StaticOrder>(w0, lds, g, S, E); }
                    { pg8::Gemm g{PB, WB + WE_PP, T, D, D_PLE, D_PLE, D_PLE}; pg8::StaticOrder S; S.init(T, D, G, bx);
                      pg8::EpiPle E{XN, SG, D, XN2, SSQ + (size_t)((nA + 2) % 3) * T * 4, lds};
                      pg8::gemm_phase<pg8::EpiPle, pg8::StaticOrder>(w0, lds, g, S, E); }
                PH_CLOSE
            }
        }
    }
    PH_CLS(12)
    PH_OPEN
#ifdef PROBE_PROF
        { const unsigned long long* P = (const unsigned long long*)(args.ws + WS_CTL + 65536); unsigned long long tot = 0; for (int k = 0; k < 12; ++k) tot += P[2 + k];
          final_norm_rows(XN2, h, args.in[I_FINN], gw, ngw, lane, 1.0f + (float)PROBE_K * (floorf((float)((double)P[2 + PROBE_PROF] / (double)tot) * (float)PROBE_Q + PROBE_OFS) * (1.0f / (float)PROBE_Q))); }
#else
        final_norm_rows(XN2, h, args.in[I_FINN], gw, ngw, lane, 1.0f);
#endif
    PH_CLOSE
#undef PH_OPEN
#undef PH_CLOSE
}

extern "C" void kernel_launch(void* const* d_in, const int* in_sizes, int n_in, void* d_out, int out_size, void* d_ws, size_t ws_size, hipStream_t stream) {
    static int grid = 0;
    if (grid == 0) {
        if (n_in != N_INPUTS || out_size != T * D || ws_size < WS_END) { fprintf(stderr, "kernel_launch: unexpected sizes (n_in %d, out %d, ws %zu, need %zu)\n", n_in, out_size, ws_size, (size_t)WS_END); grid = -1; return; }
        int dev = 0, cus = 0;
        if (hipGetDevice(&dev) != hipSuccess || hipDeviceGetAttribute(&cus, hipDeviceAttributeMultiprocessorCount, dev) != hipSuccess) { grid = -1; return; }
        if (hipFuncSetAttribute((const void*)fwd_kernel, hipFuncAttributeMaxDynamicSharedMemorySize, LDS_BYTES) != hipSuccess) { fprintf(stderr, "kernel_launch: hipFuncSetAttribute failed\n"); grid = -1; return; }
        int per_cu = 0;
        if (hipOccupancyMaxActiveBlocksPerMultiprocessor(&per_cu, (const void*)fwd_kernel, 512, LDS_BYTES) != hipSuccess || per_cu < 1) fprintf(stderr, "kernel_launch: occupancy query reports %d\n", per_cu);
        (void)hipGetLastError();
        grid = cus;
    }
    if (grid < 0) return;
    (void)in_sizes;
    hipMemsetAsync((char*)d_ws + WS_CTL, 0, CTL_BYTES, stream);
    Args a{};
    for (int i = 0; i < N_INPUTS; ++i) a.in[i] = (const float*)d_in[i];
    a.out = (float*)d_out; a.ws = (unsigned char*)d_ws;
#if ONE_LAUNCH
    a.lo = 0; a.hi = NPH;
    hipLaunchKernelGGL(fwd_kernel, dim3(grid), dim3(512), LDS_BYTES, stream, a);
#else
    for (int p = 0; p < NPH; ++p) { a.lo = p; a.hi = p + 1; hipLaunchKernelGGL(fwd_kernel, dim3(grid), dim3(512), LDS_BYTES, stream, a); }
#endif
}
```
